# Optimizing an MI355X kernel written in HIP

```python
import jax
import jax.numpy as jnp
from jax import lax
import numpy as np

D_MODEL = 1024
BATCH = 4
SEQ = 8192
DEPTH = 1

GRID_W = 64
CTX_LEN = 256

NA_HEADS = 8
NA_HEAD_DIM = 64
NA_WIDTH = NA_HEADS * NA_HEAD_DIM
WIN_H = 8
WIN_W = 16
ROPE_BASE = 10000.0

RW_HEADS = 8
RW_HEAD_DIM = 64
RW_WIDTH = RW_HEADS * RW_HEAD_DIM
DECAY_LORA = 64
AAA_LORA = 64
GATE_LORA = 128
RW_COLS = 3 * RW_WIDTH + 2 * DECAY_LORA + 2 * AAA_LORA + GATE_LORA
RW_SPLITS = (RW_WIDTH, 2 * RW_WIDTH, 3 * RW_WIDTH,
             3 * RW_WIDTH + DECAY_LORA, 3 * RW_WIDTH + 2 * DECAY_LORA,
             3 * RW_WIDTH + 2 * DECAY_LORA + AAA_LORA, 3 * RW_WIDTH + 2 * DECAY_LORA + 2 * AAA_LORA)

GATE_COLS = 2 * D_MODEL
P_IN = 3 * NA_WIDTH + RW_COLS + GATE_COLS

N_EXPERTS = 16
CAPACITY_FACTOR = 2
D_EXPERT = 2816

ALPHA = (2.0 * DEPTH) ** 0.25
BETA = (8.0 * DEPTH) ** -0.25
LN_EPS = 1e-6
GN_EPS = 64e-5

kernel_name = 'hybrid_natten_rwkv7_ecmoe_dit_block'


def layer_norm(x, gain=None, bias=None, eps=LN_EPS):
    xf = x.astype(jnp.float32)
    mu = jnp.mean(xf, axis=-1, keepdims=True)
    var = jnp.mean(jnp.square(xf - mu), axis=-1, keepdims=True)
    y = (xf - mu) * lax.rsqrt(var + eps)
    if gain is not None:
        y = y * gain.astype(jnp.float32) + bias.astype(jnp.float32)
    return y.astype(x.dtype)


def modulate(h, shift, scale):
    return layer_norm(h) * (1 + scale) + shift


def axial_rope(x):
    B, N, H, Dh = x.shape
    nf = Dh // 4
    t = jnp.arange(N)
    pos = jnp.stack([t // GRID_W, t % GRID_W], axis=-1).astype(jnp.float32)
    inv_freq = jnp.power(jnp.float32(ROPE_BASE), -jnp.arange(nf, dtype=jnp.float32) / nf)
    ang = pos[:, :, None] * inv_freq
    cos = jnp.cos(ang)[None, :, None]
    sin = jnp.sin(ang)[None, :, None]
    xr = x.astype(jnp.float32).reshape(B, N, H, 2, 2, nf)
    x1, x2 = xr[..., 0, :], xr[..., 1, :]
    out = jnp.stack([x1 * cos - x2 * sin, x2 * cos + x1 * sin], axis=-2)
    return out.reshape(B, N, H, Dh).astype(x.dtype)


def token_shift(z, mu_prev, mu_next):
    z_prev = jnp.pad(z[:, :-1], ((0, 0), (1, 0), (0, 0)))
    z_next = jnp.pad(z[:, 1:], ((0, 0), (0, 1), (0, 0)))
    return z + mu_prev * (z_prev - z) + mu_next * (z_next - z)


def neighbourhood_attention(q, k, v, k_ctx, v_ctx, rpb):
    B, H, N, Dh = q.shape
    rows = N // GRID_W
    kh = min(WIN_H, rows)
    scale = Dh ** -0.5
    grid = lambda t: t.reshape(B, H, rows, GRID_W, Dh)
    q, k, v = grid(q), grid(k), grid(v)
    col = jnp.arange(GRID_W)
    col_start = jnp.clip(col - WIN_W // 2, 0, GRID_W - WIN_W)
    col_idx = col_start[:, None] + jnp.arange(WIN_W)[None, :]
    col_off = col_idx - col[:, None] + (WIN_W - 1)

    def row_block(i):
        rs = jnp.clip(i - kh // 2, 0, rows - kh)
        qi = lax.dynamic_index_in_dim(q, i, axis=2, keepdims=False)
        kb = lax.dynamic_slice_in_dim(k, rs, kh, axis=2)[:, :, :, col_idx]
        vb = lax.dynamic_slice_in_dim(v, rs, kh, axis=2)[:, :, :, col_idx]
        row_off = rs + jnp.arange(kh) - i + (WIN_H - 1)
        bias = jnp.transpose(rpb[:, row_off][:, :, col_off], (0, 2, 1, 3))
        s_loc = jnp.einsum('bhqd,bhrqcd->bhqrc', qi, kb).astype(jnp.float32) * scale + bias.astype(jnp.float32)
        s_ctx = jnp.einsum('bhqd,bhld->bhql', qi, k_ctx).astype(jnp.float32) * scale
        s = jnp.concatenate([s_loc.reshape(B, H, GRID_W, kh * WIN_W), s_ctx], axis=-1)
        p = jax.nn.softmax(s, axis=-1).astype(v.dtype)
        p_loc = p[..., :kh * WIN_W].reshape(B, H, GRID_W, kh, WIN_W)
        return (jnp.einsum('bhqrc,bhrqcd->bhqd', p_loc, vb)
                + jnp.einsum('bhql,bhld->bhqd', p[..., kh * WIN_W:], v_ctx))

    out = lax.map(row_block, jnp.arange(rows))
    return jnp.transpose(out, (1, 0, 3, 2, 4)).reshape(B, N, H * Dh)


def context_attention(qc, kc, vc):
    B, H, L, Dh = qc.shape
    s = jnp.einsum('bhqd,bhkd->bhqk', qc, kc).astype(jnp.float32) * Dh ** -0.5
    p = jax.nn.softmax(s, axis=-1).astype(vc.dtype)
    o = jnp.einsum('bhqk,bhkd->bhqd', p, vc)
    return jnp.transpose(o, (0, 2, 1, 3)).reshape(B, L, H * Dh)


def rwkv_features(zr, p):
    B, T, _ = zr.shape
    hd = lambda t: t.reshape(B, T, RW_HEADS, RW_HEAD_DIM)
    r, k, v, wdf, wdb, adf, adb, gd = jnp.split(zr, RW_SPLITS, axis=-1)
    kkf = hd(k * p['k_k']).astype(jnp.float32)
    kk = (kkf * lax.rsqrt(jnp.sum(jnp.square(kkf), axis=-1, keepdims=True) + 1e-12)).astype(k.dtype)
    dirs = []
    for d, (wd, ad) in enumerate(((wdf, adf), (wdb, adb))):
        w_raw = (p['w0'][d] + jnp.tanh(wd) @ p['w_up'][d]).astype(jnp.float32)
        decay = jnp.exp(-jnp.exp(-jax.nn.softplus(-w_raw) - 0.5))
        a = jax.nn.sigmoid(p['a0'][d] + ad @ p['a_up'][d])
        kmod = k * (1 + (a - 1) * p['k_a'])
        dirs.append((hd(decay), hd(kmod), hd(a)))
    g = jax.nn.sigmoid(gd) @ p['g_up']
    return hd(r), hd(v), kk, dirs, g


def rwkv_scan(r, decay, k, a, v, kk, S0, reverse, emit):
    xs = tuple(jnp.moveaxis(t.astype(jnp.float32), 1, 0) for t in (r, decay, k, a, v, kk))

    def step(S, inp):
        r_t, w_t, k_t, a_t, v_t, kk_t = inp
        sa = jnp.einsum('bhvk,bhk->bhv', S, -kk_t)
        S = (S * w_t[:, :, None, :] + sa[..., None] * (kk_t * a_t)[:, :, None, :]
             + v_t[..., None] * k_t[:, :, None, :])
        y = jnp.einsum('bhvk,bhk->bhv', S, r_t) if emit else None
        return S, y

    S, ys = lax.scan(step, S0, xs, reverse=reverse)
    return S, (jnp.moveaxis(ys, 0, 1) if emit else None)


def rwkv_readout(y_sum, r, v, kmods, g, p):
    B, T = r.shape[:2]
    gn_w = p['gn_w'].reshape(RW_HEADS, RW_HEAD_DIM)
    gn_b = p['gn_b'].reshape(RW_HEADS, RW_HEAD_DIM)
    y = layer_norm(y_sum, gn_w, gn_b, GN_EPS).astype(r.dtype)
    for km in kmods:
        y = y + jnp.sum(r * km * p['r_k'], axis=-1, keepdims=True) * v
    return y.reshape(B, T, RW_WIDTH) * g


def merge_branches(y_na, y_rw, z_gate, p):
    gate_na, gate_rw = jnp.split(jax.nn.sigmoid(z_gate), 2, axis=-1)
    return (gate_na * (y_na @ p['w_pa']) + gate_rw * (y_rw @ p['w_pr'])) @ p['w_o']


def token_mixer(u, uc, p, emit_ctx):
    B = u.shape[0]
    cut = [3 * NA_WIDTH, 3 * NA_WIDTH + RW_COLS]
    z_na, z_rw, z_gate = jnp.split(u @ p['w_in'], cut, axis=-1)
    zc_na, zc_rw, zc_gate = jnp.split(uc @ p['w_in'], cut, axis=-1)

    heads = lambda t: t.reshape(t.shape[0], t.shape[1], NA_HEADS, NA_HEAD_DIM)
    bhnd = lambda t: jnp.transpose(t, (0, 2, 1, 3))
    q, k, v = (heads(t) for t in jnp.split(z_na, 3, axis=-1))
    q, k = axial_rope(q), axial_rope(k)
    qc, kc, vc = (bhnd(heads(t)) for t in jnp.split(zc_na, 3, axis=-1))
    y_na = neighbourhood_attention(bhnd(q), bhnd(k), bhnd(v), kc, vc, p['rpb'])

    r, vr, kk, dirs, g = rwkv_features(token_shift(z_rw, p['mu_prev'], p['mu_next']), p)
    rc, vrc, kkc, dirs_c, gc = rwkv_features(token_shift(zc_rw, p['mu_prev'], p['mu_next']), p)
    ys, ycs = [], []
    for d in range(2):
        rev = d == 1
        S0 = jnp.zeros((B, RW_HEADS, RW_HEAD_DIM, RW_HEAD_DIM), jnp.float32)
        S_ctx, y_c = rwkv_scan(rc, *dirs_c[d], vrc, kkc, S0, rev, emit_ctx)
        _, y_l = rwkv_scan(r, *dirs[d], vr, kk, S_ctx, rev, True)
        ys.append(y_l)
        ycs.append(y_c)
    y_rw = rwkv_readout(ys[0] + ys[1], r, vr, [dirs[0][1], dirs[1][1]], g, p)
    out = merge_branches(y_na, y_rw, z_gate, p)

    out_c = None
    if emit_ctx:
        yc_na = context_attention(qc, kc, vc)
        yc_rw = rwkv_readout(ycs[0] + ycs[1], rc, vrc, [dirs_c[0][1], dirs_c[1][1]], gc, p)
        out_c = merge_branches(yc_na, yc_rw, zc_gate, p)
    return out, out_c


def expert_choice_ffn(u, w_router, w1, w3, w2):
    B, T, D = u.shape
    cap = CAPACITY_FACTOR * T // N_EXPERTS
    aff = jax.nn.softmax((u @ w_router).astype(jnp.float32), axis=-1)
    gate, idx = lax.top_k(jnp.swapaxes(aff, 1, 2), cap)
    xs = jax.vmap(lambda ub, ib: ub[ib])(u, idx)
    hdn = jax.nn.silu(jnp.einsum('becd,edf->becf', xs, w1)) * jnp.einsum('becd,edf->becf', xs, w3)
    ye = jnp.einsum('becf,efd->becd', hdn, w2) * gate[..., None].astype(u.dtype)
    return jax.vmap(lambda ib, yb: jnp.zeros((T, D), yb.dtype).at[ib.reshape(-1)].add(yb.reshape(-1, D)))(idx, ye)


def setup_inputs(seed: int = 0) -> dict:
    key = jax.random.key(seed)
    keys = iter(jax.random.split(key, 40))
    D = D_MODEL

    def nrm(shape, s):
        return s * jax.random.normal(next(keys), shape, jnp.float32)

    def unif(shape, hi):
        return jax.random.uniform(next(keys), shape, jnp.float32, 0.0, hi)

    speed = -7.0 + 5.0 * (jnp.arange(RW_WIDTH, dtype=jnp.float32) / (RW_WIDTH - 1)) ** 0.85
    return {
        'x': nrm((BATCH, SEQ, D), 1.0),
        'c': nrm((BATCH, D), 1.0),
        'ctx': nrm((BATCH, CTX_LEN, D), 1.0),
        'c_ctx': nrm((D,), 1.0),
        'w_mod': nrm((DEPTH, D, 6 * D), 0.5 * D ** -0.5),
        'b_mod': nrm((DEPTH, 6 * D), 0.02),
        'w_in': nrm((DEPTH, D, P_IN), D ** -0.5),
        'rpb': nrm((DEPTH, NA_HEADS, 2 * WIN_H - 1, 2 * WIN_W - 1), 0.5),
        'mu_prev': unif((DEPTH, RW_COLS), 0.5),
        'mu_next': unif((DEPTH, RW_COLS), 0.5),
        'w0': speed + 0.5 + nrm((DEPTH, 2, RW_WIDTH), 0.1),
        'w_up': nrm((DEPTH, 2, DECAY_LORA, RW_WIDTH), 0.1 * DECAY_LORA ** -0.5),
        'a0': nrm((DEPTH, 2, RW_WIDTH), 0.1),
        'a_up': nrm((DEPTH, 2, AAA_LORA, RW_WIDTH), 0.5 * AAA_LORA ** -0.5),
        'g_up': nrm((DEPTH, GATE_LORA, RW_WIDTH), GATE_LORA ** -0.5),
        'k_k': 0.85 + nrm((DEPTH, RW_WIDTH), 0.02),
        'k_a': 1.0 + nrm((DEPTH, RW_WIDTH), 0.02),
        'r_k': nrm((DEPTH, RW_HEADS, RW_HEAD_DIM), 0.1),
        'gn_w': 1.0 + nrm((DEPTH, RW_WIDTH), 0.02),
        'gn_b': nrm((DEPTH, RW_WIDTH), 0.02),
        'w_pa': nrm((DEPTH, NA_WIDTH, D), NA_WIDTH ** -0.5),
        'w_pr': nrm((DEPTH, RW_WIDTH, D), RW_WIDTH ** -0.5),
        'w_o': nrm((DEPTH, D, D), BETA * D ** -0.5),
        'ln1_g': 1.0 + nrm((DEPTH, D), 0.02),
        'ln1_b': nrm((DEPTH, D), 0.02),
        'w_router': nrm((DEPTH, D, N_EXPERTS), D ** -0.5),
        'w_e1': nrm((DEPTH, N_EXPERTS, D, D_EXPERT), D ** -0.5),
        'w_e3': nrm((DEPTH, N_EXPERTS, D, D_EXPERT), D ** -0.5),
        'w_e2': nrm((DEPTH, N_EXPERTS, D_EXPERT, D), BETA * D_EXPERT ** -0.5),
        'ln2_g': 1.0 + nrm((DEPTH, D), 0.02),
        'ln2_b': nrm((DEPTH, D), 0.02),
    }


def reference(x, c, ctx, c_ctx, w_mod, b_mod, w_in, rpb, mu_prev, mu_next, w0, w_up, a0, a_up, g_up,
              k_k, k_a, r_k, gn_w, gn_b, w_pa, w_pr, w_o, ln1_g, ln1_b, w_router, w_e1, w_e3, w_e2,
              ln2_g, ln2_b):
    h, hc = x, ctx
    for l in range(DEPTH):
        emit_ctx = l < DEPTH - 1
        p = {'w_in': w_in[l], 'rpb': rpb[l], 'mu_prev': mu_prev[l], 'mu_next': mu_next[l],
             'w0': w0[l], 'w_up': w_up[l], 'a0': a0[l], 'a_up': a_up[l], 'g_up': g_up[l],
             'k_k': k_k[l], 'k_a': k_a[l], 'r_k': r_k[l], 'gn_w': gn_w[l], 'gn_b': gn_b[l],
             'w_pa': w_pa[l], 'w_pr': w_pr[l], 'w_o': w_o[l]}
        mod = jax.nn.silu(c) @ w_mod[l] + b_mod[l]
        mod_c = jax.nn.silu(c_ctx) @ w_mod[l] + b_mod[l]
        sh1, sc1, gt1, sh2, sc2, gt2 = jnp.split(mod[:, None, :], 6, axis=-1)
        csh1, csc1, cgt1, csh2, csc2, cgt2 = jnp.split(mod_c, 6, axis=-1)

        m, mc = token_mixer(modulate(h, sh1, sc1), modulate(hc, csh1, csc1), p, emit_ctx)
        h = layer_norm(ALPHA * h + gt1 * m, ln1_g[l], ln1_b[l])
        moe = expert_choice_ffn(modulate(h, sh2, sc2), w_router[l], w_e1[l], w_e3[l], w_e2[l])
        h = layer_norm(ALPHA * h + gt2 * moe, ln2_g[l], ln2_b[l])
        if emit_ctx:
            hc = layer_norm(ALPHA * hc + cgt1 * mc, ln1_g[l], ln1_b[l])
            moe_c = expert_choice_ffn(modulate(hc, csh2, csc2), w_router[l], w_e1[l], w_e3[l], w_e2[l])
            hc = layer_norm(ALPHA * hc + cgt2 * moe_c, ln2_g[l], ln2_b[l])
    return h
```

```cpp
#include <hip/hip_runtime.h>
#include <cstdio>
#include <cstdint>

#ifndef PROBE_REP
#define PROBE_REP 0
#endif
#define REPS(k) (((PROBE_REP >> (k)) & 1) ? 2 : 1)
#ifndef PROBE_DUP
#define PROBE_DUP 0
#endif
#define DUP(k) ((PROBE_DUP >> (k)) & 1)
#ifndef MK_ONE_LAUNCH
#define MK_ONE_LAUNCH 1
#endif

namespace pg8 {
#define PG8_LAS __attribute__((address_space(3)))
typedef unsigned short bf16_t;
typedef short bf16x8 __attribute__((ext_vector_type(8)));
typedef float f32x4 __attribute__((ext_vector_type(4)));
typedef unsigned u32x4 __attribute__((ext_vector_type(4)));
typedef unsigned u32x2 __attribute__((ext_vector_type(2)));
constexpr int BM = 256, BK = 64, HALF = 128, HTB = HALF * BK * 2, STAGE_BYTES = 8 * HTB, NXCD = 8, WGM = 8;

__host__ __device__ __forceinline__ int lds_byte(int r, int c) { const int st = (r >> 4) * 2 + (c >> 5), rr = r & 15, cc = c & 31, ob = rr * 64 + cc * 2; return st * 1024 + (ob ^ (((ob >> 9) & 1) << 5)); }
__host__ __device__ __forceinline__ void stage_rc(int b, int& R, int& C) { const int st = b / 1024, sb = b % 1024, swz = sb ^ (((sb >> 9) & 1) << 5); R = (st >> 1) * 16 + swz / 64; C = (st & 1) * 32 + (swz % 64) / 2; }
__host__ __device__ __forceinline__ int perm32(int rho) { const int n = rho >> 4, i = rho & 15; return 8 * (i >> 2) + 4 * n + (i & 3); }

struct Unit { int pm, pn; };
struct Gemm { const bf16_t* A; const bf16_t* Bt; int M, N, K, lda; int pmg; size_t bgs; };

struct StaticOrder {
    int nM, nN, nwg, G, c;
    __host__ __device__ void init(int M, int N, int G_, int c_) { nM = M / BM; nN = N / BM; nwg = nM * nN; G = G_; c = c_; }
    __host__ __device__ bool next(int i, Unit& u) const {
        const long L = (long)i * G + c; if (L >= nwg) return false;
        int wgid = (int)L; { const int q = nwg / NXCD, r = nwg % NXCD, xcd = wgid % NXCD, off = wgid / NXCD; wgid = (xcd < r ? xcd * (q + 1) : r * (q + 1) + (xcd - r) * q) + off; }
        const int nig = WGM * nN, gid = wgid / nig, fm = gid * WGM, gsz = (nM - fm) < WGM ? (nM - fm) : WGM;
        u.pm = fm + ((wgid % nig) % gsz); u.pn = (wgid % nig) / gsz; return true;
    }
    __device__ __forceinline__ void a_ready(const Unit&) const {}
    __device__ __forceinline__ void done(const Unit&) const {}
};

typedef __bf16 bf16x2_t __attribute__((ext_vector_type(2)));
typedef float f32x2_t __attribute__((ext_vector_type(2)));
__device__ __forceinline__ unsigned cvt_pk_bf16(float lo, float hi) { const f32x2_t v = {lo, hi}; const bf16x2_t b = __builtin_convertvector(v, bf16x2_t); return __builtin_bit_cast(unsigned, b); }
__device__ __forceinline__ float bf_lo(unsigned w) { return __uint_as_float(w << 16); }
__device__ __forceinline__ float bf_hi(unsigned w) { return __uint_as_float(w & 0xffff0000u); }
__device__ __forceinline__ float sigmoidf_(float x) { return __builtin_amdgcn_rcpf(1.0f + __expf(-x)); }

struct EpiBf16 {
    static constexpr bool PERM = true;
    bf16_t* O; int ldc;
    __device__ __forceinline__ void operator()(const f32x4 (&acc)[2][2][4][2], const Unit& u, int wr, int wc, int fr, int fq) const {
        const int row0 = u.pm * BM + wr * 64 + fr, col0 = u.pn * BM + wc * 32 + 8 * fq;
#pragma unroll
        for (int ai = 0; ai < 2; ++ai)
#pragma unroll
            for (int m = 0; m < 4; ++m) { bf16_t* rowp = O + (size_t)(row0 + ai * HALF + m * 16) * ldc + col0;
#pragma unroll
                for (int bj = 0; bj < 2; ++bj) { const f32x4 v0 = acc[ai][bj][m][0], v1 = acc[ai][bj][m][1];
                    u32x4 w; w.x = cvt_pk_bf16(v0[0], v0[1]); w.y = cvt_pk_bf16(v0[2], v0[3]); w.z = cvt_pk_bf16(v1[0], v1[1]); w.w = cvt_pk_bf16(v1[2], v1[3]);
                    *(u32x4*)(rowp + bj * HALF) = w; } }
    }
};
template <int MODE> struct EpiGate {
    static constexpr bool PERM = true;
    bf16_t* O; int ldc; const bf16_t* G; int ldg;
    __device__ __forceinline__ void operator()(const f32x4 (&acc)[2][2][4][2], const Unit& u, int wr, int wc, int fr, int fq) const {
        const int row0 = u.pm * BM + wr * 64 + fr, col0 = u.pn * BM + wc * 32 + 8 * fq;
#pragma unroll
        for (int ai = 0; ai < 2; ++ai)
#pragma unroll
            for (int m = 0; m < 4; ++m) { const size_t row = (size_t)(row0 + ai * HALF + m * 16);
#pragma unroll
                for (int bj = 0; bj < 2; ++bj) { const f32x4 v0 = acc[ai][bj][m][0], v1 = acc[ai][bj][m][1];
                    const u32x4 gz = *(const u32x4*)(G + row * ldg + col0 + bj * HALF);
                    float o[8];
                    o[0] = sigmoidf_(bf_lo(gz.x)) * v0[0]; o[1] = sigmoidf_(bf_hi(gz.x)) * v0[1]; o[2] = sigmoidf_(bf_lo(gz.y)) * v0[2]; o[3] = sigmoidf_(bf_hi(gz.y)) * v0[3];
                    o[4] = sigmoidf_(bf_lo(gz.z)) * v1[0]; o[5] = sigmoidf_(bf_hi(gz.z)) * v1[1]; o[6] = sigmoidf_(bf_lo(gz.w)) * v1[2]; o[7] = sigmoidf_(bf_hi(gz.w)) * v1[3];
                    bf16_t* op = O + row * ldc + col0 + bj * HALF;
                    if (MODE == 1) { const u32x4 pz = *(const u32x4*)op;
                        o[0] += bf_lo(pz.x); o[1] += bf_hi(pz.x); o[2] += bf_lo(pz.y); o[3] += bf_hi(pz.y); o[4] += bf_lo(pz.z); o[5] += bf_hi(pz.z); o[6] += bf_lo(pz.w); o[7] += bf_hi(pz.w); }
                    u32x4 w; w.x = cvt_pk_bf16(o[0], o[1]); w.y = cvt_pk_bf16(o[2], o[3]); w.z = cvt_pk_bf16(o[4], o[5]); w.w = cvt_pk_bf16(o[6], o[7]);
                    *(u32x4*)op = w; } }
    }
};
struct EpiResid {
    static constexpr bool PERM = false;
    float* O; const float* X; const float* gt; int gt_pitch; int rows_per_b; float alpha;
    __device__ __forceinline__ void operator()(const f32x4 (&acc)[2][2][4][2], const Unit& u, int wr, int wc, int fr, int fq) const {
        const int row0 = u.pm * BM + wr * 64 + fr, col0 = u.pn * BM + wc * 32 + 4 * fq;
        const float* gtb = gt + (size_t)((u.pm * BM) / rows_per_b) * gt_pitch + col0;
        f32x4 gv[2][2];
#pragma unroll
        for (int bj = 0; bj < 2; ++bj)
#pragma unroll
            for (int n = 0; n < 2; ++n) gv[bj][n] = *(const f32x4*)(gtb + bj * HALF + n * 16);
#pragma unroll
        for (int ai = 0; ai < 2; ++ai)
#pragma unroll
            for (int m = 0; m < 4; ++m) { const size_t off = (size_t)(row0 + ai * HALF + m * 16) * 1024 + col0;
#pragma unroll
                for (int bj = 0; bj < 2; ++bj)
#pragma unroll
                    for (int n = 0; n < 2; ++n) { const f32x4 xv = *(const f32x4*)(X + off + bj * HALF + n * 16);
                        *(f32x4*)(O + off + bj * HALF + n * 16) = xv * alpha + gv[bj][n] * acc[ai][bj][m][n]; } }
    }
};
struct EpiSwiglu {
    static constexpr bool PERM = true;
    unsigned char* H; int ldh; float as, hs;
    __device__ __forceinline__ void operator()(const f32x4 (&acc)[2][2][4][2], const Unit& u, int wr, int wc, int fr, int fq) const {
        const int row0 = u.pm * BM + wr * 64 + fr, col0 = u.pn * HALF + wc * 32 + 8 * fq;
#pragma unroll
        for (int ai = 0; ai < 2; ++ai)
#pragma unroll
            for (int m = 0; m < 4; ++m) { unsigned char* rowp = H + (size_t)(row0 + ai * HALF + m * 16) * ldh + col0;
                float o[8];
#pragma unroll
                for (int n = 0; n < 2; ++n)
#pragma unroll
                    for (int j = 0; j < 4; ++j) { const float a = acc[ai][0][m][n][j] * as, b = acc[ai][1][m][n][j] * as; o[n * 4 + j] = fminf(fmaxf(a * sigmoidf_(a) * b * hs, -448.f), 448.f); }
                u32x2 w; w.x = (unsigned)__builtin_amdgcn_cvt_pk_fp8_f32(o[2], o[3], __builtin_amdgcn_cvt_pk_fp8_f32(o[0], o[1], 0, false), true);
                w.y = (unsigned)__builtin_amdgcn_cvt_pk_fp8_f32(o[6], o[7], __builtin_amdgcn_cvt_pk_fp8_f32(o[4], o[5], 0, false), true);
                *(u32x2*)rowp = w; }
    }
};
struct EpiScaleRow {
    static constexpr bool PERM = true;
    bf16_t* O; int ldc; const float* gate; float sc;
    __device__ __forceinline__ void operator()(const f32x4 (&acc)[2][2][4][2], const Unit& u, int wr, int wc, int fr, int fq) const {
        const int row0 = u.pm * BM + wr * 64 + fr, col0 = u.pn * BM + wc * 32 + 8 * fq;
#pragma unroll
        for (int ai = 0; ai < 2; ++ai)
#pragma unroll
            for (int m = 0; m < 4; ++m) { const int row = row0 + ai * HALF + m * 16; const float gsc = gate[row] * sc; bf16_t* rowp = O + (size_t)row * ldc + col0;
#pragma unroll
                for (int bj = 0; bj < 2; ++bj) { const f32x4 v0 = acc[ai][bj][m][0] * gsc, v1 = acc[ai][bj][m][1] * gsc;
                    u32x4 w; w.x = cvt_pk_bf16(v0[0], v0[1]); w.y = cvt_pk_bf16(v0[2], v0[3]); w.z = cvt_pk_bf16(v1[0], v1[1]); w.w = cvt_pk_bf16(v1[2], v1[3]);
                    *(u32x4*)(rowp + bj * HALF) = w; } }
    }
};

typedef int v8i_t __attribute__((ext_vector_type(8)));
typedef int v4i_t __attribute__((ext_vector_type(4)));
template <class Epi, class Sched, bool ALIGN_EPI = false, bool SP2 = false, bool FP8 = false>
__device__ __forceinline__ void gemm_phase(PG8_LAS unsigned char* lds, const Gemm g, const Sched& S, const Epi& E) {
    const int tid = threadIdx.x, wid = __builtin_amdgcn_readfirstlane(tid >> 6), lane = tid & 63, wr = wid >> 2, wc = wid & 3, fr = lane & 15, fq = lane >> 4;
    const int K = g.K, nt = K / BK;
    unsigned voffA[2], voffB[2];
#pragma unroll
    for (int i = 0; i < 2; ++i) { int R, C; stage_rc(tid * 16 + i * 8192, R, C); const int Rb = Epi::PERM ? ((R & ~31) + perm32(R & 31)) : R;
        voffA[i] = (unsigned)(R * g.lda + C) * 2u; voffB[i] = (unsigned)(Rb * K + C) * 2u; }
    const size_t kstep = (size_t)(BK * 2);
    const size_t hstepA = (size_t)HALF * g.lda * 2, tstepA = 2 * hstepA;
    const size_t hstepB = (size_t)HALF * K * 2, tstepB = 2 * hstepB;
    const unsigned ldsw = (unsigned)wid * 1024u;
    const int aoff = lds_byte(wr * 64 + fr, fq * 8), boff = lds_byte(wc * 32 + fr, fq * 8);
#define PG8_SA(b, h) (((b) * 2 + (h)) * HTB)
#define PG8_SB(b, h) ((4 + (b) * 2 + (h)) * HTB)
#define PG8_STAGE(bufoff, gbase, voff) do { _Pragma("unroll") for (int _i = 0; _i < 2; ++_i) \
        __builtin_amdgcn_global_load_lds((const unsigned*)((const char*)(gbase) + (voff)[_i]), (PG8_LAS unsigned*)(lds + (bufoff) + ldsw + _i * 8192), 16, 0, 0); } while (0)
#define PG8_LDA(dst, b, h) do { if constexpr (FP8) { _Pragma("unroll") for (int m = 0; m < 4; ++m) dst##8[m] = __builtin_shufflevector(*(const PG8_LAS v4i_t*)(lds + PG8_SA(b, h) + aoff + m * 2048), *(const PG8_LAS v4i_t*)(lds + PG8_SA(b, h) + aoff + m * 2048 + 1024), 0, 1, 2, 3, 4, 5, 6, 7); } \
    else { _Pragma("unroll") for (int m = 0; m < 4; ++m) _Pragma("unroll") for (int k = 0; k < 2; ++k) dst[m][k] = *(const PG8_LAS bf16x8*)(lds + PG8_SA(b, h) + aoff + m * 2048 + k * 1024); } } while (0)
#define PG8_LDB(dst, b, h) do { if constexpr (FP8) { _Pragma("unroll") for (int n = 0; n < 2; ++n) dst##8[n] = __builtin_shufflevector(*(const PG8_LAS v4i_t*)(lds + PG8_SB(b, h) + boff + n * 2048), *(const PG8_LAS v4i_t*)(lds + PG8_SB(b, h) + boff + n * 2048 + 1024), 0, 1, 2, 3, 4, 5, 6, 7); } \
    else { _Pragma("unroll") for (int n = 0; n < 2; ++n) _Pragma("unroll") for (int k = 0; k < 2; ++k) dst[n][k] = *(const PG8_LAS bf16x8*)(lds + PG8_SB(b, h) + boff + n * 2048 + k * 1024); } } while (0)
#define PG8_MMA(ai, bj, At, Bt) do { __builtin_amdgcn_s_setprio(1); _Pragma("unroll") for (int m = 0; m < 4; ++m) _Pragma("unroll") for (int n = 0; n < 2; ++n) { \
        if constexpr (FP8) { asm volatile("v_mfma_scale_f32_16x16x128_f8f6f4 %0, %1, %2, %0, %3, %3 op_sel_hi:[0,0,0]" : "+v"(acc[ai][bj][m][n]) : "v"(Bt##8[n]), "v"(At##8[m]), "v"(sc1)); } \
        else { _Pragma("unroll") for (int k = 0; k < 2; ++k) acc[ai][bj][m][n] = __builtin_amdgcn_mfma_f32_16x16x32_bf16(Bt[n][k], At[m][k], acc[ai][bj][m][n], 0, 0, 0); } } \
        __builtin_amdgcn_s_setprio(0); } while (0)
#define PG8_WAIT_V(n) asm volatile("s_waitcnt vmcnt(" #n ")" ::: "memory")
#define PG8_WAIT_L(n) asm volatile("s_waitcnt lgkmcnt(" #n ")" ::: "memory")
#define PG8_BAR __builtin_amdgcn_s_barrier()
#define PG8_SCHED __builtin_amdgcn_sched_barrier(0)
    Unit cur, nxt; int ui = 0;
    if (!S.next(0, cur)) return;
    f32x4 acc[2][2][4][2];
#pragma unroll
    for (int a = 0; a < 2; ++a)
#pragma unroll
        for (int b = 0; b < 2; ++b)
#pragma unroll
            for (int m = 0; m < 4; ++m)
#pragma unroll
                for (int n = 0; n < 2; ++n) acc[a][b][m][n] = (f32x4){0.f, 0.f, 0.f, 0.f};
    bf16x8 At[4][2], B0[2][2], B1[2][2]; v8i_t At8[4], B08[2], B18[2]; const int sc1 = 0x7f7f7f7f;
    const char* cA = (const char*)g.A + (size_t)cur.pm * tstepA; const char* cB = (const char*)g.Bt + (size_t)cur.pn * tstepB + (size_t)(cur.pm / g.pmg) * g.bgs;
    S.a_ready(cur);
    if constexpr (SP2) {
        PG8_STAGE(PG8_SB(0, 0), cB, voffB); PG8_STAGE(PG8_SB(0, 1), cB + hstepB, voffB); PG8_STAGE(PG8_SA(0, 0), cA, voffA); PG8_STAGE(PG8_SA(0, 1), cA + hstepA, voffA);
        if (wr == 1) PG8_BAR;
        PG8_WAIT_V(2); PG8_BAR;
        PG8_STAGE(PG8_SB(1, 0), cB + kstep, voffB); PG8_STAGE(PG8_SA(1, 0), cA + kstep, voffA); PG8_STAGE(PG8_SB(1, 1), cB + hstepB + kstep, voffB);
        PG8_WAIT_V(6); PG8_BAR;
    } else {
        PG8_STAGE(PG8_SB(0, 0), cB, voffB); PG8_STAGE(PG8_SA(0, 0), cA, voffA); PG8_STAGE(PG8_SB(0, 1), cB + hstepB, voffB); PG8_STAGE(PG8_SA(0, 1), cA + hstepA, voffA);
        if (wr == 1) PG8_BAR;
        PG8_WAIT_V(4); PG8_BAR;
        PG8_STAGE(PG8_SB(1, 0), cB + kstep, voffB); PG8_STAGE(PG8_SA(1, 0), cA + kstep, voffA); PG8_STAGE(PG8_SB(1, 1), cB + hstepB + kstep, voffB);
        PG8_WAIT_V(6); PG8_BAR;
    }
    for (;;) {
        const bool has_next = S.next(ui + 1, nxt);
        const char* nA = has_next ? (const char*)g.A + (size_t)nxt.pm * tstepA : cA;
        const char* nB = has_next ? (const char*)g.Bt + (size_t)nxt.pn * tstepB + (size_t)(nxt.pm / g.pmg) * g.bgs : cB;
        for (int t = 0; t < nt; t += 2) {
            const bool last = (t == nt - 2);
            const char* a1 = cA + (size_t)(t + 1) * kstep;
            const char* a2 = last ? nA : cA + (size_t)(t + 2) * kstep; const char* b2 = last ? nB : cB + (size_t)(t + 2) * kstep;
            const char* a3 = a2 + kstep; const char* b3 = b2 + kstep;
            if (last && has_next) S.a_ready(nxt);
            if constexpr (SP2) {
            PG8_LDB(B0, 0, 0); PG8_LDB(B1, 0, 1); PG8_SCHED; PG8_LDA(At, 0, 0); PG8_STAGE(PG8_SA(1, 1), a1 + hstepA, voffA);
            PG8_WAIT_V(8); PG8_WAIT_L(0); PG8_BAR; PG8_MMA(0, 0, At, B0); PG8_MMA(0, 1, At, B1); PG8_BAR; PG8_SCHED;
            PG8_LDA(At, 0, 1); PG8_STAGE(PG8_SB(0, 0), b2, voffB); PG8_STAGE(PG8_SB(0, 1), b2 + hstepB, voffB); PG8_STAGE(PG8_SA(0, 0), a2, voffA);
            PG8_WAIT_V(8); PG8_WAIT_L(0); PG8_BAR; PG8_MMA(1, 0, At, B0); PG8_MMA(1, 1, At, B1); PG8_BAR; PG8_SCHED;
            PG8_LDB(B0, 1, 0); PG8_LDB(B1, 1, 1); PG8_SCHED; PG8_LDA(At, 1, 0); PG8_STAGE(PG8_SA(0, 1), a2 + hstepA, voffA);
            PG8_WAIT_V(8); PG8_WAIT_L(0); PG8_BAR; PG8_MMA(0, 0, At, B0); PG8_MMA(0, 1, At, B1); PG8_BAR; PG8_SCHED;
            PG8_LDA(At, 1, 1); PG8_STAGE(PG8_SB(1, 0), b3, voffB); PG8_STAGE(PG8_SB(1, 1), b3 + hstepB, voffB); PG8_STAGE(PG8_SA(1, 0), a3, voffA);
            PG8_WAIT_V(8); PG8_WAIT_L(0); PG8_BAR; PG8_MMA(1, 0, At, B0); PG8_MMA(1, 1, At, B1); PG8_BAR; PG8_SCHED;
            } else {
            PG8_LDB(B0, 0, 0); PG8_SCHED; PG8_LDA(At, 0, 0); PG8_STAGE(PG8_SA(1, 1), a1 + hstepA, voffA);
            PG8_WAIT_L(8); PG8_BAR; PG8_WAIT_L(0); PG8_MMA(0, 0, At, B0); PG8_BAR; PG8_SCHED;
            PG8_LDB(B1, 0, 1); PG8_STAGE(PG8_SB(0, 0), b2, voffB);
            PG8_BAR; PG8_WAIT_L(0); PG8_MMA(0, 1, At, B1); PG8_BAR;
            PG8_LDA(At, 0, 1); PG8_STAGE(PG8_SA(0, 0), a2, voffA);
            PG8_BAR; PG8_WAIT_L(0); PG8_MMA(1, 0, At, B0); PG8_BAR; PG8_SCHED;
            PG8_STAGE(PG8_SB(0, 1), b2 + hstepB, voffB);
            PG8_WAIT_V(6); PG8_BAR; PG8_MMA(1, 1, At, B1); PG8_BAR;
            PG8_LDB(B0, 1, 0); PG8_SCHED; PG8_LDA(At, 1, 0); PG8_STAGE(PG8_SA(0, 1), a2 + hstepA, voffA);
            PG8_WAIT_L(8); PG8_BAR; PG8_WAIT_L(0); PG8_MMA(0, 0, At, B0); PG8_BAR; PG8_SCHED;
            PG8_LDB(B1, 1, 1); PG8_STAGE(PG8_SB(1, 0), b3, voffB);
            PG8_BAR; PG8_WAIT_L(0); PG8_MMA(0, 1, At, B1); PG8_BAR;
            PG8_LDA(At, 1, 1); PG8_STAGE(PG8_SA(1, 0), a3, voffA);
            PG8_BAR; PG8_WAIT_L(0); PG8_MMA(1, 0, At, B0); PG8_BAR; PG8_SCHED;
            PG8_STAGE(PG8_SB(1, 1), b3 + hstepB, voffB);
            PG8_WAIT_V(6); PG8_BAR; PG8_MMA(1, 1, At, B1); PG8_BAR;
            }
        }
        if constexpr (ALIGN_EPI) { if (wr == 0) PG8_BAR; }
        if constexpr (FP8) asm volatile("s_nop 15\n\ts_nop 15" ::: "memory");
        E(acc, cur, wr, wc, fr, fq); S.done(cur);
        if (!has_next) break;
#pragma unroll
        for (int a = 0; a < 2; ++a)
#pragma unroll
            for (int b = 0; b < 2; ++b)
#pragma unroll
                for (int m = 0; m < 4; ++m)
#pragma unroll
                    for (int n = 0; n < 2; ++n) acc[a][b][m][n] = (f32x4){0.f, 0.f, 0.f, 0.f};
        cur = nxt; cA = nA; cB = nB; ++ui;
        if constexpr (FP8) asm volatile("s_nop 7" ::: "memory");
        if constexpr (ALIGN_EPI) { if (wr == 1) PG8_BAR; }
    }
    PG8_WAIT_V(0);
    if constexpr (!ALIGN_EPI) { if (wr == 0) PG8_BAR; }
    PG8_BAR;
#undef PG8_SA
#undef PG8_SB
#undef PG8_STAGE
#undef PG8_LDA
#undef PG8_LDB
#undef PG8_MMA
#undef PG8_WAIT_V
#undef PG8_WAIT_L
#undef PG8_BAR
#undef PG8_SCHED
}
}

constexpr int NWAVES = 8, NTHR = 512;
constexpr int NB = 4, T = 8192, D = 1024, LC = 256, GW = 64, GH = 128;
constexpr int MT = NB * T, MC = NB * LC, MA = MT + MC;
constexpr int PIN = 5504, PINP = 5632;
constexpr int ZQ = 0, ZK = 512, ZV = 1024, ZRW = 1536, ZR = 1536, ZRK = 2048, ZRV = 2560, ZLORA = 3072, ZG = 3456, ZGNA = 3456, ZGRW = 4480;
constexpr int NE = 16, CAP = 1024, DE = 2816, NSLOT = NB * NE * CAP;
constexpr float ALPHA = 1.189207115f;
constexpr float LN_EPS = 1e-6f, GN_EPS = 64e-5f;
constexpr int LORAW = 2560;

constexpr size_t MiB = 1u << 20;
constexpr size_t WS_CTL = 0, CTL_ZERO_BYTES = 1 * MiB;
constexpr size_t WS_MOD = 1 * MiB;
constexpr size_t WS_WIN = 2 * MiB;
constexpr size_t WS_WPA = 13 * MiB, WS_WPR = 14 * MiB, WS_WO = 15 * MiB;
constexpr size_t WS_AFF = 17 * MiB;
constexpr size_t WS_IDX = 19 * MiB;
constexpr size_t WS_GATEV = 19 * MiB + 256 * 1024;
constexpr size_t WS_SLOT = 20 * MiB;
constexpr size_t WS_U = 22 * MiB;
constexpr size_t WS_Z = 88 * MiB;
constexpr size_t WS_LORA = 451 * MiB;
constexpr size_t WS_ROPE = 1 * MiB + 128 * 1024;
constexpr size_t WS_LW = 1 * MiB + 512 * 1024;
constexpr size_t WS_COEF = 17 * MiB;
constexpr size_t WS_YFB = 22 * MiB;
constexpr size_t WS_PQ = 451 * MiB;
constexpr size_t WS_G = 583 * MiB;
constexpr size_t WS_VT = 616 * MiB;
constexpr size_t WS_END1 = 616 * MiB;
constexpr size_t WS_U2 = 22 * MiB;
constexpr size_t WS_W13 = 54 * MiB;
constexpr size_t WS_W2 = 654 * MiB;
constexpr size_t WS_XS = 186 * MiB;
constexpr size_t WS_HDN = 250 * MiB;
constexpr size_t WS_YE = 426 * MiB;
constexpr float W13_SCALE = 64.f, W2_SCALE = 128.f, HDN_SCALE = 8.f;
constexpr size_t WS_END = 698 * MiB;
constexpr int W2_EARLY_TILES = 256 * 12;
static_assert(WS_VT + (size_t)34 * MiB <= WS_END, "ws map");
constexpr size_t VT_LAT_ELEMS = (size_t)NB * 8 * 64 * T, VT_CTX_ELEMS = (size_t)NB * 8 * 64 * LC;

constexpr int RING_BYTES = 131072, LDS_BYTES = 147456, LDSCTL_OFF = LDS_BYTES - 512, MISC_OFF = LDSCTL_OFF + 320;

#define GAS __attribute__((address_space(1)))
#define LAS __attribute__((address_space(3)))
typedef unsigned short bf16;
typedef unsigned v4u __attribute__((ext_vector_type(4)));
typedef unsigned v2u __attribute__((ext_vector_type(2)));
typedef float f32x4 __attribute__((ext_vector_type(4)));
typedef float f32x2 __attribute__((ext_vector_type(2)));
typedef short bf16x8 __attribute__((ext_vector_type(8)));
typedef short bf16x4 __attribute__((ext_vector_type(4)));
typedef GAS unsigned gu32;
#define RLX_AGENT __ATOMIC_RELAXED, __HIP_MEMORY_SCOPE_AGENT
#define LDS_WAIT() asm volatile("s_waitcnt lgkmcnt(0)" ::: "memory")
#define VM_WAIT() asm volatile("s_waitcnt vmcnt(0)" ::: "memory")
__device__ __forceinline__ unsigned f2bf(float f) { return pg8::cvt_pk_bf16(f, f) & 0xffffu; }
__device__ __forceinline__ unsigned pk2(float lo, float hi) { return pg8::cvt_pk_bf16(lo, hi); }
__device__ __forceinline__ float bf2f(bf16 b) { return __uint_as_float(((unsigned)b) << 16); }
__device__ __forceinline__ float bflo(unsigned w) { return __uint_as_float(w << 16); }
__device__ __forceinline__ float bfhi(unsigned w) { return __uint_as_float(w & 0xffff0000u); }
__device__ __forceinline__ float sigm(float x) { return 1.0f / (1.0f + __expf(-x)); }

#define XB_TMO      128
#define XB_XCNT(j)  (256  + 64 * (j))
#define XB_XSUB(j)  (1280 + 64 * (j))
#define XB_XGEN(j)  (2304 + 64 * (j))
#define XB_TOP      3328
#define XB_TOPGEN   3392
#define XCD_BAR_WORDS 3456
#define XB_SPIN_CAP (1u << 18)
__device__ __forceinline__ unsigned xb_ld(unsigned* p)              { return __hip_atomic_load(p, __ATOMIC_RELAXED, __HIP_MEMORY_SCOPE_AGENT); }
__device__ __forceinline__ unsigned xb_add(unsigned* p, unsigned v) { return __hip_atomic_fetch_add(p, v, __ATOMIC_RELAXED, __HIP_MEMORY_SCOPE_AGENT); }
__device__ __forceinline__ unsigned xb_xcc_id() { return (unsigned)__builtin_amdgcn_s_getreg((3 << 11) | 20) & 0xFu; }
#define XB_SPIN(cond, bar) do { unsigned _sp = 0; while (cond) { __builtin_amdgcn_s_sleep(1); \
    if ((++_sp & 255u) == 0u) { if (xb_ld(&(bar)[XB_TMO])) break; if (_sp > XB_SPIN_CAP) { atomicAdd(&(bar)[XB_TMO], 1u); break; } } } } while (0)
struct XcdBarrier { unsigned* bar; unsigned x; volatile LAS unsigned* st; };
__device__ __forceinline__ XcdBarrier xcd_barrier_post(unsigned* bar, volatile LAS unsigned* st) {
    XcdBarrier b; b.bar = bar; b.x = xb_xcc_id(); b.st = st;
    if (threadIdx.x == 0) (void)xb_add(&bar[XB_XCNT(b.x)], 1u);
    return b;
}
__device__ __forceinline__ void xcd_barrier_complete(unsigned* bar, unsigned x, unsigned& nloc, unsigned& nx) {
    const unsigned G = gridDim.x * gridDim.y * gridDim.z;
    unsigned sum, cnt, mine, sp = 0u;
    for (;;) {
        sum = 0u; cnt = 0u; mine = 0u;
#pragma unroll
        for (unsigned j = 0; j < 16; ++j) { const unsigned c = xb_ld(&bar[XB_XCNT(j)]); sum += c; cnt += (c > 0u) ? 1u : 0u; mine = (j == x) ? c : mine; }
        if (sum == G) break;
        __builtin_amdgcn_s_sleep(1);
        if ((++sp & 255u) == 0u) { if (xb_ld(&bar[XB_TMO])) break; if (sp > XB_SPIN_CAP) { atomicAdd(&bar[XB_TMO], 1u); break; } }
    }
    nloc = mine > 0u ? mine : 1u; nx = cnt > 0u ? cnt : 1u;
}
__device__ __forceinline__ void xcd_barrier(const XcdBarrier& b) {
    asm volatile("s_waitcnt vmcnt(0)" ::: "memory");
    __syncthreads();
    if (threadIdx.x == 0) {
        unsigned* bar = b.bar;
        __builtin_amdgcn_s_waitcnt(0);
        unsigned nloc = b.st[0], nx = b.st[1];
        if (nloc == 0u) { xcd_barrier_complete(bar, b.x, nloc, nx); b.st[0] = nloc; b.st[1] = nx; }
        const unsigned old = xb_add(&bar[XB_XSUB(b.x)], 1u);
        const unsigned gen = old / nloc;
        if (old + 1u == (gen + 1u) * nloc) {
            __builtin_amdgcn_fence(__ATOMIC_RELEASE, "agent");
            asm volatile("s_waitcnt vmcnt(0)" ::: "memory");
#pragma unroll
            for (unsigned j = 0; j < 16; ++j) (void)xb_add(&bar[XB_XGEN(j)], 1u);
        }
        const unsigned target = (gen + 1u) * nx;
        XB_SPIN(xb_ld(&bar[XB_XGEN(b.x)]) < target, bar);
        __builtin_amdgcn_fence(__ATOMIC_ACQUIRE, "agent");
        asm volatile("s_waitcnt vmcnt(0)" ::: "memory");
    }
    __syncthreads();
}
constexpr int CW_BAR = 4096;

template <int CTRL> __device__ __forceinline__ float dppf(float v) { return __builtin_bit_cast(float, __builtin_amdgcn_update_dpp(0, __builtin_bit_cast(int, v), CTRL, 0xF, 0xF, true)); }
__device__ __forceinline__ float row16_sum(float v) {
    v += dppf<0xB1>(v);
    v += dppf<0x4E>(v);
    v += dppf<0x141>(v);
    v += dppf<0x140>(v);
    return v;
}

__device__ __forceinline__ float wave_sum(float v) { v = row16_sum(v); v += __shfl_xor(v, 16); v += __shfl_xor(v, 32); return v; }

__device__ __forceinline__ void unpack8(v4u w, float (&o)[8]) { o[0] = bflo(w.x); o[1] = bfhi(w.x); o[2] = bflo(w.y); o[3] = bfhi(w.y); o[4] = bflo(w.z); o[5] = bfhi(w.z); o[6] = bflo(w.w); o[7] = bfhi(w.w); }
__device__ __forceinline__ v4u pack8(const float (&v)[8]) { v4u o; o.x = pg8::cvt_pk_bf16(v[0], v[1]); o.y = pg8::cvt_pk_bf16(v[2], v[3]); o.z = pg8::cvt_pk_bf16(v[4], v[5]); o.w = pg8::cvt_pk_bf16(v[6], v[7]); return o; }
struct Frame {
    LAS unsigned char* lds;
    int tid, lane, wave, G, bid;
    const float* in[31]; float* out; unsigned char* ws;
};

__device__ __forceinline__ void transpose_item(const float* W, int N, int k0, int n0, bf16* WT, size_t dst_row0, int dpitch, LAS float* scr, int lane) {
#pragma unroll 8
    for (int i = 0; i < 32; ++i) { const int kk = 2 * i + (lane >> 5); scr[kk * 33 + (lane & 31)] = W[(size_t)(k0 + kk) * N + n0 + (lane & 31)]; }
    LDS_WAIT(); asm volatile("" ::: "memory");
    const int c = lane & 7;
#pragma unroll
    for (int j = 0; j < 4; ++j) { const int n = (lane >> 3) + 8 * j; const LAS float* s = scr + (8 * c) * 33 + n;
        v4u o; o.x = pk2(s[0 * 33], s[1 * 33]); o.y = pk2(s[2 * 33], s[3 * 33]); o.z = pk2(s[4 * 33], s[5 * 33]); o.w = pk2(s[6 * 33], s[7 * 33]);
        *(GAS v4u*)(WT + (dst_row0 + n) * dpitch + k0 + 8 * c) = o; }
    LDS_WAIT(); asm volatile("" ::: "memory");
}

__device__ __forceinline__ void cvt_tile64(const float* W, int N, int k0, int n0, bf16* WT, size_t dst_row0, int dpitch, int lane) {
    const int c = lane & 15, kq = lane >> 4;
    const float* src = W + (size_t)(k0 + 16 * kq) * N + n0 + 4 * c;
    f32x4 x[16];
#pragma unroll
    for (int j = 0; j < 16; ++j) x[j] = __builtin_nontemporal_load((const GAS f32x4*)(src + (size_t)j * N));
#pragma unroll
    for (int e = 0; e < 4; ++e) { bf16* dst = WT + (dst_row0 + 4 * c + e) * dpitch + k0 + 16 * kq;
        v4u o0, o1;
        o0.x = pg8::cvt_pk_bf16(x[0][e], x[1][e]); o0.y = pg8::cvt_pk_bf16(x[2][e], x[3][e]); o0.z = pg8::cvt_pk_bf16(x[4][e], x[5][e]); o0.w = pg8::cvt_pk_bf16(x[6][e], x[7][e]);
        o1.x = pg8::cvt_pk_bf16(x[8][e], x[9][e]); o1.y = pg8::cvt_pk_bf16(x[10][e], x[11][e]); o1.z = pg8::cvt_pk_bf16(x[12][e], x[13][e]); o1.w = pg8::cvt_pk_bf16(x[14][e], x[15][e]);
        *(GAS v4u*)dst = o0; *(GAS v4u*)(dst + 8) = o1; }
}

__device__ __forceinline__ unsigned pk4_fp8(float a, float b, float c, float d) { int w = 0; w = __builtin_amdgcn_cvt_pk_fp8_f32(a, b, w, false); w = __builtin_amdgcn_cvt_pk_fp8_f32(c, d, w, true); return (unsigned)w; }
__device__ __forceinline__ float clamp448(float x) { return fminf(fmaxf(x, -448.f), 448.f); }
__device__ __forceinline__ void cvt_tile64_fp8(const float* W, int N, int k0, int n0, unsigned char* WT, size_t dst_row0, int dpitch, float scale, int lane) {
    const int c = lane & 15, kq = lane >> 4;
    const float* src = W + (size_t)(k0 + 16 * kq) * N + n0 + 4 * c;
    f32x4 x[16];
#pragma unroll
    for (int j = 0; j < 16; ++j) x[j] = __builtin_nontemporal_load((const GAS f32x4*)(src + (size_t)j * N)) * scale;
#pragma unroll
    for (int e = 0; e < 4; ++e) { unsigned char* dst = WT + (dst_row0 + 4 * c + e) * dpitch + k0 + 16 * kq;
        v4u o; o.x = pk4_fp8(x[0][e], x[1][e], x[2][e], x[3][e]); o.y = pk4_fp8(x[4][e], x[5][e], x[6][e], x[7][e]); o.z = pk4_fp8(x[8][e], x[9][e], x[10][e], x[11][e]); o.w = pk4_fp8(x[12][e], x[13][e], x[14][e], x[15][e]);
        *(GAS v4u*)dst = o; }
}

__device__ __forceinline__ void phase_prologue(Frame& F) {
    const float* c = F.in[1]; const float* cctx = F.in[3]; const float* w_mod = F.in[4]; const float* b_mod = F.in[5];
    float* MODV = (float*)(F.ws + WS_MOD);
    if (F.bid < 96) {
        LAS float* sil = (LAS float*)F.lds;
        LAS float* part = (LAS float*)(F.lds + 5 * 1024 * 4);
        for (int e = F.tid; e < 5 * 1024; e += NTHR) { const int r = e >> 10, k = e & 1023; const float v = (r < 4) ? c[r * 1024 + k] : cctx[k]; sil[e] = v * sigm(v); }
        __syncthreads();
        const int col = F.bid * 64 + F.lane;
        { const int kq = F.lane >> 4, c4 = (F.lane & 15) * 4; f32x4 a4[5];
#pragma unroll
          for (int r = 0; r < 5; ++r) a4[r] = (f32x4){0.f, 0.f, 0.f, 0.f};
#pragma unroll 8
          for (int it = 0; it < 32; ++it) { const int k = F.wave * 128 + it * 4 + kq; const f32x4 w = *(const GAS f32x4*)(w_mod + (size_t)k * 6144 + F.bid * 64 + c4);
#pragma unroll
              for (int r = 0; r < 5; ++r) a4[r] += w * sil[r * 1024 + k]; }
#pragma unroll
          for (int r = 0; r < 5; ++r) {
#pragma unroll
              for (int j = 0; j < 4; ++j) { float v = a4[r][j]; v += __shfl_xor(v, 16); v += __shfl_xor(v, 32); a4[r][j] = v; }
              if (kq == 0) *(LAS f32x4*)(part + (F.wave * 5 + r) * 64 + c4) = a4[r]; } }
        __syncthreads();
        if (F.wave < 5) { float s = b_mod[col];
#pragma unroll
            for (int w = 0; w < 8; ++w) s += part[(w * 5 + F.wave) * 64 + F.lane];
            MODV[F.wave * 6144 + col] = s; }
        __syncthreads();
    }
    const int gw = F.bid * NWAVES + F.wave, NGW = F.G * NWAVES;
    bf16* WinT = (bf16*)(F.ws + WS_WIN); bf16* WpaT = (bf16*)(F.ws + WS_WPA); bf16* WprT = (bf16*)(F.ws + WS_WPR); bf16* WoT = (bf16*)(F.ws + WS_WO);
    bf16* WupT = (bf16*)(F.ws + WS_LW); bf16* AupT = WupT + 2 * 512 * 64; bf16* GupT = AupT + 2 * 512 * 64;
    constexpr int I_IN = 16 * (PIN / 64), I_PA = 8 * 16, I_PR = 8 * 16, I_O = 16 * 16, I_LW = 16 + 16 + 16, I_ALL = I_IN + I_PA + I_PR + I_O + I_LW;
    for (int it = gw; it < I_ALL; it += NGW) {
        int r = it;
        if (r < I_IN) { const int nb = PIN / 64; cvt_tile64(F.in[6], PIN, 64 * (r / nb), 64 * (r % nb), WinT, (size_t)64 * (r % nb), 1024, F.lane); continue; } r -= I_IN;
        if (r < I_PA) { cvt_tile64(F.in[20], 1024, 64 * (r / 16), 64 * (r % 16), WpaT, (size_t)64 * (r % 16), 512, F.lane); continue; } r -= I_PA;
        if (r < I_PR) { cvt_tile64(F.in[21], 1024, 64 * (r / 16), 64 * (r % 16), WprT, (size_t)64 * (r % 16), 512, F.lane); continue; } r -= I_PR;
        if (r < I_O) { cvt_tile64(F.in[22], 1024, 64 * (r / 16), 64 * (r % 16), WoT, (size_t)64 * (r % 16), 1024, F.lane); continue; } r -= I_O;
        if (r < 16) { cvt_tile64(F.in[11] + (size_t)(r >> 3) * 64 * 512, 512, 0, 64 * (r & 7), WupT + (size_t)(r >> 3) * 512 * 64, (size_t)64 * (r & 7), 64, F.lane); continue; } r -= 16;
        if (r < 16) { cvt_tile64(F.in[13] + (size_t)(r >> 3) * 64 * 512, 512, 0, 64 * (r & 7), AupT + (size_t)(r >> 3) * 512 * 64, (size_t)64 * (r & 7), 64, F.lane); continue; } r -= 16;
        cvt_tile64(F.in[14], 512, 64 * (r >> 3), 64 * (r & 7), GupT, (size_t)64 * (r & 7), 128, F.lane);
    }
    { float* tab = (float*)(F.ws + WS_ROPE); const int i = F.bid * NTHR + F.tid;
      if (i < 128 * 16) { const float ang = (float)(i >> 4) * powf(10000.0f, -(float)(i & 15) / 16.0f); float sn, cs; sincosf(ang, &sn, &cs); tab[2 * i] = cs; tab[2 * i + 1] = sn; } }
    { GAS v4u* z = (GAS v4u*)(WinT + (size_t)PIN * 1024); const int n16 = (PINP - PIN) * 1024 * 2 / 16;
      for (int i = F.bid * NTHR + F.tid; i < n16; i += F.G * NTHR) z[i] = (v4u){0u, 0u, 0u, 0u}; }
}

__device__ __forceinline__ void phase_ln_mod(Frame& F) {
    const float* MODV = (const float*)(F.ws + WS_MOD);
    bf16* U = (bf16*)(F.ws + WS_U);
    const int gw = F.bid * NWAVES + F.wave, NGW = F.G * NWAVES;
    for (int m = gw; m < MA; m += NGW) {
        const float* xrow = (m < MT) ? F.in[0] + (size_t)m * D : F.in[2] + (size_t)(m - MT) * D;
        const int mr = (m < MT) ? (m / T) : 4;
        const float* sh = MODV + mr * 6144; const float* sc = sh + 1024;
        const GAS f32x4* xr = (const GAS f32x4*)xrow + F.lane;
        f32x4 v[4]; float s = 0.f;
#pragma unroll
        for (int j = 0; j < 4; ++j) { v[j] = xr[64 * j]; s += (v[j].x + v[j].y) + (v[j].z + v[j].w); }
        const float mean = wave_sum(s) * (1.f / D); float s2 = 0.f;
#pragma unroll
        for (int j = 0; j < 4; ++j) { v[j] = v[j] - mean; s2 += (v[j].x * v[j].x + v[j].y * v[j].y) + (v[j].z * v[j].z + v[j].w * v[j].w); }
        const float rstd = 1.f / sqrtf(wave_sum(s2) * (1.f / D) + LN_EPS);
        GAS unsigned long long* o8 = (GAS unsigned long long*)(U + (size_t)m * D) + F.lane;
#pragma unroll
        for (int j = 0; j < 4; ++j) { const f32x4 a = *((const f32x4*)sc + F.lane + 64 * j), b = *((const f32x4*)sh + F.lane + 64 * j);
            const f32x4 o = v[j] * rstd * (a + 1.0f) + b;
            o8[64 * j] = (unsigned long long)pk2(o.x, o.y) | ((unsigned long long)pk2(o.z, o.w) << 32); }
    }
}

__device__ __forceinline__ void phase_rope_vt(Frame& F) {
    bf16* Z = (bf16*)(F.ws + WS_Z);
    const int gw = F.bid * NWAVES + F.wave, NGW = F.G * NWAVES;
    {
        const int fh = F.lane & 1, a = (F.lane >> 1) & 1, h = (F.lane >> 2) & 7, w = F.lane >> 5;
        const float* tab = (const float*)(F.ws + WS_ROPE);
        for (int m = gw; m < MT; m += NGW) {
            const int t = m % T; const int pos = a ? (t % GW) : (t / GW);
            bf16* p1 = Z + (size_t)m * PINP + w * 512 + h * 64 + a * 32 + fh * 8;
            float x1[8], x2[8], o1[8], o2[8];
            unpack8(*(const GAS v4u*)p1, x1); unpack8(*(const GAS v4u*)(p1 + 16), x2);
            const f32x4* tp = (const f32x4*)(tab + (size_t)(pos * 16 + fh * 8) * 2);
#pragma unroll
            for (int j2 = 0; j2 < 4; ++j2) { const f32x4 cs2 = tp[j2];
                o1[2 * j2] = x1[2 * j2] * cs2.x - x2[2 * j2] * cs2.y; o2[2 * j2] = x2[2 * j2] * cs2.x + x1[2 * j2] * cs2.y;
                o1[2 * j2 + 1] = x1[2 * j2 + 1] * cs2.z - x2[2 * j2 + 1] * cs2.w; o2[2 * j2 + 1] = x2[2 * j2 + 1] * cs2.z + x1[2 * j2 + 1] * cs2.w; }
            *(GAS v4u*)p1 = pack8(o1); *(GAS v4u*)(p1 + 16) = pack8(o2);
        }
    }
    {
        bf16* VT = (bf16*)(F.ws + WS_VT); bf16* VTC = VT + VT_LAT_ELEMS;
        LAS bf16* scr = (LAS bf16*)(F.lds + F.wave * 16384);
        constexpr int NI_LAT = (MT / 64) * 8, NI = NI_LAT + (MC / 64) * 8;
        for (int it = gw; it < NI; it += NGW) {
            const bool lat = it < NI_LAT; const int r = lat ? it : it - NI_LAT;
            const int h = r & 7, tb = r >> 3;
            const int row0 = (lat ? 0 : MT) + tb * 64;
            const int b = lat ? (tb * 64) / T : (tb * 64) / LC, t0 = lat ? (tb * 64) % T : (tb * 64) % LC;
#pragma unroll 8
            for (int i = 0; i < 32; ++i) { const int tok = 2 * i + (F.lane >> 5); const unsigned w = *(const GAS unsigned*)(Z + (size_t)(row0 + tok) * PINP + ZV + h * 64 + 2 * (F.lane & 31));
                scr[tok * 66 + 2 * (F.lane & 31)] = (bf16)(w & 0xffff); scr[tok * 66 + 2 * (F.lane & 31) + 1] = (bf16)(w >> 16); }
            LDS_WAIT(); asm volatile("" ::: "memory");
            if (lat) {
                bf16* dst = VT + ((size_t)(b * 8 + h) * (T / 4) + (t0 >> 2)) * 256;
#pragma unroll
                for (int j = 0; j < 8; ++j) { const int g = 2 * j + (F.lane >> 5), dh = 2 * (F.lane & 31); const LAS bf16* s0 = scr + (4 * g) * 66 + dh;
                    v4u o; o.x = (unsigned)s0[0] | ((unsigned)s0[66] << 16); o.y = (unsigned)s0[2 * 66] | ((unsigned)s0[3 * 66] << 16);
                    o.z = (unsigned)s0[1] | ((unsigned)s0[66 + 1] << 16); o.w = (unsigned)s0[2 * 66 + 1] | ((unsigned)s0[3 * 66 + 1] << 16);
                    *(GAS v4u*)(dst + (size_t)(j * 64 + F.lane) * 8) = o; }
            } else {
                bf16* dst = VTC + ((size_t)(b * 8 + h) * 64) * LC + t0;
                const int c = F.lane & 7;
#pragma unroll
                for (int j = 0; j < 8; ++j) { const int dh = (F.lane >> 3) + 8 * j; const LAS bf16* s = scr + (8 * c) * 66 + dh;
                    v4u o; o.x = (unsigned)s[0] | ((unsigned)s[66] << 16); o.y = (unsigned)s[2 * 66] | ((unsigned)s[3 * 66] << 16); o.z = (unsigned)s[4 * 66] | ((unsigned)s[5 * 66] << 16); o.w = (unsigned)s[6 * 66] | ((unsigned)s[7 * 66] << 16);
                    *(GAS v4u*)(dst + (size_t)dh * LC + 8 * c) = o; }
            }
            LDS_WAIT(); asm volatile("" ::: "memory");
        }
    }
}

constexpr int NA_KP = 72, NA_VP = 264;
__device__ __forceinline__ void na_wave_task(Frame& F, int task, LAS float* rpbs, const LAS bf16* ck, const LAS bf16* cvt, int ocol = ZQ) {
    bf16* Z = (bf16*)(F.ws + WS_Z);
    const bf16* VT = (const bf16*)(F.ws + WS_VT);
    const int jq = task & 3, h = (task >> 2) & 7, i = (task >> 5) & 127, b = task >> 12;
    const int rs = min(max(i - 4, 0), GH - 8);
    const int cb = (jq == 0) ? 0 : (jq == 1) ? 8 : (jq == 2) ? 24 : 32;
    const int qi = F.lane & 15, qd = F.lane >> 4;
    const int j = jq * 16 + qi, cs = min(max(j - 8, 0), GW - 16);
    const size_t qrow = (size_t)b * T + i * GW + j;
    const bf16x8 q0 = *(const GAS bf16x8*)(Z + qrow * PINP + ZQ + h * 64 + qd * 8);
    const bf16x8 q1 = *(const GAS bf16x8*)(Z + qrow * PINP + ZQ + h * 64 + 32 + qd * 8);
    f32x4 s[32];
    int bidx[2][4];
#pragma unroll
    for (int half = 0; half < 2; ++half)
#pragma unroll
        for (int jj = 0; jj < 4; ++jj) { const int c = cb + half * 16 + qd * 4 + jj; const bool ok = (c >= cs) && (c < cs + 16); bidx[half][jj] = ok ? h * 465 + (rs - i + 7) * 31 + (c - j + 15) : 8 * 465; }
    LAS bf16* kb = (LAS bf16*)(F.lds + 87040 + F.wave * 4608);
    v4u kraw[4];
#pragma unroll
    for (int ii = 0; ii < 4; ++ii) kraw[ii] = *(const GAS v4u*)(Z + ((size_t)b * T + rs * GW + cb + 8 * ii + (F.lane >> 3)) * PINP + ZK + h * 64 + (F.lane & 7) * 8);
#pragma unroll
    for (int r = 0; r < 8; ++r) {
#pragma unroll
        for (int ii = 0; ii < 4; ++ii) *(LAS v4u*)(kb + (8 * ii + (F.lane >> 3)) * NA_KP + (F.lane & 7) * 8) = kraw[ii];
        if (r < 7) {
#pragma unroll
            for (int ii = 0; ii < 4; ++ii) kraw[ii] = *(const GAS v4u*)(Z + ((size_t)b * T + (rs + r + 1) * GW + cb + 8 * ii + (F.lane >> 3)) * PINP + ZK + h * 64 + (F.lane & 7) * 8); }
#pragma unroll
        for (int half = 0; half < 2; ++half) {
            const bf16x8 k0 = *(const LAS bf16x8*)(kb + (half * 16 + qi) * NA_KP + qd * 8), k1 = *(const LAS bf16x8*)(kb + (half * 16 + qi) * NA_KP + 32 + qd * 8);
            f32x4 a = (f32x4){0.f, 0.f, 0.f, 0.f};
            a = __builtin_amdgcn_mfma_f32_16x16x32_bf16(k0, q0, a, 0, 0, 0);
            a = __builtin_amdgcn_mfma_f32_16x16x32_bf16(k1, q1, a, 0, 0, 0);
#pragma unroll
            for (int jj = 0; jj < 4; ++jj) a[jj] += rpbs[bidx[half][jj] + r * 31];
            s[2 * r + half] = a; }
        __builtin_amdgcn_sched_barrier(0);
    }
#pragma unroll
    for (int tc = 0; tc < 16; ++tc) {
        const bf16x8 k0 = *(const LAS bf16x8*)(ck + (tc * 16 + qi) * NA_KP + qd * 8);
        const bf16x8 k1 = *(const LAS bf16x8*)(ck + (tc * 16 + qi) * NA_KP + 32 + qd * 8);
        f32x4 a = (f32x4){0.f, 0.f, 0.f, 0.f};
        a = __builtin_amdgcn_mfma_f32_16x16x32_bf16(k0, q0, a, 0, 0, 0);
        a = __builtin_amdgcn_mfma_f32_16x16x32_bf16(k1, q1, a, 0, 0, 0);
        s[16 + tc] = a;
        if ((tc & 1) == 1) __builtin_amdgcn_sched_barrier(0);
    }
    float mx = -1e30f;
#pragma unroll
    for (int tl = 0; tl < 32; ++tl) mx = fmaxf(fmaxf(fmaxf(s[tl][0], s[tl][1]), fmaxf(s[tl][2], s[tl][3])), mx);
    mx = fmaxf(mx, __shfl_xor(mx, 16)); mx = fmaxf(mx, __shfl_xor(mx, 32));
    float sum = 0.f; const float esc = 0.125f * 1.44269504f, mxs = mx * esc;
#pragma unroll
    for (int tl = 0; tl < 32; ++tl) {
#pragma unroll
        for (int jj = 0; jj < 4; ++jj) { const float e = __builtin_amdgcn_exp2f(__builtin_fmaf(s[tl][jj], esc, -mxs)); s[tl][jj] = e; sum += e; } }
    sum += __shfl_xor(sum, 16); sum += __shfl_xor(sum, 32);
    const float inv = 1.0f / sum;
    f32x4 o[4];
#pragma unroll
    for (int dt = 0; dt < 4; ++dt) o[dt] = (f32x4){0.f, 0.f, 0.f, 0.f};
#pragma unroll
    for (int ks = 0; ks < 16; ++ks) {
        const f32x4 p0 = s[2 * ks], p1 = s[2 * ks + 1];
        v4u pw; pw.x = pk2(p0[0], p0[1]); pw.y = pk2(p0[2], p0[3]); pw.z = pk2(p1[0], p1[1]); pw.w = pk2(p1[2], p1[3]);
        const bf16x8 pa = __builtin_bit_cast(bf16x8, pw);
        if (ks < 8) { const bf16* vb = VT + ((size_t)(b * 8 + h) * (T / 4) + (((rs + ks) * GW + cb) >> 2) + qd) * 256;
#pragma unroll
            for (int dt = 0; dt < 4; ++dt) {
                const bf16* vp = vb + (dt * 16 + qi) * 4;
                const v2u lo = *(const GAS v2u*)vp, hi = *(const GAS v2u*)(vp + 4 * 256);
                v4u vw; vw.x = lo.x; vw.y = lo.y; vw.z = hi.x; vw.w = hi.y;
                o[dt] = __builtin_amdgcn_mfma_f32_16x16x32_bf16(pa, __builtin_bit_cast(bf16x8, vw), o[dt], 0, 0, 0); } }
        else { const LAS bf16* vb = cvt + (ks - 8) * 32 + qd * 4;
#pragma unroll
            for (int dt = 0; dt < 4; ++dt) {
                const LAS bf16* vp = vb + (dt * 16 + qi) * NA_VP;
                const v2u lo = *(const LAS v2u*)vp, hi = *(const LAS v2u*)(vp + 16);
                v4u vw; vw.x = lo.x; vw.y = lo.y; vw.z = hi.x; vw.w = hi.y;
                o[dt] = __builtin_amdgcn_mfma_f32_16x16x32_bf16(pa, __builtin_bit_cast(bf16x8, vw), o[dt], 0, 0, 0); } }
        __builtin_amdgcn_sched_barrier(0);
    }
    float invq[4];
#pragma unroll
    for (int jj = 0; jj < 4; ++jj) invq[jj] = __shfl(inv, qd * 4 + jj);
#pragma unroll
    for (int dt = 0; dt < 4; ++dt)
#pragma unroll
        for (int jj = 0; jj < 4; ++jj) Z[((size_t)b * T + i * GW + jq * 16 + qd * 4 + jj) * PINP + ocol + h * 64 + dt * 16 + qi] = (bf16)f2bf(o[dt][jj] * invq[jj]);
}

constexpr int CP = 72;
constexpr int CBUF = 9216;
__device__ __forceinline__ int swz(int row, int col) { return row * 64 + (((((col >> 3) ^ (row >> 1) ^ ((row & 1) << 2)) & 7) << 3) | (col & 7)); }
constexpr int NCHK = (LC + T) / 64;
constexpr size_t PQ_UNIT = 16384, RY_UNIT = 16384;
constexpr int LDS_TOT = 15 * CBUF, LDS_CLE = LDS_TOT + 2048, LDS_MU = LDS_CLE + 256 + 2048;
#define CB(i) ((LAS bf16*)(F.lds + (i) * CBUF))
__device__ __forceinline__ bf16x8 ldsfrag(const LAS bf16* base, int row, int col) { return *(const LAS bf16x8*)(base + swz(row, col)); }
template <int MODE = 0> __device__ __forceinline__ void mm2(const LAS bf16* X, const LAS bf16* Y, int mt0, int nt, int r, int q, f32x4 (&acc)[2]) {
    if (MODE == 1) return;
    const bf16x8 y0 = ldsfrag(Y, 16 * nt + r, 8 * q), y1 = ldsfrag(Y, 16 * nt + r, 32 + 8 * q);
#pragma unroll
    for (int t = 0; t < 2; ++t) { const bf16x8 x0 = ldsfrag(X, 16 * (mt0 + t) + r, 8 * q), x1 = ldsfrag(X, 16 * (mt0 + t) + r, 32 + 8 * q);
        acc[t] = __builtin_amdgcn_mfma_f32_16x16x32_bf16(x0, y0, acc[t], 0, 0, 0); acc[t] = __builtin_amdgcn_mfma_f32_16x16x32_bf16(x1, y1, acc[t], 0, 0, 0); }
}
struct FragX { bf16x8 a[2][2]; };
struct FragY { bf16x8 b[2]; };
template <int MODE = 0> __device__ __forceinline__ FragX ldX(const LAS bf16* X, int mt0, int r, int q) { FragX f;
#pragma unroll
    for (int t = 0; t < 2; ++t) { if (MODE == 1) { f.a[t][0] = f.a[t][1] = (bf16x8){0, 0, 0, 0, 0, 0, 0, 0}; } else { f.a[t][0] = ldsfrag(X, 16 * (mt0 + t) + r, 8 * q); f.a[t][1] = ldsfrag(X, 16 * (mt0 + t) + r, 32 + 8 * q); } }
    return f; }
template <int MODE = 0> __device__ __forceinline__ FragY ldY(const LAS bf16* Y, int nt, int r, int q) { FragY f;
    if (MODE == 1) { f.b[0] = f.b[1] = (bf16x8){0, 0, 0, 0, 0, 0, 0, 0}; } else { f.b[0] = ldsfrag(Y, 16 * nt + r, 8 * q); f.b[1] = ldsfrag(Y, 16 * nt + r, 32 + 8 * q); }
    return f; }
template <int MODE = 0> __device__ __forceinline__ void mmf(const FragX& x, const FragY& y, f32x4 (&acc)[2]) {
    if (MODE == 1) return;
#pragma unroll
    for (int k = 0; k < 2; ++k)
#pragma unroll
        for (int t = 0; t < 2; ++t) acc[t] = __builtin_amdgcn_mfma_f32_16x16x32_bf16(x.a[t][k], y.b[k], acc[t], 0, 0, 0);
}
__device__ __forceinline__ v2u pack4(f32x4 v) { v2u o; o.x = pg8::cvt_pk_bf16(v[0], v[1]); o.y = pg8::cvt_pk_bf16(v[2], v[3]); return o; }
__device__ __forceinline__ f32x4 unpack4(v2u w) { return (f32x4){bflo(w.x), bfhi(w.x), bflo(w.y), bfhi(w.y)}; }
__device__ __forceinline__ void stT(LAS bf16* O, int mt, int nt, int r, int q, f32x4 v) { *(LAS v2u*)(O + swz(16 * nt + r, 16 * mt + 4 * q)) = pack4(v); }
__device__ __forceinline__ void stR(LAS bf16* O, int mt, int nt, int r, int q, f32x4 v) {
#pragma unroll
    for (int jj = 0; jj < 4; ++jj) O[swz(16 * mt + 4 * q + jj, 16 * nt + r)] = (bf16)f2bf(v[jj]); }
__device__ __forceinline__ f32x4 ldT(const LAS bf16* O, int mt, int nt, int r, int q) { return unpack4(*(const LAS v2u*)(O + swz(16 * nt + r, 16 * mt + 4 * q))); }
#define Z2 {(f32x4){0.f, 0.f, 0.f, 0.f}, (f32x4){0.f, 0.f, 0.f, 0.f}}
__device__ __forceinline__ float tanh_fast(float x) { return 1.0f - 2.0f * __builtin_amdgcn_rcpf(1.0f + __expf(2.0f * x)); }
__device__ __forceinline__ bf16 f2bf_hw(float x) { return (bf16)(pg8::cvt_pk_bf16(x, x) & 0xffffu); }
__device__ __forceinline__ void shift8(const bf16* zp, bool hasp, bool hasn, const float* mup, const float* mun, float (&o)[8]) {
    float z[8], a[8], b[8];
    unpack8(*(const GAS v4u*)zp, z);
    unpack8(hasp ? *(const GAS v4u*)(zp - PINP) : (v4u){0u, 0u, 0u, 0u}, a);
    unpack8(hasn ? *(const GAS v4u*)(zp + PINP) : (v4u){0u, 0u, 0u, 0u}, b);
    const f32x4 p0 = *(const f32x4*)mup, p1 = *(const f32x4*)(mup + 4), n0 = *(const f32x4*)mun, n1 = *(const f32x4*)(mun + 4);
#pragma unroll
    for (int e = 0; e < 8; ++e) { const float mp = e < 4 ? p0[e & 3] : p1[e & 3], mn = e < 4 ? n0[e & 3] : n1[e & 3]; o[e] = z[e] + mp * (a[e] - z[e]) + mn * (b[e] - z[e]); }
}
__device__ __forceinline__ void shift8u(const char* zu, unsigned zo, bool hasp, bool hasn, const char* mup, const char* mun, unsigned mo, float (&o)[8]) {
    float z[8], a[8], b[8];
    unpack8(*(const GAS v4u*)(zu + zo), z);
    unpack8(hasp ? *(const GAS v4u*)(zu - PINP * 2 + zo) : (v4u){0u, 0u, 0u, 0u}, a);
    unpack8(hasn ? *(const GAS v4u*)(zu + PINP * 2 + zo) : (v4u){0u, 0u, 0u, 0u}, b);
    const f32x4 p0 = *(const GAS f32x4*)(mup + mo), p1 = *(const GAS f32x4*)(mup + 16 + mo), n0 = *(const GAS f32x4*)(mun + mo), n1 = *(const GAS f32x4*)(mun + 16 + mo);
#pragma unroll
    for (int e = 0; e < 8; ++e) { const float mp = e < 4 ? p0[e & 3] : p1[e & 3], mn = e < 4 ? n0[e & 3] : n1[e & 3]; o[e] = z[e] + mp * (a[e] - z[e]) + mn * (b[e] - z[e]); }
}
__device__ __forceinline__ void shift8l(const char* zu, unsigned zo, bool hasp, bool hasn, const LAS float* mup, const LAS float* mun, float (&o)[8]) {
    float z[8], a[8], b[8];
    unpack8(*(const GAS v4u*)(zu + zo), z);
    unpack8(hasp ? *(const GAS v4u*)(zu - PINP * 2 + zo) : (v4u){0u, 0u, 0u, 0u}, a);
    unpack8(hasn ? *(const GAS v4u*)(zu + PINP * 2 + zo) : (v4u){0u, 0u, 0u, 0u}, b);
    const f32x4 p0 = *(const LAS f32x4*)mup, p1 = *(const LAS f32x4*)(mup + 4), n0 = *(const LAS f32x4*)mun, n1 = *(const LAS f32x4*)(mun + 4);
#pragma unroll
    for (int e = 0; e < 8; ++e) { const float mp = e < 4 ? p0[e & 3] : p1[e & 3], mn = e < 4 ? n0[e & 3] : n1[e & 3]; o[e] = z[e] + mp * (a[e] - z[e]) + mn * (b[e] - z[e]); }
}
struct Raw3 { v4u z, a, b; };
__device__ __forceinline__ void dma_tile(const char* gbase, unsigned zo, unsigned lds_tile, int wave, int lane) {
    const unsigned m0a = lds_tile + (unsigned)wave * 1024u;
    asm volatile("s_mov_b32 m0, %0\n\ts_nop 0\n\tglobal_load_lds_dwordx4 %1, %2" :: "s"(m0a), "v"(zo), "s"(gbase) : "memory", "m0");
    if (wave == 0) { if (lane < 16) { const char* g2 = gbase + (size_t)64 * PINP * 2; const unsigned m0b = lds_tile + 8192u;
        asm volatile("s_mov_b32 m0, %0\n\ts_nop 0\n\tglobal_load_lds_dwordx4 %1, %2" :: "s"(m0b), "v"(zo), "s"(g2) : "memory", "m0"); } }
}
__device__ __forceinline__ Raw3 rd3(const LAS unsigned char* tile, int t1, int k8) { Raw3 w; const LAS unsigned char* p = tile + t1 * 128 + k8 * 2;
    w.a = *(const LAS v4u*)p; w.z = *(const LAS v4u*)(p + 128); w.b = *(const LAS v4u*)(p + 256); return w; }
__device__ __forceinline__ Raw3 ld3(const char* zu, unsigned zo) { Raw3 w; w.z = *(const GAS v4u*)(zu + zo); w.a = *(const GAS v4u*)(zu - PINP * 2 + zo); w.b = *(const GAS v4u*)(zu + PINP * 2 + zo); return w; }
__device__ __forceinline__ void mix8(const Raw3& w, bool hasp, bool hasn, const LAS float* mup, const LAS float* mun, float (&o)[8]) {
    float z[8], a[8], b[8];
    unpack8(w.z, z); unpack8(hasp ? w.a : (v4u){0u, 0u, 0u, 0u}, a); unpack8(hasn ? w.b : (v4u){0u, 0u, 0u, 0u}, b);
    const f32x4 p0 = *(const LAS f32x4*)mup, p1 = *(const LAS f32x4*)(mup + 4), n0 = *(const LAS f32x4*)mun, n1 = *(const LAS f32x4*)(mun + 4);
#pragma unroll
    for (int e = 0; e < 8; ++e) { const float mp = e < 4 ? p0[e & 3] : p1[e & 3], mn = e < 4 ? n0[e & 3] : n1[e & 3]; o[e] = z[e] + mp * (a[e] - z[e]) + mn * (b[e] - z[e]); }
}
#define VMW(n) asm volatile("s_waitcnt vmcnt(" #n ")" ::: "memory")
__device__ __forceinline__ float sum8(float v) { v += dppf<0xB1>(v); v += dppf<0x4E>(v); v += dppf<0x141>(v); return v; }

__device__ __forceinline__ int afrag_off(int row, int col) { return ((((row >> 4) * 2 + (col >> 5)) * 64 + ((col >> 2) & 3) * 16 + (row & 15)) << 3) + ((col >> 4) & 1) * 4 + (col & 3); }
__device__ __forceinline__ int cfrag_off(int n, int m) { return ((((n >> 4) * 4 + (m >> 4)) * 64 + ((m >> 2) & 3) * 16 + (n & 15)) << 2) + (m & 3); }
template <int MODE> __device__ __forceinline__ void rwkvA_unit(Frame& F, int u, int& hl, int pre, int un) {
    int lane_ = F.lane, tid_ = F.tid; asm volatile("" : "+v"(lane_), "+v"(tid_));
    const bf16* Z = (const bf16*)(F.ws + WS_Z);
    const bf16* WupT = (const bf16*)(F.ws + WS_LW); const bf16* AupT = WupT + 2 * 512 * 64; const bf16* GupT = AupT + 2 * 512 * 64;
    const int h = u & 7, bt = u >> 3, b = bt / NCHK, blk = bt % NCHK; const bool isctx = blk < 4;
    const int seqlen = isctx ? LC : T, s0 = (isctx ? blk : blk - 4) * 64;
    const size_t row0 = (isctx ? (size_t)MT + b * LC : (size_t)b * T) + s0;
    const int ti = lane_, c8 = F.wave * 8;
    const int r = lane_ & 15, q = lane_ >> 4, nt = F.wave & 3, mt0 = 2 * (F.wave >> 2);
    const int sp = s0 + ti; const bool hasp = sp > 0, hasn = sp < seqlen - 1;
    const bf16* zrow = Z + (row0 + ti) * PINP;
    const int t1 = tid_ >> 3, k8 = (tid_ & 7) * 8; const int sp1 = s0 + t1; const bool hasp1 = sp1 > 0, hasn1 = sp1 < seqlen - 1;
    const char* Zu = (const char*)(Z + row0 * PINP); const unsigned zo = (unsigned)((t1 * PINP + k8) * 2), mo = (unsigned)(k8 * 4);
    LAS float* RSs = (LAS float*)(F.lds + 4 * CBUF); LAS float* KSs = RSs + 64 * 68; LAS bf16* VSs = (LAS bf16*)(F.lds + 4 * CBUF + 2 * 64 * 68 * 4);
    LAS float* ssp = (LAS float*)(F.lds + LDS_CLE + 256);
    const LAS float* mpL = (const LAS float*)(F.lds + LDS_MU); const LAS float* mnL = mpL + 384;
    LAS float* mpR = (LAS float*)(F.lds + 0 * CBUF + 8192); LAS float* mnR = (LAS float*)(F.lds + 1 * CBUF + 8192);
    if (h != hl) { hl = h; if (tid_ < 192) { const int gi = (tid_ >> 6) * 512 + h * 64 + (tid_ & 63); mpR[tid_] = F.in[8][gi]; mnR[tid_] = F.in[9][gi]; } __syncthreads(); }
    const unsigned ldsb = (unsigned)(size_t)F.lds;
    const char* Zm = Zu - PINP * 2;
    if (pre < 0) { dma_tile(Zm + (ZR + h * 64) * 2, zo, ldsb + 10 * CBUF, F.wave, lane_); dma_tile(Zm + (ZRK + h * 64) * 2, zo, ldsb + 11 * CBUF, F.wave, lane_); dma_tile(Zm + (ZRV + h * 64) * 2, zo, ldsb + 14 * CBUF, F.wave, lane_); VMW(0); }
    else if (pre == 4) VMW(4); else VMW(8);
    __syncthreads();
    dma_tile(Zm + ZLORA * 2, zo, ldsb + 9 * CBUF, F.wave, lane_); dma_tile(Zm + (ZLORA + 128) * 2, zo, ldsb + 12 * CBUF, F.wave, lane_); dma_tile(Zm + (ZLORA + 256) * 2, zo, ldsb + 13 * CBUF, F.wave, lane_);
    { float x[8], y[8];
      mix8(rd3(F.lds + 10 * CBUF, t1, k8), hasp1, hasn1, mpR + k8, mnR + k8, x);
      *(LAS f32x4*)(RSs + t1 * 68 + k8) = (f32x4){x[0], x[1], x[2], x[3]}; *(LAS f32x4*)(RSs + t1 * 68 + k8 + 4) = (f32x4){x[4], x[5], x[6], x[7]};
      mix8(rd3(F.lds + 11 * CBUF, t1, k8), hasp1, hasn1, mpR + 64 + k8, mnR + 64 + k8, y);
      *(LAS f32x4*)(KSs + t1 * 68 + k8) = (f32x4){y[0], y[1], y[2], y[3]}; *(LAS f32x4*)(KSs + t1 * 68 + k8 + 4) = (f32x4){y[4], y[5], y[6], y[7]};
      float ss = 0.f;
#pragma unroll
      for (int e = 0; e < 8; ++e) { const float kv = y[e] * F.in[15][h * 64 + k8 + e]; ss += kv * kv; }
      ss = sum8(ss); if ((tid_ & 7) == 0) ssp[t1] = 1.0f / sqrtf(ss + 1e-12f);
      mix8(rd3(F.lds + 14 * CBUF, t1, k8), hasp1, hasn1, mpR + 128 + k8, mnR + 128 + k8, x);
      *(LAS v4u*)(VSs + t1 * CP + k8) = pack8(x); }
    VMW(0); __syncthreads();
    float rs[8], ks[8], rn = 0.f; v4u vsp = {0u, 0u, 0u, 0u};
    LAS float* lwT = (LAS float*)(F.lds + 10 * CBUF);
    LAS float* aT = (LAS float*)(F.lds + 10 * CBUF + 64 * 68 * 4);
    LAS float* tot = (LAS float*)(F.lds + LDS_TOT); LAS float* cle = (LAS float*)(F.lds + LDS_CLE);
#pragma unroll 1
    for (int d = 0; d < 2; ++d) {
        const int ip = d ? 63 - ti : ti;
        const int chunk_p = isctx ? (d ? 3 - blk : blk) : (d ? 4 + (131 - blk) : blk);
        const bf16* wy = WupT + ((size_t)(d * 512 + h * 64 + 16 * nt + r)) * 64 + 8 * q; const bf16* ay = AupT + ((size_t)(d * 512 + h * 64 + 16 * nt + r)) * 64 + 8 * q;
        const bf16x8 wy0 = *(const GAS bf16x8*)wy, wy1 = *(const GAS bf16x8*)(wy + 32), ay0 = *(const GAS bf16x8*)ay, ay1 = *(const GAS bf16x8*)(ay + 32);
        const float w0v = F.in[10][d * 512 + h * 64 + 16 * nt + r], a0v = F.in[12][d * 512 + h * 64 + 16 * nt + r];
        { float x[8]; const int ip1 = d ? 63 - t1 : t1;
          Raw3 gB; if (d == 0) gB = ld3(Zu + (ZLORA + 256 + 64) * 2, zo);
          mix8(rd3(F.lds + (d ? 10 : 9) * CBUF, t1, k8), hasp1, hasn1, mpL + d * 64 + k8, mnL + d * 64 + k8, x);
#pragma unroll
          for (int e = 0; e < 8; ++e) x[e] = tanh_fast(x[e]);
          *(LAS v4u*)(CB(0) + swz(ip1, k8)) = pack8(x);
          mix8(rd3(F.lds + (d ? 11 : 12) * CBUF, t1, k8), hasp1, hasn1, mpL + 128 + d * 64 + k8, mnL + 128 + d * 64 + k8, x);
          *(LAS v4u*)(CB(1) + swz(ip1, k8)) = pack8(x);
          if (d == 0) {
              mix8(rd3(F.lds + 13 * CBUF, t1, k8), hasp1, hasn1, mpL + 256 + k8, mnL + 256 + k8, x);
#pragma unroll
              for (int e = 0; e < 8; ++e) x[e] = sigm(x[e]);
              *(LAS v4u*)(CB(2) + t1 * 144 + k8) = pack8(x);
              mix8(gB, hasp1, hasn1, mpL + 256 + 64 + k8, mnL + 256 + 64 + k8, x);
#pragma unroll
              for (int e = 0; e < 8; ++e) x[e] = sigm(x[e]);
              *(LAS v4u*)(CB(2) + t1 * 144 + 64 + k8) = pack8(x); } }
        __syncthreads();
        if (MODE == 5) { __syncthreads(); continue; }
        { f32x4 aw[2] = Z2, aa[2] = Z2;
          { const FragX xw = ldX<0>(CB(0), mt0, r, q), xa = ldX<0>(CB(1), mt0, r, q); FragY yw, ya; yw.b[0] = wy0; yw.b[1] = wy1; ya.b[0] = ay0; ya.b[1] = ay1;
            __builtin_amdgcn_sched_barrier(0);
            mmf<0>(xw, yw, aw); mmf<0>(xa, ya, aa); }
          const int c = 16 * nt + r;
#pragma unroll
          for (int t = 0; t < 2; ++t) { f32x4 lw, av;
#pragma unroll
              for (int jj = 0; jj < 4; ++jj) { lw[jj] = -0.60653066f * sigm(aw[t][jj] + w0v); av[jj] = sigm(aa[t][jj] + a0v); }
              *(LAS f32x4*)(lwT + c * 68 + 16 * (mt0 + t) + 4 * q) = lw; *(LAS f32x4*)(aT + c * 68 + 16 * (mt0 + t) + 4 * q) = av; }
          if (d == 0) { bf16x8 gyv[4]; { const bf16* gy = GupT + ((size_t)(h * 64 + 16 * nt + r)) * 128 + 8 * q;
#pragma unroll
              for (int k4 = 0; k4 < 4; ++k4) gyv[k4] = *(const GAS bf16x8*)(gy + 32 * k4); }
              f32x4 ag[2] = Z2;
#pragma unroll
              for (int kp = 0; kp < 2; ++kp) { bf16x8 xg[2][2];
#pragma unroll
                  for (int t = 0; t < 2; ++t)
#pragma unroll
                      for (int k2 = 0; k2 < 2; ++k2) xg[t][k2] = *(const LAS bf16x8*)(CB(2) + (16 * (mt0 + t) + r) * 144 + 32 * (2 * kp + k2) + 8 * q);
                  __builtin_amdgcn_sched_barrier(0);
#pragma unroll
                  for (int k2 = 0; k2 < 2; ++k2)
#pragma unroll
                      for (int t = 0; t < 2; ++t) ag[t] = __builtin_amdgcn_mfma_f32_16x16x32_bf16(gyv[2 * kp + k2], xg[t][k2], ag[t], 0, 0, 0); }
              if (!isctx) { bf16* G = (bf16*)(F.ws + WS_G);
#pragma unroll
                  for (int t = 0; t < 2; ++t) *(GAS v2u*)(G + (row0 + 16 * (mt0 + t) + r) * 512 + h * 64 + 16 * nt + 4 * q) = pack4(ag[t]); } } }
        __syncthreads();
        if (MODE == 4) { __syncthreads(); continue; }
        { const int c = tid_ & 63, g = tid_ >> 6; LAS float* p = lwT + c * 68 + 8 * g;
          f32x4 v0 = *(LAS f32x4*)p, v1 = *(LAS f32x4*)(p + 4);
          v0[1] += v0[0]; v0[2] += v0[1]; v0[3] += v0[2]; v1[0] += v0[3]; v1[1] += v1[0]; v1[2] += v1[1]; v1[3] += v1[2];
          tot[g * 64 + c] = v1[3];
          __syncthreads();
          float base = 0.f;
#pragma unroll
          for (int g2 = 0; g2 < 7; ++g2) base += (g2 < g) ? tot[g2 * 64 + c] : 0.f;
          v0 += base; v1 += base; *(LAS f32x4*)p = v0; *(LAS f32x4*)(p + 4) = v1;
          if (g == 7) cle[c] = v1[3]; }
        __syncthreads();
        { float at[8], btv[8], kt[8], rt[8]; float cf = 0.f;
          if (d == 0) { const f32x4 r0 = *(const LAS f32x4*)(RSs + ti * 68 + c8), r1 = *(const LAS f32x4*)(RSs + ti * 68 + c8 + 4), k0 = *(const LAS f32x4*)(KSs + ti * 68 + c8), k1 = *(const LAS f32x4*)(KSs + ti * 68 + c8 + 4);
              vsp = *(const LAS v4u*)(VSs + ti * CP + c8); rn = ssp[ti];
#pragma unroll
              for (int e = 0; e < 8; ++e) { rs[e] = e < 4 ? r0[e & 3] : r1[e & 3]; ks[e] = e < 4 ? k0[e & 3] : k1[e & 3]; }
              __syncthreads(); }
          float vs[8]; unpack8(vsp, vs);
#pragma unroll
          for (int e = 0; e < 8; ++e) { const int c = c8 + e; const float cl = lwT[c * 68 + ip], clp = ip > 0 ? lwT[c * 68 + ip - 1] : 0.f, a = aT[c * 68 + ip], ce = cle[c];
              const float G = __expf(cl), iG = __expf(-cl), Gex = __expf(clp), GeG = __expf(ce - cl);
              const float kke = ks[e] * F.in[15][h * 64 + c] * rn;
              const float km = ks[e] * (1.0f + (a - 1.0f) * F.in[16][h * 64 + c]), kb = kke * a;
              at[e] = -kke * Gex; btv[e] = kb * iG; kt[e] = km * iG; rt[e] = rs[e] * G;
              { const int so = swz(c, ip); CB(4)[so] = f2bf_hw(at[e]); CB(5)[so] = f2bf_hw(kb * GeG); CB(6)[so] = f2bf_hw(km * GeG); CB(7)[so] = f2bf_hw(vs[e]); }
              cf += rs[e] * km * F.in[17][h * 64 + c]; }
          { const int so = swz(ip, c8); *(LAS v4u*)(CB(0) + so) = pack8(at); *(LAS v4u*)(CB(1) + so) = pack8(btv); *(LAS v4u*)(CB(2) + so) = pack8(kt); *(LAS v4u*)(CB(3) + so) = pack8(rt); }
          ssp[F.wave * 64 + ti] = cf; }
        __syncthreads();
        if (!isctx && F.wave == 0) { float cf = 0.f;
#pragma unroll
            for (int w = 0; w < 8; ++w) cf += ssp[w * 64 + ti];
            ((float*)(F.ws + WS_COEF))[(row0 + ti) * 16 + h * 2 + d] = cf; }
        if (MODE == 3) { __syncthreads(); continue; }
        { f32x4 pN[2] = Z2, pLak[2] = Z2, pMrb[2] = Z2, pMrk[2] = Z2;
          { const FragX x1 = ldX<MODE>(CB(1), mt0, r, q), x2 = ldX<MODE>(CB(2), mt0, r, q); const FragY y0 = ldY<MODE>(CB(0), nt, r, q), y3 = ldY<MODE>(CB(3), nt, r, q);
            __builtin_amdgcn_sched_barrier(0);
            mmf<MODE>(x1, y0, pN); mmf<MODE>(x2, y0, pLak); mmf<MODE>(x1, y3, pMrb); mmf<MODE>(x2, y3, pMrk); }
          __builtin_amdgcn_sched_barrier(0);
          const int n = 16 * nt + r;
#pragma unroll
          for (int t = 0; t < 2; ++t) { f32x4 t0;
#pragma unroll
              for (int jj = 0; jj < 4; ++jj) { const int m = 16 * (mt0 + t) + 4 * q + jj;
                  pN[t][jj] = (m < n) ? pN[t][jj] : 0.f; t0[jj] = pN[t][jj] + ((m == n) ? 1.0f : 0.f);
                  pLak[t][jj] = (m < n) ? pLak[t][jj] : 0.f; pMrb[t][jj] = (m <= n) ? pMrb[t][jj] : 0.f; pMrk[t][jj] = (m <= n) ? pMrk[t][jj] : 0.f; }
              stT(CB(8), mt0 + t, nt, r, q, pN[t]); stT(CB(10), mt0 + t, nt, r, q, t0); stR(CB(9), mt0 + t, nt, r, q, pN[t]);
              stT(CB(11), mt0 + t, nt, r, q, pLak[t]); stT(CB(12), mt0 + t, nt, r, q, pMrb[t]); stT(CB(13), mt0 + t, nt, r, q, pMrk[t]); } }
        __syncthreads();
#define SQ_ST(a1, ONT_, ON_) do { _Pragma("unroll") for (int t = 0; t < 2; ++t) { stT(CB(ONT_), mt0 + t, nt, r, q, a1[t]); if ((ON_) >= 0) stR(CB((ON_) < 0 ? 0 : (ON_)), mt0 + t, nt, r, q, a1[t]); } } while (0)
#define TSQ_STAGE(NTB_, TOLD_, TNEW_, NB_, NTB2_, ONT_, ON_) do { f32x4 a3[2], a1[2] = Z2; \
            const FragX xt = ldX<MODE>(CB(NTB_), mt0, r, q); const FragY yt = ldY<MODE>(CB(TOLD_), nt, r, q); a3[0] = ldT(CB(TOLD_), mt0, nt, r, q); a3[1] = ldT(CB(TOLD_), mt0 + 1, nt, r, q); \
            const FragX xs = ldX<MODE>(CB(NB_), mt0, r, q); const FragY ys = ldY<MODE>(CB(NTB2_), nt, r, q); \
            __builtin_amdgcn_sched_barrier(0); \
            mmf<MODE>(xt, yt, a3); mmf<MODE>(xs, ys, a1); \
            __builtin_amdgcn_sched_barrier(0); \
            _Pragma("unroll") for (int t = 0; t < 2; ++t) stT(CB(TNEW_), mt0 + t, nt, r, q, a3[t]); \
            SQ_ST(a1, ONT_, ON_); } while (0)
        { f32x4 w1[2] = Z2, a1[2] = Z2;
          { const FragX xw = ldX<MODE>(CB(11), mt0, r, q), xs = ldX<MODE>(CB(8), mt0, r, q); const FragY yw = ldY<MODE>(CB(7), nt, r, q), ys = ldY<MODE>(CB(9), nt, r, q);
            __builtin_amdgcn_sched_barrier(0);
            mmf<MODE>(xw, yw, w1); mmf<MODE>(xs, ys, a1); }
          __builtin_amdgcn_sched_barrier(0);
          stT(CB(14), mt0, nt, r, q, w1[0]); stT(CB(14), mt0 + 1, nt, r, q, w1[1]); SQ_ST(a1, 0, 1); }
        __syncthreads();
        TSQ_STAGE(0, 10, 2, 1, 0, 8, 9);   __syncthreads();
        TSQ_STAGE(8, 2, 10, 9, 8, 0, 1);   __syncthreads();
        TSQ_STAGE(0, 10, 2, 1, 0, 8, 9);   __syncthreads();
        TSQ_STAGE(8, 2, 10, 9, 8, 0, -1);  __syncthreads();
        { f32x4 a3[2]; const FragX xt = ldX<MODE>(CB(0), mt0, r, q); const FragY yt = ldY<MODE>(CB(10), nt, r, q); a3[0] = ldT(CB(10), mt0, nt, r, q); a3[1] = ldT(CB(10), mt0 + 1, nt, r, q);
          __builtin_amdgcn_sched_barrier(0);
          mmf<MODE>(xt, yt, a3); stT(CB(2), mt0, nt, r, q, a3[0]); stT(CB(2), mt0 + 1, nt, r, q, a3[1]); }
        __syncthreads();
        if (d == 0) { dma_tile(Zm + (ZLORA + 64) * 2, zo, ldsb + 10 * CBUF, F.wave, lane_); dma_tile(Zm + (ZLORA + 128 + 64) * 2, zo, ldsb + 11 * CBUF, F.wave, lane_); }
        { f32x4 w2[2] = Z2, ah[2] = Z2;
          { const FragX xT = ldX<MODE>(CB(2), mt0, r, q); const FragY y14 = ldY<MODE>(CB(14), nt, r, q), y4 = ldY<MODE>(CB(4), nt, r, q);
            __builtin_amdgcn_sched_barrier(0);
            mmf<MODE>(xT, y14, w2); mmf<MODE>(xT, y4, ah); }
#pragma unroll
          for (int t = 0; t < 2; ++t) { stT(CB(8), mt0 + t, nt, r, q, w2[t]); stT(CB(9), mt0 + t, nt, r, q, ah[t]); } }
        __syncthreads();
        if (d == 1 && un >= 0) { const int hn = un & 7, btn = un >> 3, bn = btn / NCHK, blkn = btn % NCHK;
            const size_t rown = (blkn < 4 ? (size_t)MT + bn * LC + blkn * 64 : (size_t)bn * T + (blkn - 4) * 64);
            const char* zn = (const char*)(Z + (rown - 1) * PINP);
            dma_tile(zn + (ZR + hn * 64) * 2, zo, ldsb + 10 * CBUF, F.wave, lane_); dma_tile(zn + (ZRK + hn * 64) * 2, zo, ldsb + 11 * CBUF, F.wave, lane_); dma_tile(zn + (ZRV + hn * 64) * 2, zo, ldsb + 14 * CBUF, F.wave, lane_); }
        { const size_t ud = ((size_t)((b * 8 + h) * 2 + d)) * NCHK + chunk_p;
          bf16* Pg = (bf16*)(F.ws + WS_PQ + ud * PQ_UNIT); bf16* Qg = Pg + 4096;
          f32x4 pP[2] = Z2, pQ[2] = Z2;
          { const FragX x9 = ldX<MODE>(CB(9), mt0, r, q), x5 = ldX<MODE>(CB(5), mt0, r, q), x6 = ldX<MODE>(CB(6), mt0, r, q); const FragY y5 = ldY<MODE>(CB(5), nt, r, q), y8 = ldY<MODE>(CB(8), nt, r, q), y7 = ldY<MODE>(CB(7), nt, r, q);
            __builtin_amdgcn_sched_barrier(0);
            mmf<MODE>(x9, y5, pP); mmf<MODE>(x5, y8, pQ); mmf<MODE>(x6, y7, pQ); }
          __builtin_amdgcn_sched_barrier(0);
          const int n = 16 * nt + r; const float ge = __expf(cle[n]);
#pragma unroll
          for (int t = 0; t < 2; ++t) {
#pragma unroll
              for (int jj = 0; jj < 4; ++jj) { const int m = 16 * (mt0 + t) + 4 * q + jj; pP[t][jj] += (m == n) ? ge : 0.f; }
              *(GAS v2u*)(Pg + afrag_off(n, 16 * (mt0 + t) + 4 * q)) = pack4(pP[t]); *(GAS v2u*)(Qg + cfrag_off(n, 16 * (mt0 + t) + 4 * q)) = pack4(pQ[t]); }
          if (!isctx) { const size_t ul = ((size_t)((b * 8 + h) * 2 + d)) * 128 + (chunk_p - 4);
              bf16* Rg = (bf16*)((unsigned char*)F.out + ul * RY_UNIT); bf16* Yg = Rg + 4096;
              f32x4 pR[2], pY[2] = Z2; pR[0] = ldT(CB(3), mt0, nt, r, q); pR[1] = ldT(CB(3), mt0 + 1, nt, r, q);
              { const FragX x9 = ldX<MODE>(CB(9), mt0, r, q), x12 = ldX<MODE>(CB(12), mt0, r, q), x13 = ldX<MODE>(CB(13), mt0, r, q); const FragY y12 = ldY<MODE>(CB(12), nt, r, q), y8 = ldY<MODE>(CB(8), nt, r, q), y7 = ldY<MODE>(CB(7), nt, r, q);
                __builtin_amdgcn_sched_barrier(0);
                mmf<MODE>(x9, y12, pR); mmf<MODE>(x12, y8, pY); mmf<MODE>(x13, y7, pY); }
              __builtin_amdgcn_sched_barrier(0);
#pragma unroll
              for (int t = 0; t < 2; ++t) {
                  *(GAS v2u*)(Rg + afrag_off(d ? 63 - n : n, 16 * (mt0 + t) + 4 * q)) = pack4(pR[t]);
                  if (d) { const f32x4 rv = {pY[t][3], pY[t][2], pY[t][1], pY[t][0]}; *(GAS v2u*)(Yg + cfrag_off(n, 60 - 16 * (mt0 + t) - 4 * q)) = pack4(rv); }
                  else *(GAS v2u*)(Yg + cfrag_off(n, 16 * (mt0 + t) + 4 * q)) = pack4(pY[t]); } } }
        if (d == 0) { if (isctx) VMW(4); else VMW(8); }
        __syncthreads();
    }
#undef SQ_ST
#undef TSQ_STAGE
}

struct BSetPQ { v4u p[8]; v2u qv[4]; };
constexpr size_t XC_UNIT = 2048;
__device__ __forceinline__ void rwkvB_task(Frame& F, int task) {
    const int vsl = task & 3, chain = task >> 2;
    const int r = F.lane & 15, q = F.lane >> 4;
    const unsigned char* PQ = F.ws + WS_PQ + (size_t)chain * NCHK * PQ_UNIT;
    unsigned char* XC = F.ws + WS_YFB + ((size_t)chain * 128 * 4 + vsl) * XC_UNIT;
    f32x4 X[4];
#pragma unroll
    for (int i = 0; i < 4; ++i) X[i] = (f32x4){0.f, 0.f, 0.f, 0.f};
#define B_LOADPQ(S, c_) do { const int _c = (c_) < NCHK ? (c_) : NCHK - 1; const bf16* _P = (const bf16*)(PQ + (size_t)_c * PQ_UNIT); const bf16* _Q = _P + 4096; \
        _Pragma("unroll") for (int mt = 0; mt < 4; ++mt) { S.qv[mt] = *(const GAS v2u*)(_Q + (((vsl * 4 + mt) * 64 + F.lane) << 2)); \
            _Pragma("unroll") for (int ks = 0; ks < 2; ++ks) S.p[mt * 2 + ks] = *(const GAS v4u*)(_P + (((mt * 2 + ks) * 64 + F.lane) << 3)); } } while (0)
#define B_STEP(S, c_) do { const int _c = (c_); bf16x8 xb[2]; \
        _Pragma("unroll") for (int ks = 0; ks < 2; ++ks) { const v2u lo = pack4(X[2 * ks]), hi = pack4(X[2 * ks + 1]); const v4u xw = {lo.x, lo.y, hi.x, hi.y}; xb[ks] = __builtin_bit_cast(bf16x8, xw); \
            if (_c >= 4) *(GAS v4u*)(XC + (size_t)(_c - 4) * 4 * XC_UNIT + ks * 1024 + F.lane * 16) = xw; } \
        _Pragma("unroll") for (int mt = 0; mt < 4; ++mt) { f32x4 xn = unpack4(S.qv[mt]); \
            _Pragma("unroll") for (int ks = 0; ks < 2; ++ks) xn = __builtin_amdgcn_mfma_f32_16x16x32_bf16(__builtin_bit_cast(bf16x8, S.p[mt * 2 + ks]), xb[ks], xn, 0, 0, 0); \
            X[mt] = xn; } } while (0)
    BSetPQ SA, SB, SC;
    B_LOADPQ(SA, 0); B_LOADPQ(SB, 1);
#pragma unroll 1
    for (int c = 0; c < NCHK; c += 3) {
        B_LOADPQ(SC, c + 2); B_STEP(SA, c);
        B_LOADPQ(SA, c + 3); B_STEP(SB, c + 1);
        B_LOADPQ(SB, c + 4); B_STEP(SC, c + 2);
    }
#undef B_LOADPQ
#undef B_STEP
}

constexpr int YSP = 520;
__device__ __forceinline__ void phase_readout(Frame& F) {
    bf16* Z = (bf16*)(F.ws + WS_Z); const bf16* G = (const bf16*)(F.ws + WS_G); const float* COEF = (const float*)(F.ws + WS_COEF);
    LAS bf16* YS = (LAS bf16*)F.lds;
    const int r = F.lane & 15, q = F.lane >> 4, h = F.wave;
    const int hh = F.lane >> 3, c0 = F.lane * 8;
    float gnw[8], gnb[8];
#pragma unroll
    for (int e = 0; e < 8; ++e) { gnw[e] = F.in[18][c0 + e]; gnb[e] = F.in[19][c0 + e]; }
    for (int u = F.bid; u < NB * 128; u += F.G) {
        const int b = u >> 7, blk = u & 127;
        f32x4 y[4][4];
#pragma unroll
        for (int it = 0; it < 4; ++it)
#pragma unroll
            for (int vs = 0; vs < 4; ++vs) y[it][vs] = (f32x4){0.f, 0.f, 0.f, 0.f};
#pragma unroll
        for (int d = 0; d < 2; ++d) {
            const int chain = (b * 8 + h) * 2 + d, lc = d ? 127 - blk : blk;
            const bf16* Rg = (const bf16*)((const unsigned char*)F.out + ((size_t)chain * 128 + lc) * RY_UNIT); const bf16* Yg = Rg + 4096;
            const unsigned char* XC = F.ws + WS_YFB + ((size_t)chain * 128 + lc) * 4 * XC_UNIT;
            v4u xw[4][2], rr[4][2]; v2u yl[4][4];
#pragma unroll
            for (int vs = 0; vs < 4; ++vs) { xw[vs][0] = *(const GAS v4u*)(XC + vs * XC_UNIT + F.lane * 16); xw[vs][1] = *(const GAS v4u*)(XC + vs * XC_UNIT + 1024 + F.lane * 16); }
#pragma unroll
            for (int it = 0; it < 4; ++it) {
#pragma unroll
                for (int ks = 0; ks < 2; ++ks) rr[it][ks] = *(const GAS v4u*)(Rg + (((it * 2 + ks) * 64 + F.lane) << 3));
#pragma unroll
                for (int vs = 0; vs < 4; ++vs) yl[it][vs] = *(const GAS v2u*)(Yg + (((vs * 4 + it) * 64 + F.lane) << 2)); }
#pragma unroll
            for (int it = 0; it < 4; ++it)
#pragma unroll
                for (int vs = 0; vs < 4; ++vs) { f32x4 a = y[it][vs] + unpack4(yl[it][vs]);
#pragma unroll
                    for (int ks = 0; ks < 2; ++ks) a = __builtin_amdgcn_mfma_f32_16x16x32_bf16(__builtin_bit_cast(bf16x8, rr[it][ks]), __builtin_bit_cast(bf16x8, xw[vs][ks]), a, 0, 0, 0);
                    y[it][vs] = a; }
        }
#pragma unroll
        for (int it = 0; it < 4; ++it)
#pragma unroll
            for (int vs = 0; vs < 4; ++vs)
#pragma unroll
                for (int jj = 0; jj < 4; ++jj) YS[(16 * it + 4 * q + jj) * YSP + h * 64 + 16 * vs + r] = f2bf_hw(y[it][vs][jj]);
        __syncthreads();
#pragma unroll 2
        for (int tk = 0; tk < 8; ++tk) {
            const int tok = 8 * F.wave + tk, t = blk * 64 + tok; const size_t m = (size_t)b * T + t;
            float vsh[8], yf[8], gg[8];
            shift8(Z + m * PINP + ZRV + c0, t > 0, t < T - 1, F.in[8] + 1024 + c0, F.in[9] + 1024 + c0, vsh);
            unpack8(*(const LAS v4u*)(YS + tok * YSP + c0), yf); unpack8(*(const GAS v4u*)(G + m * 512 + c0), gg);
            const f32x2 cf2 = *(const GAS f32x2*)(COEF + m * 16 + hh * 2); const float coef = cf2.x + cf2.y;
            float sm = 0.f;
#pragma unroll
            for (int e = 0; e < 8; ++e) sm += yf[e];
            const float mean = sum8(sm) * (1.0f / 64.0f); float q2 = 0.f;
#pragma unroll
            for (int e = 0; e < 8; ++e) { yf[e] -= mean; q2 += yf[e] * yf[e]; }
            const float rstd = 1.0f / sqrtf(sum8(q2) * (1.0f / 64.0f) + GN_EPS);
            float o[8];
#pragma unroll
            for (int e = 0; e < 8; ++e) o[e] = (yf[e] * rstd * gnw[e] + gnb[e] + coef * vsh[e]) * gg[e];
            *(GAS v4u*)(Z + m * PINP + ZK + c0) = pack8(o);
        }
        __syncthreads();
    }
}

__device__ __forceinline__ void phase_ln1_router(Frame& F, float* hdst = nullptr) {
    const float* MODV = (const float*)(F.ws + WS_MOD);
    unsigned char* U2 = F.ws + WS_U2; float* AFF = (float*)(F.ws + WS_AFF);
    LAS float* wr = (LAS float*)F.lds;
    for (int e = F.tid; e < 1024 * 16; e += NTHR) { const int d = e >> 4, ex = e & 15, j = d >> 8, ln = (d & 255) >> 2, q = d & 3; wr[((j * 4 + q) * 64 + ln) * 20 + ex] = F.in[25][e]; }
    LAS float* tr = (LAS float*)(F.lds + 81920 + F.wave * 4352);
    __syncthreads();
    const int gw = F.bid * NWAVES + F.wave, NGW = F.G * NWAVES;
    for (int m = gw; m < MT; m += NGW) {
        const int b = m / T;
        const float* sh2 = MODV + b * 6144 + 3072; const float* sc2 = sh2 + 1024;
        GAS f32x4* hr = (GAS f32x4*)(F.out + (size_t)m * D) + F.lane;
        f32x4 v[4]; float s = 0.f;
#pragma unroll
        for (int j = 0; j < 4; ++j) { v[j] = hr[64 * j]; s += (v[j].x + v[j].y) + (v[j].z + v[j].w); }
        float mean = wave_sum(s) * (1.f / D); float s2 = 0.f;
#pragma unroll
        for (int j = 0; j < 4; ++j) { v[j] = v[j] - mean; s2 += (v[j].x * v[j].x + v[j].y * v[j].y) + (v[j].z * v[j].z + v[j].w * v[j].w); }
        float rstd = 1.f / sqrtf(wave_sum(s2) * (1.f / D) + LN_EPS);
        s = 0.f;
#pragma unroll
        for (int j = 0; j < 4; ++j) { const f32x4 g = *((const f32x4*)F.in[23] + F.lane + 64 * j), bb = *((const f32x4*)F.in[24] + F.lane + 64 * j);
            v[j] = v[j] * rstd * g + bb; if (hdst) ((GAS f32x4*)(hdst + (size_t)m * D) + F.lane)[64 * j] = v[j]; else hr[64 * j] = v[j]; s += (v[j].x + v[j].y) + (v[j].z + v[j].w); }
        mean = wave_sum(s) * (1.f / D); s2 = 0.f;
#pragma unroll
        for (int j = 0; j < 4; ++j) { v[j] = v[j] - mean; s2 += (v[j].x * v[j].x + v[j].y * v[j].y) + (v[j].z * v[j].z + v[j].w * v[j].w); }
        rstd = 1.f / sqrtf(wave_sum(s2) * (1.f / D) + LN_EPS);
        GAS unsigned* o4 = (GAS unsigned*)(U2 + (size_t)m * D) + F.lane;
        float lg[16];
#pragma unroll
        for (int e = 0; e < 16; ++e) lg[e] = 0.f;
#pragma unroll
        for (int j = 0; j < 4; ++j) { const f32x4 a = *((const f32x4*)sc2 + F.lane + 64 * j), bb = *((const f32x4*)sh2 + F.lane + 64 * j);
            const f32x4 o = v[j] * rstd * (a + 1.0f) + bb; v[j] = o;
            o4[64 * j] = pk4_fp8(o.x, o.y, o.z, o.w); }
#pragma unroll
        for (int j = 0; j < 4; ++j) {
#pragma unroll
            for (int q = 0; q < 4; ++q) { const LAS f32x4* wp = (const LAS f32x4*)(wr + (size_t)(((j * 4 + q) * 64 + F.lane) * 20)); const float oq = v[j][q];
#pragma unroll
                for (int e4 = 0; e4 < 4; ++e4) { const f32x4 w = wp[e4]; lg[e4 * 4 + 0] += oq * w.x; lg[e4 * 4 + 1] += oq * w.y; lg[e4 * 4 + 2] += oq * w.z; lg[e4 * 4 + 3] += oq * w.w; } }
            __builtin_amdgcn_sched_barrier(0); }
#pragma unroll
        for (int e = 0; e < 16; ++e) tr[F.lane * 17 + e] = lg[e];
        LDS_WAIT(); asm volatile("" ::: "memory");
        float lgt = 0.f;
#pragma unroll
        for (int i = 0; i < 16; ++i) lgt += tr[((F.lane >> 4) * 16 + i) * 17 + (F.lane & 15)];
        LDS_WAIT(); asm volatile("" ::: "memory");
        lgt += __shfl_xor(lgt, 16); lgt += __shfl_xor(lgt, 32);
        float mx = lgt;
        mx = fmaxf(mx, dppf<0xB1>(mx)); mx = fmaxf(mx, dppf<0x4E>(mx)); mx = fmaxf(mx, dppf<0x141>(mx)); mx = fmaxf(mx, dppf<0x140>(mx));
        const float ex = expf(lgt - mx); const float mine = ex / row16_sum(ex);
        if (F.lane < 16) AFF[(size_t)m * 16 + F.lane] = mine;
    }
}

__device__ __forceinline__ unsigned block_excl_scan(Frame& F, unsigned v, LAS unsigned* sc, unsigned& total) {
    unsigned inc = v;
#pragma unroll
    for (int o = 1; o < 64; o <<= 1) { const unsigned t = __shfl_up(inc, o); if (F.lane >= o) inc += t; }
    __syncthreads();
    if (F.lane == 63) sc[F.wave] = inc;
    __syncthreads();
    unsigned base = 0, tot = 0;
#pragma unroll
    for (int w = 0; w < 8; ++w) { const unsigned x = sc[w]; if (w < F.wave) base += x; tot += x; }
    total = tot;
    return base + inc - v;
}
__device__ __forceinline__ void topk_unit(Frame& F, int unit) {
    const int b = unit & 3, e = unit >> 2;
    const float* AFF = (const float*)(F.ws + WS_AFF);
    int* IDX = (int*)(F.ws + WS_IDX); float* GATEV = (float*)(F.ws + WS_GATEV); int* SLOT = (int*)(F.ws + WS_SLOT);
    LAS unsigned* hist = (LAS unsigned*)F.lds;
    LAS unsigned* sc = hist + 256;
    LAS unsigned* sel = sc + 16;
    LAS int* idl = (LAS int*)(sel + 16);
    unsigned key[16];
#pragma unroll
    for (int i = 0; i < 16; ++i) key[i] = __float_as_uint(AFF[((size_t)b * T + F.tid * 16 + i) * 16 + e]);
    unsigned prefix = 0, need = CAP;
#pragma unroll 1
    for (int rd = 0; rd < 4; ++rd) {
        const int shift = 24 - 8 * rd; const unsigned hmask = (rd == 0) ? 0u : (0xffffffffu << (shift + 8));
        if (F.tid < 256) hist[F.tid] = 0u;
        __syncthreads();
#pragma unroll
        for (int i = 0; i < 16; ++i) if ((key[i] & hmask) == prefix) __hip_atomic_fetch_add(&hist[(key[i] >> shift) & 255u], 1u, __ATOMIC_RELAXED, __HIP_MEMORY_SCOPE_WORKGROUP);
        __syncthreads();
        if (F.wave == 0) {
            const unsigned c0 = hist[4 * F.lane], c1 = hist[4 * F.lane + 1], c2 = hist[4 * F.lane + 2], c3 = hist[4 * F.lane + 3];
            const unsigned tot4 = (c0 + c1) + (c2 + c3); unsigned x = tot4;
#pragma unroll
            for (int o = 1; o < 64; o <<= 1) { const unsigned t = __shfl_down(x, o); if (F.lane + o < 64) x += t; }
            const unsigned excl = x - tot4;
            if (excl < need && need <= x) { unsigned cum = excl; int bin;
                if (cum + c3 >= need) bin = 4 * F.lane + 3; else { cum += c3; if (cum + c2 >= need) bin = 4 * F.lane + 2; else { cum += c2; if (cum + c1 >= need) bin = 4 * F.lane + 1; else { cum += c1; bin = 4 * F.lane; } } }
                sel[0] = (unsigned)bin; sel[1] = need - cum; } }
        __syncthreads();
        prefix |= sel[0] << shift; need = sel[1];
        __syncthreads();
    }
    unsigned neq = 0, ngt = 0;
#pragma unroll
    for (int i = 0; i < 16; ++i) { neq += (key[i] == prefix); ngt += (key[i] > prefix); }
    unsigned tot; const unsigned eqbase = block_excl_scan(F, neq, sc, tot);
    unsigned cnt = 0, eqr = eqbase; unsigned selm = 0;
#pragma unroll
    for (int i = 0; i < 16; ++i) { bool s = key[i] > prefix; if (key[i] == prefix) { s = eqr < need; ++eqr; } if (s) { selm |= 1u << i; ++cnt; } }
    const unsigned pos0 = block_excl_scan(F, cnt, sc, tot);
    unsigned pos = pos0;
#pragma unroll
    for (int i = 0; i < 16; ++i) { const int t = F.tid * 16 + i; int sl = -1;
        if (selm & (1u << i)) { sl = (int)pos; ++pos; const int slot = (e * NB + b) * CAP + sl; IDX[slot] = b * T + t; GATEV[slot] = __uint_as_float(key[i]); idl[sl] = b * T + t; }
        SLOT[((size_t)b * T + t) * 16 + e] = sl; }
    __syncthreads();
    { const unsigned char* U2 = F.ws + WS_U2; unsigned char* XS = F.ws + WS_XS + (size_t)((e * NB + b) * CAP) * D;
#pragma unroll 1
      for (int s0 = F.wave * 16; s0 < CAP; s0 += NWAVES * 16) { v4u rw[16];
#pragma unroll
          for (int k = 0; k < 16; ++k) rw[k] = *((const GAS v4u*)(U2 + (size_t)idl[s0 + k] * D) + F.lane);
#pragma unroll
          for (int k = 0; k < 16; ++k) *((GAS v4u*)(XS + (size_t)(s0 + k) * D) + F.lane) = rw[k]; } }
    __syncthreads();
}
constexpr int CV_I13 = 16 * (DE / 64), CV_I2 = (DE / 64) * 16, CV_N13 = NE * 2 * CV_I13;
constexpr int Z_EARLY_PER_WAVE = 6;
__device__ __forceinline__ int z_tail_first(int G) { return ((MA / 256) * (PINP / 256)) % G; }
__device__ __forceinline__ int z_early_tiles(int G) { const int t = z_tail_first(G); const int n = t > 0 ? (G - t) * NWAVES * Z_EARLY_PER_WAVE : 0; return n <= NE * CV_I2 - W2_EARLY_TILES ? n : 0; }
__device__ __forceinline__ void cvt_w2_tile(Frame& F, int w2t) { const int e = w2t / CV_I2, r = w2t % CV_I2, k0 = 64 * (r / 16), n0 = 64 * (r % 16);
    cvt_tile64_fp8(F.in[28] + (size_t)e * DE * 1024, 1024, k0, n0, F.ws + WS_W2 + (size_t)e * 1024 * DE, (size_t)n0, DE, W2_SCALE, F.lane); }
__device__ __forceinline__ void cvt_w13_tile(Frame& F, int it0) { const int e = it0 / (2 * CV_I13); int r = it0 % (2 * CV_I13);
    const int which = r / CV_I13; r %= CV_I13; const int nb = DE / 64, k0 = 64 * (r / nb), n0 = 64 * (r % nb);
    cvt_tile64_fp8(F.in[which ? 27 : 26] + (size_t)e * 1024 * DE, DE, k0, n0, F.ws + WS_W13 + (size_t)e * PINP * 1024, (size_t)(256 * (n0 / 128) + 128 * which + (n0 % 128)), 1024, W13_SCALE, F.lane); }
__device__ __forceinline__ void phase_topk_convert(Frame& F) {
    if (F.bid < NB * NE) topk_unit(F, F.bid);
    const int NTK = NB * NE * NWAVES, NVW = F.G * NWAVES - NTK;
    const int gwl = F.bid * NWAVES + F.wave; const int vw0 = gwl < NTK ? 0 : (gwl - NTK), nvw = gwl < NTK ? 0 : 1;
    const int w2done = z_early_tiles(F.G) + W2_EARLY_TILES, nlate = CV_N13 + NE * CV_I2 - w2done;
    for (int itb = vw0; itb < nlate; itb += NVW) for (int v = 0; v < nvw; ++v) { const int it0 = itb + v; if (it0 >= nlate) break;
        if (it0 < CV_N13) cvt_w13_tile(F, it0); else cvt_w2_tile(F, it0 - CV_N13 + w2done); }
}

__device__ __forceinline__ void phase_gather(Frame& F) {
    const int* IDX = (const int*)(F.ws + WS_IDX); const unsigned char* U2 = F.ws + WS_U2; unsigned char* XS = F.ws + WS_XS;
    const int gw = F.bid * NWAVES + F.wave, NGW = F.G * NWAVES;
    for (int s = gw; s < NSLOT; s += NGW) {
        const int src = IDX[s];
        *((GAS v4u*)(XS + (size_t)s * D) + F.lane) = *((const GAS v4u*)(U2 + (size_t)src * D) + F.lane);
    }
}

__device__ __forceinline__ void phase_final(Frame& F, float* odst = nullptr) {
    const float* MODV = (const float*)(F.ws + WS_MOD); const int* SLOT = (const int*)(F.ws + WS_SLOT); const bf16* YE = (const bf16*)(F.ws + WS_YE);
    const int gw = F.bid * NWAVES + F.wave, NGW = F.G * NWAVES;
    for (int m = gw; m < MT; m += NGW) {
        const int b = m / T;
        const float* gt2 = MODV + b * 6144 + 5120;
        GAS f32x4* hr = (GAS f32x4*)(F.out + (size_t)m * D) + F.lane;
        f32x4 acc[4];
#pragma unroll
        for (int j = 0; j < 4; ++j) acc[j] = (f32x4){0.f, 0.f, 0.f, 0.f};
        const int myslot = (F.lane < 16) ? SLOT[(size_t)m * 16 + F.lane] : -1;
        f32x4 hv[4];
#pragma unroll
        for (int j = 0; j < 4; ++j) hv[j] = hr[64 * j];
        unsigned mask = (unsigned)(__ballot(myslot >= 0) & 0xFFFFull);
        while (mask) {
            const int e0 = __builtin_ctz(mask); mask &= mask - 1; const bool two = mask != 0; const int e1 = two ? __builtin_ctz(mask) : e0; if (two) mask &= mask - 1;
            const int s0 = __shfl(myslot, e0), s1 = __shfl(myslot, e1);
            const GAS v2u* y0 = (const GAS v2u*)(YE + (size_t)((e0 * NB + b) * CAP + s0) * D) + F.lane; const GAS v2u* y1 = (const GAS v2u*)(YE + (size_t)((e1 * NB + b) * CAP + s1) * D) + F.lane;
            v2u w0[4], w1[4];
#pragma unroll
            for (int j = 0; j < 4; ++j) { w0[j] = y0[64 * j]; w1[j] = y1[64 * j]; }
            const float f1 = two ? 1.f : 0.f;
#pragma unroll
            for (int j = 0; j < 4; ++j) { acc[j].x += bflo(w0[j].x) + f1 * bflo(w1[j].x); acc[j].y += bfhi(w0[j].x) + f1 * bfhi(w1[j].x); acc[j].z += bflo(w0[j].y) + f1 * bflo(w1[j].y); acc[j].w += bfhi(w0[j].y) + f1 * bfhi(w1[j].y); } }
        f32x4 v[4]; float s = 0.f;
#pragma unroll
        for (int j = 0; j < 4; ++j) { const f32x4 g = *((const f32x4*)gt2 + F.lane + 64 * j); v[j] = hv[j] * ALPHA + g * acc[j]; s += (v[j].x + v[j].y) + (v[j].z + v[j].w); }
        const float mean = wave_sum(s) * (1.f / D); float s2 = 0.f;
#pragma unroll
        for (int j = 0; j < 4; ++j) { v[j] = v[j] - mean; s2 += (v[j].x * v[j].x + v[j].y * v[j].y) + (v[j].z * v[j].z + v[j].w * v[j].w); }
        const float rstd = 1.f / sqrtf(wave_sum(s2) * (1.f / D) + LN_EPS);
#pragma unroll
        for (int j = 0; j < 4; ++j) { const f32x4 g = *((const f32x4*)F.in[29] + F.lane + 64 * j), bb = *((const f32x4*)F.in[30] + F.lane + 64 * j); { const f32x4 ov = v[j] * rstd * g + bb; if (odst) ((GAS f32x4*)(odst + (size_t)m * D) + F.lane)[64 * j] = ov; else hr[64 * j] = ov; } }
    }
}

constexpr int N_PHASES = 16;
struct Args { const float* in[31]; float* out; unsigned char* ws; int ph_lo, ph_hi; };
__global__ void __launch_bounds__(NTHR, 2) fwd(Args args) {
    extern __shared__ __attribute__((aligned(16))) unsigned char lds[];
    Frame F;
    F.lds = (LAS unsigned char*)lds;
    F.tid = threadIdx.x; F.lane = F.tid & 63; F.wave = __builtin_amdgcn_readfirstlane(F.tid >> 6);
    F.G = gridDim.x; F.bid = blockIdx.x;
#pragma unroll
    for (int i = 0; i < 31; ++i) F.in[i] = args.in[i];
    F.out = args.out; F.ws = args.ws;
    volatile LAS unsigned* MISC = (volatile LAS unsigned*)(F.lds + MISC_OFF);
    for (int u = F.tid; u < (LDS_BYTES - LDSCTL_OFF) / 4; u += NTHR) ((LAS unsigned*)(F.lds + LDSCTL_OFF))[u] = 0u;
    __syncthreads();
    XcdBarrier bar; bar.bar = (unsigned*)(F.ws + WS_CTL) + CW_BAR; bar.x = 0; bar.st = nullptr;
    const int lo = args.ph_lo, hi = args.ph_hi;
    const bool multi = (hi - lo) > 1;
    if (multi) bar = xcd_barrier_post((unsigned*)(F.ws + WS_CTL) + CW_BAR, MISC + 8);
#ifndef PH_MASK
#define PH_MASK 0xFFFF
#endif
#define IN(k) (((PH_MASK >> (k)) & 1) && lo <= (k) && (k) < hi)
#define SEAM(k) do { if (IN(k) && IN((k) + 1)) xcd_barrier(bar); } while (0)
    LAS unsigned char* ring = F.lds;
    bf16* Z = (bf16*)(F.ws + WS_Z);

    if (IN(0)) { for (int rp = 0; rp < REPS(0); ++rp) { phase_prologue(F); if (rp + 1 < REPS(0)) xcd_barrier(bar); } SEAM(0); }
    if (IN(1)) { for (int rp = 0; rp < REPS(1); ++rp) { phase_ln_mod(F); if (rp + 1 < REPS(1)) xcd_barrier(bar); } SEAM(1); }
    if (IN(2)) {
        pg8::Gemm g{(const bf16*)(F.ws + WS_U), (const bf16*)(F.ws + WS_WIN), MA, PINP, D, D, 1 << 30, 0};
        pg8::StaticOrder S; S.init(MA, PINP, F.G, F.bid);
        pg8::EpiBf16 E{Z, PINP};
        pg8::gemm_phase<pg8::EpiBf16, pg8::StaticOrder, true, true>(ring, g, S, E);
        if (DUP(2)) { xcd_barrier(bar); pg8::gemm_phase<pg8::EpiBf16, pg8::StaticOrder, true, true>(ring, g, S, E); }
        { const int t0 = z_tail_first(F.G);
          if (z_early_tiles(F.G) > 0 && F.bid >= t0) { const int nw = (F.G - t0) * NWAVES, w0 = (F.bid - t0) * NWAVES + F.wave;
              for (int k = 0; k < Z_EARLY_PER_WAVE; ++k) cvt_w2_tile(F, w0 + k * nw); } }
        SEAM(2);
    }
    if (IN(3)) {
        phase_rope_vt(F);
        __syncthreads();
        { LAS float* mu = (LAS float*)(F.lds + LDS_MU); for (int e = F.tid; e < 768; e += NTHR) mu[e] = F.in[e < 384 ? 8 : 9][1536 + (e < 384 ? e : e - 384)]; }
        __syncthreads();
#ifdef PROBE_AMODE
        { int hl0 = -1; for (int u = F.bid; u < NB * NCHK * 8; u += F.G) rwkvA_unit<PROBE_AMODE>(F, u, hl0, -1, -1); }
        xcd_barrier(bar);
#endif
        for (int rp = 0; rp < REPS(3); ++rp) { int hl = -1, pre = -1; for (int u = F.bid; u < NB * NCHK * 8; u += F.G) { const int un = u + F.G < NB * NCHK * 8 ? u + F.G : -1; rwkvA_unit<0>(F, u, hl, pre, un); pre = (((u >> 3) % NCHK) < 4) ? 4 : 8; } if (rp + 1 < REPS(3)) xcd_barrier(bar); }
        SEAM(3);
    }
    if (IN(4)) {
        LAS float* rpbs = (LAS float*)F.lds;
        LAS bf16* ck = (LAS bf16*)(F.lds + 16384);
        LAS bf16* cvt = (LAS bf16*)(F.lds + 16384 + 36864);
        for (int e = F.tid; e < 8 * 465 + 224; e += NTHR) rpbs[e] = e < 8 * 465 ? 8.0f * F.in[7][e] : -1e30f;
        {
            const int vb = F.bid, bh = (vb >> 3) & 31, b4 = bh >> 3, h4 = bh & 7, sub = vb & 7;
            { const bf16* Zc = Z + ((size_t)MT + b4 * LC) * PINP + ZK + h4 * 64; const bf16* VTCg = (const bf16*)(F.ws + WS_VT) + VT_LAT_ELEMS + (size_t)bh * 64 * LC;
              for (int e = F.tid; e < 256 * 8; e += NTHR) { const int row = e >> 3, c8 = (e & 7) * 8; *(LAS v4u*)(ck + row * NA_KP + c8) = *(const GAS v4u*)(Zc + (size_t)row * PINP + c8); }
              for (int e = F.tid; e < 64 * 32; e += NTHR) { const int row = e >> 5, c8 = (e & 31) * 8; *(LAS v4u*)(cvt + row * NA_VP + c8) = *(const GAS v4u*)(VTCg + (size_t)row * LC + c8); } }
            __syncthreads();
            if (vb < 256) {
                if (DUP(4)) { if (F.wave > 0) for (int tk = F.wave - 1; tk < 64; tk += 7) na_wave_task(F, (b4 << 12) | ((16 * sub + (tk >> 2)) << 5) | (h4 << 2) | (tk & 3), rpbs, ck, cvt, ZV); }
                if (F.wave == 0) { rwkvB_task(F, vb);
                    { const int ze = z_early_tiles(F.G); for (int w2t = ze + vb; w2t < ze + W2_EARLY_TILES; w2t += 256) cvt_w2_tile(F, w2t); } }
                else { for (int tk = F.wave - 1; tk < 64; tk += 7) na_wave_task(F, (b4 << 12) | ((16 * sub + (tk >> 2)) << 5) | (h4 << 2) | (tk & 3), rpbs, ck, cvt); }
            }
        }
        if (REPS(4) > 1) { xcd_barrier(bar); if (F.wave == 0 && F.bid < 256) rwkvB_task(F, F.bid); }
        SEAM(4);
    }
    if (IN(5)) { for (int rp = 0; rp < REPS(5); ++rp) { phase_readout(F); if (rp + 1 < REPS(5)) xcd_barrier(bar); } SEAM(5); }
    if (IN(6)) {
        pg8::StaticOrder S; S.init(MT, D, F.G, F.bid);
        { pg8::Gemm g{Z + ZQ, (const bf16*)(F.ws + WS_WPA), MT, D, 512, PINP, 1 << 30, 0};
          pg8::EpiGate<0> E{(bf16*)(F.ws + WS_LORA), D, Z + ZGNA, PINP};
          pg8::gemm_phase<pg8::EpiGate<0>, pg8::StaticOrder, true, true>(ring, g, S, E); }
        VM_WAIT(); __syncthreads();
        { pg8::Gemm g{Z + ZK, (const bf16*)(F.ws + WS_WPR), MT, D, 512, PINP, 1 << 30, 0};
          pg8::EpiGate<1> E{(bf16*)(F.ws + WS_LORA), D, Z + ZGRW, PINP};
          pg8::gemm_phase<pg8::EpiGate<1>, pg8::StaticOrder, true, true>(ring, g, S, E); }
        if (DUP(6)) { xcd_barrier(bar);

        { pg8::Gemm g{Z + ZQ, (const bf16*)(F.ws + WS_WPA), MT, D, 512, PINP, 1 << 30, 0};
          pg8::EpiGate<0> E{(bf16*)(F.ws + WS_LORA), D, Z + ZGNA, PINP};
          pg8::gemm_phase<pg8::EpiGate<0>, pg8::StaticOrder, true, true>(ring, g, S, E); }
        VM_WAIT(); __syncthreads();
        { pg8::Gemm g{Z + ZK, (const bf16*)(F.ws + WS_WPR), MT, D, 512, PINP, 1 << 30, 0};
          pg8::EpiGate<1> E{(bf16*)(F.ws + WS_LORA), D, Z + ZGRW, PINP};
          pg8::gemm_phase<pg8::EpiGate<1>, pg8::StaticOrder, true, true>(ring, g, S, E); }
        }
        SEAM(6);
    }
    if (IN(7)) {
        pg8::Gemm g{(const bf16*)(F.ws + WS_LORA), (const bf16*)(F.ws + WS_WO), MT, D, D, D, 1 << 30, 0};
        pg8::StaticOrder S; S.init(MT, D, F.G, F.bid);
        pg8::EpiResid E{F.out, F.in[0], (const float*)(F.ws + WS_MOD) + 2048, 6144, T, ALPHA};
        pg8::gemm_phase<pg8::EpiResid, pg8::StaticOrder, true, true>(ring, g, S, E);
        if (DUP(7)) { xcd_barrier(bar); pg8::gemm_phase<pg8::EpiResid, pg8::StaticOrder, true, true>(ring, g, S, E); }
        SEAM(7);
    }
    if (IN(8)) { if (DUP(8)) { phase_ln1_router(F, (float*)(F.ws + WS_YE)); xcd_barrier(bar); } phase_ln1_router(F); SEAM(8); }
    if (IN(9)) { for (int rp = 0; rp < REPS(9); ++rp) { phase_topk_convert(F); if (rp + 1 < REPS(9)) xcd_barrier(bar); } SEAM(9); }
    if (IN(11)) {
        pg8::Gemm g{(const bf16*)(F.ws + WS_XS), (const bf16*)(F.ws + WS_W13), NSLOT, PINP, D / 2, D / 2, 16, (size_t)PINP * 1024};
        pg8::StaticOrder S; S.init(NSLOT, PINP, F.G, F.bid);
        pg8::EpiSwiglu E{F.ws + WS_HDN, DE, 1.0f / W13_SCALE, HDN_SCALE};
        pg8::gemm_phase<pg8::EpiSwiglu, pg8::StaticOrder, true, true, true>(ring, g, S, E);
        if (DUP(11)) { xcd_barrier(bar); pg8::gemm_phase<pg8::EpiSwiglu, pg8::StaticOrder, true, true, true>(ring, g, S, E); }
        SEAM(11);
    }
    if (IN(12)) {
        pg8::Gemm g{(const bf16*)(F.ws + WS_HDN), (const bf16*)(F.ws + WS_W2), NSLOT, D, DE / 2, DE / 2, 16, (size_t)1024 * DE};
        pg8::StaticOrder S; S.init(NSLOT, D, F.G, F.bid);
        pg8::EpiScaleRow E{(bf16*)(F.ws + WS_YE), D, (const float*)(F.ws + WS_GATEV), 1.0f / (W2_SCALE * HDN_SCALE)};
        pg8::gemm_phase<pg8::EpiScaleRow, pg8::StaticOrder, true, true, true>(ring, g, S, E);
        if (DUP(12)) { xcd_barrier(bar); pg8::gemm_phase<pg8::EpiScaleRow, pg8::StaticOrder, true, true, true>(ring, g, S, E); }
        if (IN(12) && IN(15)) xcd_barrier(bar);
    }
    if (IN(15)) { if (DUP(15)) { phase_final(F, (float*)(F.ws + WS_HDN)); xcd_barrier(bar); } phase_final(F); }
#undef IN
#undef SEAM
}

extern "C" void kernel_launch(void* const* d_in, const int* in_sizes, int n_in, void* d_out, int out_size, void* d_ws, size_t ws_size, hipStream_t stream) {
    static int grid = 0;
    if (grid == 0) {
        if (n_in != 31 || out_size != MT * D || ws_size < WS_END) { fprintf(stderr, "kernel_launch: unexpected shapes (n_in %d, out %d, ws %zu); nothing launched\n", n_in, out_size, ws_size); grid = -1; return; }
        int dev = 0, cus = 0, per_cu = 0;
        if (hipGetDevice(&dev) != hipSuccess || hipDeviceGetAttribute(&cus, hipDeviceAttributeMultiprocessorCount, dev) != hipSuccess) { grid = -1; return; }
        if (hipFuncSetAttribute((const void*)fwd, hipFuncAttributeMaxDynamicSharedMemorySize, LDS_BYTES) != hipSuccess) { fprintf(stderr, "kernel_launch: hipFuncSetAttribute failed\n"); grid = -1; return; }
        if (hipOccupancyMaxActiveBlocksPerMultiprocessor(&per_cu, (const void*)fwd, NTHR, LDS_BYTES) != hipSuccess || per_cu < 1) fprintf(stderr, "kernel_launch: occupancy query reports %d\n", per_cu);
        (void)hipGetLastError();
        grid = cus;
        if (grid < 256) { fprintf(stderr, "kernel_launch: this kernel needs >= 256 CUs (got %d); nothing launched\n", cus); grid = -1; return; }
    }
    if (grid < 0) return;
    (void)hipMemsetAsync((char*)d_ws + WS_CTL, 0, CTL_ZERO_BYTES, stream);
    Args a{};
    for (int i = 0; i < 31; ++i) a.in[i] = (const float*)d_in[i];
    a.out = (float*)d_out; a.ws = (unsigned char*)d_ws;
#if MK_ONE_LAUNCH
    a.ph_lo = 0; a.ph_hi = 16;
    hipLaunchKernelGGL(fwd, dim3(grid), dim3(NTHR), LDS_BYTES, stream, a);
#else
    for (int p = 0; p < 16; ++p) { a.ph_lo = p; a.ph_hi = p + 1; hipLaunchKernelGGL(fwd, dim3(grid), dim3(NTHR), LDS_BYTES, stream, a); }
#endif
}
```

```cpp
#include <hip/hip_runtime.h>
#include <cstdio>
#include <cstdint>

#ifndef PROBE_REP
#define PROBE_REP 0
#endif
#define REPS(k) (((PROBE_REP >> (k)) & 1) ? 2 : 1)
#ifndef PROBE_DUP
#define PROBE_DUP 0
#endif
#define DUP(k) ((PROBE_DUP >> (k)) & 1)
#ifndef MK_ONE_LAUNCH
#define MK_ONE_LAUNCH 1
#endif

namespace pg8 {
#define PG8_LAS __attribute__((address_space(3)))
typedef unsigned short bf16_t;
typedef short bf16x8 __attribute__((ext_vector_type(8)));
typedef float f32x4 __attribute__((ext_vector_type(4)));
typedef unsigned u32x4 __attribute__((ext_vector_type(4)));
typedef unsigned u32x2 __attribute__((ext_vector_type(2)));
constexpr int BM = 256, BK = 64, HALF = 128, HTB = HALF * BK * 2, STAGE_BYTES = 8 * HTB, NXCD = 8, WGM = 8;

__host__ __device__ __forceinline__ int lds_byte(int r, int c) { const int st = (r >> 4) * 2 + (c >> 5), rr = r & 15, cc = c & 31, ob = rr * 64 + cc * 2; return st * 1024 + (ob ^ (((ob >> 9) & 1) << 5)); }
__host__ __device__ __forceinline__ void stage_rc(int b, int& R, int& C) { const int st = b / 1024, sb = b % 1024, swz = sb ^ (((sb >> 9) & 1) << 5); R = (st >> 1) * 16 + swz / 64; C = (st & 1) * 32 + (swz % 64) / 2; }
__host__ __device__ __forceinline__ int perm32(int rho) { const int n = rho >> 4, i = rho & 15; return 8 * (i >> 2) + 4 * n + (i & 3); }

struct Unit { int pm, pn; };
struct Gemm { const bf16_t* A; const bf16_t* Bt; int M, N, K, lda; int pmg; size_t bgs; };

struct StaticOrder {
    int nM, nN, nwg, G, c;
    __host__ __device__ void init(int M, int N, int G_, int c_) { nM = M / BM; nN = N / BM; nwg = nM * nN; G = G_; c = c_; }
    __host__ __device__ bool next(int i, Unit& u) const {
        const long L = (long)i * G + c; if (L >= nwg) return false;
        int wgid = (int)L; { const int q = nwg / NXCD, r = nwg % NXCD, xcd = wgid % NXCD, off = wgid / NXCD; wgid = (xcd < r ? xcd * (q + 1) : r * (q + 1) + (xcd - r) * q) + off; }
        const int nig = WGM * nN, gid = wgid / nig, fm = gid * WGM, gsz = (nM - fm) < WGM ? (nM - fm) : WGM;
        u.pm = fm + ((wgid % nig) % gsz); u.pn = (wgid % nig) / gsz; return true;
    }
    __device__ __forceinline__ void a_ready(const Unit&) const {}
    __device__ __forceinline__ void done(const Unit&) const {}
};

typedef __bf16 bf16x2_t __attribute__((ext_vector_type(2)));
typedef float f32x2_t __attribute__((ext_vector_type(2)));
__device__ __forceinline__ unsigned cvt_pk_bf16(float lo, float hi) { const f32x2_t v = {lo, hi}; const bf16x2_t b = __builtin_convertvector(v, bf16x2_t); return __builtin_bit_cast(unsigned, b); }
__device__ __forceinline__ float bf_lo(unsigned w) { return __uint_as_float(w << 16); }
__device__ __forceinline__ float bf_hi(unsigned w) { return __uint_as_float(w & 0xffff0000u); }
__device__ __forceinline__ float sigmoidf_(float x) { return __builtin_amdgcn_rcpf(1.0f + __expf(-x)); }

struct EpiBf16 {
    static constexpr bool PERM = true;
    bf16_t* O; int ldc;
    __device__ __forceinline__ void operator()(const f32x4 (&acc)[2][2][4][2], const Unit& u, int wr, int wc, int fr, int fq) const {
        const int row0 = u.pm * BM + wr * 64 + fr, col0 = u.pn * BM + wc * 32 + 8 * fq;
#pragma unroll
        for (int ai = 0; ai < 2; ++ai)
#pragma unroll
            for (int m = 0; m < 4; ++m) { bf16_t* rowp = O + (size_t)(row0 + ai * HALF + m * 16) * ldc + col0;
#pragma unroll
                for (int bj = 0; bj < 2; ++bj) { const f32x4 v0 = acc[ai][bj][m][0], v1 = acc[ai][bj][m][1];
                    u32x4 w; w.x = cvt_pk_bf16(v0[0], v0[1]); w.y = cvt_pk_bf16(v0[2], v0[3]); w.z = cvt_pk_bf16(v1[0], v1[1]); w.w = cvt_pk_bf16(v1[2], v1[3]);
                    *(u32x4*)(rowp + bj * HALF) = w; } }
    }
};
template <int MODE> struct EpiGate {
    static constexpr bool PERM = true;
    bf16_t* O; int ldc; const bf16_t* G; int ldg;
    __device__ __forceinline__ void operator()(const f32x4 (&acc)[2][2][4][2], const Unit& u, int wr, int wc, int fr, int fq) const {
        const int row0 = u.pm * BM + wr * 64 + fr, col0 = u.pn * BM + wc * 32 + 8 * fq;
#pragma unroll
        for (int ai = 0; ai < 2; ++ai)
#pragma unroll
            for (int m = 0; m < 4; ++m) { const size_t row = (size_t)(row0 + ai * HALF + m * 16);
#pragma unroll
                for (int bj = 0; bj < 2; ++bj) { const f32x4 v0 = acc[ai][bj][m][0], v1 = acc[ai][bj][m][1];
                    const u32x4 gz = *(const u32x4*)(G + row * ldg + col0 + bj * HALF);
                    float o[8];
                    o[0] = sigmoidf_(bf_lo(gz.x)) * v0[0]; o[1] = sigmoidf_(bf_hi(gz.x)) * v0[1]; o[2] = sigmoidf_(bf_lo(gz.y)) * v0[2]; o[3] = sigmoidf_(bf_hi(gz.y)) * v0[3];
                    o[4] = sigmoidf_(bf_lo(gz.z)) * v1[0]; o[5] = sigmoidf_(bf_hi(gz.z)) * v1[1]; o[6] = sigmoidf_(bf_lo(gz.w)) * v1[2]; o[7] = sigmoidf_(bf_hi(gz.w)) * v1[3];
                    bf16_t* op = O + row * ldc + col0 + bj * HALF;
                    if (MODE == 1) { const u32x4 pz = *(const u32x4*)op;
                        o[0] += bf_lo(pz.x); o[1] += bf_hi(pz.x); o[2] += bf_lo(pz.y); o[3] += bf_hi(pz.y); o[4] += bf_lo(pz.z); o[5] += bf_hi(pz.z); o[6] += bf_lo(pz.w); o[7] += bf_hi(pz.w); }
                    u32x4 w; w.x = cvt_pk_bf16(o[0], o[1]); w.y = cvt_pk_bf16(o[2], o[3]); w.z = cvt_pk_bf16(o[4], o[5]); w.w = cvt_pk_bf16(o[6], o[7]);
                    *(u32x4*)op = w; } }
    }
};
struct EpiResid {
    static constexpr bool PERM = false;
    float* O; const float* X; const float* gt; int gt_pitch; int rows_per_b; float alpha;
    __device__ __forceinline__ void operator()(const f32x4 (&acc)[2][2][4][2], const Unit& u, int wr, int wc, int fr, int fq) const {
        const int row0 = u.pm * BM + wr * 64 + fr, col0 = u.pn * BM + wc * 32 + 4 * fq;
        const float* gtb = gt + (size_t)((u.pm * BM) / rows_per_b) * gt_pitch + col0;
        f32x4 gv[2][2];
#pragma unroll
        for (int bj = 0; bj < 2; ++bj)
#pragma unroll
            for (int n = 0; n < 2; ++n) gv[bj][n] = *(const f32x4*)(gtb + bj * HALF + n * 16);
#pragma unroll
        for (int ai = 0; ai < 2; ++ai)
#pragma unroll
            for (int m = 0; m < 4; ++m) { const size_t off = (size_t)(row0 + ai * HALF + m * 16) * 1024 + col0;
#pragma unroll
                for (int bj = 0; bj < 2; ++bj)
#pragma unroll
                    for (int n = 0; n < 2; ++n) { const f32x4 xv = *(const f32x4*)(X + off + bj * HALF + n * 16);
                        *(f32x4*)(O + off + bj * HALF + n * 16) = xv * alpha + gv[bj][n] * acc[ai][bj][m][n]; } }
    }
};
struct EpiSwiglu {
    static constexpr bool PERM = true;
    unsigned char* H; int ldh; float as, hs;
    __device__ __forceinline__ void operator()(const f32x4 (&acc)[2][2][4][2], const Unit& u, int wr, int wc, int fr, int fq) const {
        const int row0 = u.pm * BM + wr * 64 + fr, col0 = u.pn * HALF + wc * 32 + 8 * fq;
#pragma unroll
        for (int ai = 0; ai < 2; ++ai)
#pragma unroll
            for (int m = 0; m < 4; ++m) { unsigned char* rowp = H + (size_t)(row0 + ai * HALF + m * 16) * ldh + col0;
                float o[8];
#pragma unroll
                for (int n = 0; n < 2; ++n)
#pragma unroll
                    for (int j = 0; j < 4; ++j) { const float a = acc[ai][0][m][n][j] * as, b = acc[ai][1][m][n][j] * as; o[n * 4 + j] = fminf(fmaxf(a * sigmoidf_(a) * b * hs, -448.f), 448.f); }
                u32x2 w; w.x = (unsigned)__builtin_amdgcn_cvt_pk_fp8_f32(o[2], o[3], __builtin_amdgcn_cvt_pk_fp8_f32(o[0], o[1], 0, false), true);
                w.y = (unsigned)__builtin_amdgcn_cvt_pk_fp8_f32(o[6], o[7], __builtin_amdgcn_cvt_pk_fp8_f32(o[4], o[5], 0, false), true);
                *(u32x2*)rowp = w; }
    }
};
struct EpiScaleRow {
    static constexpr bool PERM = true;
    bf16_t* O; int ldc; const float* gate; float sc;
    __device__ __forceinline__ void operator()(const f32x4 (&acc)[2][2][4][2], const Unit& u, int wr, int wc, int fr, int fq) const {
        const int row0 = u.pm * BM + wr * 64 + fr, col0 = u.pn * BM + wc * 32 + 8 * fq;
#pragma unroll
        for (int ai = 0; ai < 2; ++ai)
#pragma unroll
            for (int m = 0; m < 4; ++m) { const int row = row0 + ai * HALF + m * 16; const float gsc = gate[row] * sc; bf16_t* rowp = O + (size_t)row * ldc + col0;
#pragma unroll
                for (int bj = 0; bj < 2; ++bj) { const f32x4 v0 = acc[ai][bj][m][0] * gsc, v1 = acc[ai][bj][m][1] * gsc;
                    u32x4 w; w.x = cvt_pk_bf16(v0[0], v0[1]); w.y = cvt_pk_bf16(v0[2], v0[3]); w.z = cvt_pk_bf16(v1[0], v1[1]); w.w = cvt_pk_bf16(v1[2], v1[3]);
                    *(u32x4*)(rowp + bj * HALF) = w; } }
    }
};

typedef int v8i_t __attribute__((ext_vector_type(8)));
typedef int v4i_t __attribute__((ext_vector_type(4)));
template <class Epi, class Sched, bool ALIGN_EPI = false, bool SP2 = false, bool FP8 = false>
__device__ __forceinline__ void gemm_phase(PG8_LAS unsigned char* lds, const Gemm g, const Sched& S, const Epi& E) {
    const int tid = threadIdx.x, wid = __builtin_amdgcn_readfirstlane(tid >> 6), lane = tid & 63, wr = wid >> 2, wc = wid & 3, fr = lane & 15, fq = lane >> 4;
    const int K = g.K, nt = K / BK;
    unsigned voffA[2], voffB[2];
#pragma unroll
    for (int i = 0; i < 2; ++i) { int R, C; stage_rc(tid * 16 + i * 8192, R, C); const int Rb = Epi::PERM ? ((R & ~31) + perm32(R & 31)) : R;
        voffA[i] = (unsigned)(R * g.lda + C) * 2u; voffB[i] = (unsigned)(Rb * K + C) * 2u; }
    const size_t kstep = (size_t)(BK * 2);
    const size_t hstepA = (size_t)HALF * g.lda * 2, tstepA = 2 * hstepA;
    const size_t hstepB = (size_t)HALF * K * 2, tstepB = 2 * hstepB;
    const unsigned ldsw = (unsigned)wid * 1024u;
    const int aoff = lds_byte(wr * 64 + fr, fq * 8), boff = lds_byte(wc * 32 + fr, fq * 8);
#define PG8_SA(b, h) (((b) * 2 + (h)) * HTB)
#define PG8_SB(b, h) ((4 + (b) * 2 + (h)) * HTB)
#define PG8_STAGE(bufoff, gbase, voff) do { _Pragma("unroll") for (int _i = 0; _i < 2; ++_i) \
        __builtin_amdgcn_global_load_lds((const unsigned*)((const char*)(gbase) + (voff)[_i]), (PG8_LAS unsigned*)(lds + (bufoff) + ldsw + _i * 8192), 16, 0, 0); } while (0)
#define PG8_LDA(dst, b, h) do { if constexpr (FP8) { _Pragma("unroll") for (int m = 0; m < 4; ++m) dst##8[m] = __builtin_shufflevector(*(const PG8_LAS v4i_t*)(lds + PG8_SA(b, h) + aoff + m * 2048), *(const PG8_LAS v4i_t*)(lds + PG8_SA(b, h) + aoff + m * 2048 + 1024), 0, 1, 2, 3, 4, 5, 6, 7); } \
    else { _Pragma("unroll") for (int m = 0; m < 4; ++m) _Pragma("unroll") for (int k = 0; k < 2; ++k) dst[m][k] = *(const PG8_LAS bf16x8*)(lds + PG8_SA(b, h) + aoff + m * 2048 + k * 1024); } } while (0)
#define PG8_LDB(dst, b, h) do { if constexpr (FP8) { _Pragma("unroll") for (int n = 0; n < 2; ++n) dst##8[n] = __builtin_shufflevector(*(const PG8_LAS v4i_t*)(lds + PG8_SB(b, h) + boff + n * 2048), *(const PG8_LAS v4i_t*)(lds + PG8_SB(b, h) + boff + n * 2048 + 1024), 0, 1, 2, 3, 4, 5, 6, 7); } \
    else { _Pragma("unroll") for (int n = 0; n < 2; ++n) _Pragma("unroll") for (int k = 0; k < 2; ++k) dst[n][k] = *(const PG8_LAS bf16x8*)(lds + PG8_SB(b, h) + boff + n * 2048 + k * 1024); } } while (0)
#define PG8_MMA(ai, bj, At, Bt) do { __builtin_amdgcn_s_setprio(1); _Pragma("unroll") for (int m = 0; m < 4; ++m) _Pragma("unroll") for (int n = 0; n < 2; ++n) { \
        if constexpr (FP8) { asm volatile("v_mfma_scale_f32_16x16x128_f8f6f4 %0, %1, %2, %0, %3, %3 op_sel_hi:[0,0,0]" : "+v"(acc[ai][bj][m][n]) : "v"(Bt##8[n]), "v"(At##8[m]), "v"(sc1)); } \
        else { _Pragma("unroll") for (int k = 0; k < 2; ++k) acc[ai][bj][m][n] = __builtin_amdgcn_mfma_f32_16x16x32_bf16(Bt[n][k], At[m][k], acc[ai][bj][m][n], 0, 0, 0); } } \
        __builtin_amdgcn_s_setprio(0); } while (0)
#define PG8_WAIT_V(n) asm volatile("s_waitcnt vmcnt(" #n ")" ::: "memory")
#define PG8_WAIT_L(n) asm volatile("s_waitcnt lgkmcnt(" #n ")" ::: "memory")
#define PG8_BAR __builtin_amdgcn_s_barrier()
#define PG8_SCHED __builtin_amdgcn_sched_barrier(0)
    Unit cur, nxt; int ui = 0;
    if (!S.next(0, cur)) return;
    f32x4 acc[2][2][4][2];
#pragma unroll
    for (int a = 0; a < 2; ++a)
#pragma unroll
        for (int b = 0; b < 2; ++b)
#pragma unroll
            for (int m = 0; m < 4; ++m)
#pragma unroll
                for (int n = 0; n < 2; ++n) acc[a][b][m][n] = (f32x4){0.f, 0.f, 0.f, 0.f};
    bf16x8 At[4][2], B0[2][2], B1[2][2]; v8i_t At8[4], B08[2], B18[2]; const int sc1 = 0x7f7f7f7f;
    const char* cA = (const char*)g.A + (size_t)cur.pm * tstepA; const char* cB = (const char*)g.Bt + (size_t)cur.pn * tstepB + (size_t)(cur.pm / g.pmg) * g.bgs;
    S.a_ready(cur);
    if constexpr (SP2) {
        PG8_STAGE(PG8_SB(0, 0), cB, voffB); PG8_STAGE(PG8_SB(0, 1), cB + hstepB, voffB); PG8_STAGE(PG8_SA(0, 0), cA, voffA); PG8_STAGE(PG8_SA(0, 1), cA + hstepA, voffA);
        if (wr == 1) PG8_BAR;
        PG8_WAIT_V(2); PG8_BAR;
        PG8_STAGE(PG8_SB(1, 0), cB + kstep, voffB); PG8_STAGE(PG8_SA(1, 0), cA + kstep, voffA); PG8_STAGE(PG8_SB(1, 1), cB + hstepB + kstep, voffB);
        PG8_WAIT_V(6); PG8_BAR;
    } else {
        PG8_STAGE(PG8_SB(0, 0), cB, voffB); PG8_STAGE(PG8_SA(0, 0), cA, voffA); PG8_STAGE(PG8_SB(0, 1), cB + hstepB, voffB); PG8_STAGE(PG8_SA(0, 1), cA + hstepA, voffA);
        if (wr == 1) PG8_BAR;
        PG8_WAIT_V(4); PG8_BAR;
        PG8_STAGE(PG8_SB(1, 0), cB + kstep, voffB); PG8_STAGE(PG8_SA(1, 0), cA + kstep, voffA); PG8_STAGE(PG8_SB(1, 1), cB + hstepB + kstep, voffB);
        PG8_WAIT_V(6); PG8_BAR;
    }
    for (;;) {
        const bool has_next = S.next(ui + 1, nxt);
        const char* nA = has_next ? (const char*)g.A + (size_t)nxt.pm * tstepA : cA;
        const char* nB = has_next ? (const char*)g.Bt + (size_t)nxt.pn * tstepB + (size_t)(nxt.pm / g.pmg) * g.bgs : cB;
        for (int t = 0; t < nt; t += 2) {
            const bool last = (t == nt - 2);
            const char* a1 = cA + (size_t)(t + 1) * kstep;
            const char* a2 = last ? nA : cA + (size_t)(t + 2) * kstep; const char* b2 = last ? nB : cB + (size_t)(t + 2) * kstep;
            const char* a3 = a2 + kstep; const char* b3 = b2 + kstep;
            if (last && has_next) S.a_ready(nxt);
            if constexpr (SP2) {
            PG8_LDB(B0, 0, 0); PG8_LDB(B1, 0, 1); PG8_SCHED; PG8_LDA(At, 0, 0); PG8_STAGE(PG8_SA(1, 1), a1 + hstepA, voffA);
            PG8_WAIT_V(8); PG8_WAIT_L(0); PG8_BAR; PG8_MMA(0, 0, At, B0); PG8_MMA(0, 1, At, B1); PG8_BAR; PG8_SCHED;
            PG8_LDA(At, 0, 1); PG8_STAGE(PG8_SB(0, 0), b2, voffB); PG8_STAGE(PG8_SB(0, 1), b2 + hstepB, voffB); PG8_STAGE(PG8_SA(0, 0), a2, voffA);
            PG8_WAIT_V(8); PG8_WAIT_L(0); PG8_BAR; PG8_MMA(1, 0, At, B0); PG8_MMA(1, 1, At, B1); PG8_BAR; PG8_SCHED;
            PG8_LDB(B0, 1, 0); PG8_LDB(B1, 1, 1); PG8_SCHED; PG8_LDA(At, 1, 0); PG8_STAGE(PG8_SA(0, 1), a2 + hstepA, voffA);
            PG8_WAIT_V(8); PG8_WAIT_L(0); PG8_BAR; PG8_MMA(0, 0, At, B0); PG8_MMA(0, 1, At, B1); PG8_BAR; PG8_SCHED;
            PG8_LDA(At, 1, 1); PG8_STAGE(PG8_SB(1, 0), b3, voffB); PG8_STAGE(PG8_SB(1, 1), b3 + hstepB, voffB); PG8_STAGE(PG8_SA(1, 0), a3, voffA);
            PG8_WAIT_V(8); PG8_WAIT_L(0); PG8_BAR; PG8_MMA(1, 0, At, B0); PG8_MMA(1, 1, At, B1); PG8_BAR; PG8_SCHED;
            } else {
            PG8_LDB(B0, 0, 0); PG8_SCHED; PG8_LDA(At, 0, 0); PG8_STAGE(PG8_SA(1, 1), a1 + hstepA, voffA);
            PG8_WAIT_L(8); PG8_BAR; PG8_WAIT_L(0); PG8_MMA(0, 0, At, B0); PG8_BAR; PG8_SCHED;
            PG8_LDB(B1, 0, 1); PG8_STAGE(PG8_SB(0, 0), b2, voffB);
            PG8_BAR; PG8_WAIT_L(0); PG8_MMA(0, 1, At, B1); PG8_BAR;
            PG8_LDA(At, 0, 1); PG8_STAGE(PG8_SA(0, 0), a2, voffA);
            PG8_BAR; PG8_WAIT_L(0); PG8_MMA(1, 0, At, B0); PG8_BAR; PG8_SCHED;
            PG8_STAGE(PG8_SB(0, 1), b2 + hstepB, voffB);
            PG8_WAIT_V(6); PG8_BAR; PG8_MMA(1, 1, At, B1); PG8_BAR;
            PG8_LDB(B0, 1, 0); PG8_SCHED; PG8_LDA(At, 1, 0); PG8_STAGE(PG8_SA(0, 1), a2 + hstepA, voffA);
            PG8_WAIT_L(8); PG8_BAR; PG8_WAIT_L(0); PG8_MMA(0, 0, At, B0); PG8_BAR; PG8_SCHED;
            PG8_LDB(B1, 1, 1); PG8_STAGE(PG8_SB(1, 0), b3, voffB);
            PG8_BAR; PG8_WAIT_L(0); PG8_MMA(0, 1, At, B1); PG8_BAR;
            PG8_LDA(At, 1, 1); PG8_STAGE(PG8_SA(1, 0), a3, voffA);
            PG8_BAR; PG8_WAIT_L(0); PG8_MMA(1, 0, At, B0); PG8_BAR; PG8_SCHED;
            PG8_STAGE(PG8_SB(1, 1), b3 + hstepB, voffB);
            PG8_WAIT_V(6); PG8_BAR; PG8_MMA(1, 1, At, B1); PG8_BAR;
            }
        }
        if constexpr (ALIGN_EPI) { if (wr == 0) PG8_BAR; }
        if constexpr (FP8) asm volatile("s_nop 15\n\ts_nop 15" ::: "memory");
        E(acc, cur, wr, wc, fr, fq); S.done(cur);
        if (!has_next) break;
#pragma unroll
        for (int a = 0; a < 2; ++a)
#pragma unroll
            for (int b = 0; b < 2; ++b)
#pragma unroll
                for (int m = 0; m < 4; ++m)
#pragma unroll
                    for (int n = 0; n < 2; ++n) acc[a][b][m][n] = (f32x4){0.f, 0.f, 0.f, 0.f};
        cur = nxt; cA = nA; cB = nB; ++ui;
        if constexpr (FP8) asm volatile("s_nop 7" ::: "memory");
        if constexpr (ALIGN_EPI) { if (wr == 1) PG8_BAR; }
    }
    PG8_WAIT_V(0);
    if constexpr (!ALIGN_EPI) { if (wr == 0) PG8_BAR; }
    PG8_BAR;
#undef PG8_SA
#undef PG8_SB
#undef PG8_STAGE
#undef PG8_LDA
#undef PG8_LDB
#undef PG8_MMA
#undef PG8_WAIT_V
#undef PG8_WAIT_L
#undef PG8_BAR
#undef PG8_SCHED
}
}

constexpr int NWAVES = 8, NTHR = 512;
constexpr int NB = 4, T = 8192, D = 1024, LC = 256, GW = 64, GH = 128;
constexpr int MT = NB * T, MC = NB * LC, MA = MT + MC;
constexpr int PIN = 5504, PINP = 5632;
constexpr int ZQ = 0, ZK = 512, ZV = 1024, ZRW = 1536, ZR = 1536, ZRK = 2048, ZRV = 2560, ZLORA = 3072, ZG = 3456, ZGNA = 3456, ZGRW = 4480;
constexpr int NE = 16, CAP = 1024, DE = 2816, NSLOT = NB * NE * CAP;
constexpr float ALPHA = 1.189207115f;
constexpr float LN_EPS = 1e-6f, GN_EPS = 64e-5f;
constexpr int LORAW = 2560;

constexpr size_t MiB = 1u << 20;
constexpr size_t WS_CTL = 0, CTL_ZERO_BYTES = 1 * MiB;
constexpr size_t WS_MOD = 1 * MiB;
constexpr size_t WS_WIN = 2 * MiB;
constexpr size_t WS_WPA = 13 * MiB, WS_WPR = 14 * MiB, WS_WO = 15 * MiB;
constexpr size_t WS_AFF = 17 * MiB;
constexpr size_t WS_IDX = 19 * MiB;
constexpr size_t WS_GATEV = 19 * MiB + 256 * 1024;
constexpr size_t WS_SLOT = 20 * MiB;
constexpr size_t WS_U = 22 * MiB;
constexpr size_t WS_Z = 88 * MiB;
constexpr size_t WS_LORA = 451 * MiB;
constexpr size_t WS_ROPE = 1 * MiB + 128 * 1024;
constexpr size_t WS_LW = 1 * MiB + 512 * 1024;
constexpr size_t WS_COEF = 17 * MiB;
constexpr size_t WS_YFB = 22 * MiB;
constexpr size_t WS_PQ = 451 * MiB;
constexpr size_t WS_G = 583 * MiB;
constexpr size_t WS_VT = 616 * MiB;
constexpr size_t WS_END1 = 616 * MiB;
constexpr size_t WS_U2 = 22 * MiB;
constexpr size_t WS_W13 = 54 * MiB;
constexpr size_t WS_W2 = 654 * MiB;
constexpr size_t WS_XS = 186 * MiB;
constexpr size_t WS_HDN = 250 * MiB;
constexpr size_t WS_YE = 426 * MiB;
constexpr float W13_SCALE = 64.f, W2_SCALE = 128.f, HDN_SCALE = 8.f;
constexpr size_t WS_END = 698 * MiB;
constexpr int W2_EARLY_TILES = 256 * 12;
static_assert(WS_VT + (size_t)34 * MiB <= WS_END, "ws map");
constexpr size_t VT_LAT_ELEMS = (size_t)NB * 8 * 64 * T, VT_CTX_ELEMS = (size_t)NB * 8 * 64 * LC;

constexpr int RING_BYTES = 131072, LDS_BYTES = 147456, LDSCTL_OFF = LDS_BYTES - 512, MISC_OFF = LDSCTL_OFF + 320;

#define GAS __attribute__((address_space(1)))
#define LAS __attribute__((address_space(3)))
typedef unsigned short bf16;
typedef unsigned v4u __attribute__((ext_vector_type(4)));
typedef unsigned v2u __attribute__((ext_vector_type(2)));
typedef float f32x4 __attribute__((ext_vector_type(4)));
typedef float f32x2 __attribute__((ext_vector_type(2)));
typedef short bf16x8 __attribute__((ext_vector_type(8)));
typedef short bf16x4 __attribute__((ext_vector_type(4)));
typedef GAS unsigned gu32;
#define RLX_AGENT __ATOMIC_RELAXED, __HIP_MEMORY_SCOPE_AGENT
#define LDS_WAIT() asm volatile("s_waitcnt lgkmcnt(0)" ::: "memory")
#define VM_WAIT() asm volatile("s_waitcnt vmcnt(0)" ::: "memory")
__device__ __forceinline__ unsigned f2bf(float f) { return pg8::cvt_pk_bf16(f, f) & 0xffffu; }
__device__ __forceinline__ unsigned pk2(float lo, float hi) { return pg8::cvt_pk_bf16(lo, hi); }
__device__ __forceinline__ float bf2f(bf16 b) { return __uint_as_float(((unsigned)b) << 16); }
__device__ __forceinline__ float bflo(unsigned w) { return __uint_as_float(w << 16); }
__device__ __forceinline__ float bfhi(unsigned w) { return __uint_as_float(w & 0xffff0000u); }
__device__ __forceinline__ float sigm(float x) { return 1.0f / (1.0f + __expf(-x)); }

#define XB_TMO      128
#define XB_XCNT(j)  (256  + 64 * (j))
#define XB_XSUB(j)  (1280 + 64 * (j))
#define XB_XGEN(j)  (2304 + 64 * (j))
#define XB_TOP      3328
#define XB_TOPGEN   3392
#define XCD_BAR_WORDS 3456
#define XB_SPIN_CAP (1u << 18)
__device__ __forceinline__ unsigned xb_ld(unsigned* p)              { return __hip_atomic_load(p, __ATOMIC_RELAXED, __HIP_MEMORY_SCOPE_AGENT); }
__device__ __forceinline__ unsigned xb_add(unsigned* p, unsigned v) { return __hip_atomic_fetch_add(p, v, __ATOMIC_RELAXED, __HIP_MEMORY_SCOPE_AGENT); }
__device__ __forceinline__ unsigned xb_xcc_id() { return (unsigned)__builtin_amdgcn_s_getreg((3 << 11) | 20) & 0xFu; }
#define XB_SPIN(cond, bar) do { unsigned _sp = 0; while (cond) { __builtin_amdgcn_s_sleep(1); \
    if ((++_sp & 255u) == 0u) { if (xb_ld(&(bar)[XB_TMO])) break; if (_sp > XB_SPIN_CAP) { atomicAdd(&(bar)[XB_TMO], 1u); break; } } } } while (0)
struct XcdBarrier { unsigned* bar; unsigned x; volatile LAS unsigned* st; };
__device__ __forceinline__ XcdBarrier xcd_barrier_post(unsigned* bar, volatile LAS unsigned* st) {
    XcdBarrier b; b.bar = bar; b.x = xb_xcc_id(); b.st = st;
    if (threadIdx.x == 0) (void)xb_add(&bar[XB_XCNT(b.x)], 1u);
    return b;
}
__device__ __forceinline__ void xcd_barrier_complete(unsigned* bar, unsigned x, unsigned& nloc, unsigned& nx) {
    const unsigned G = gridDim.x * gridDim.y * gridDim.z;
    unsigned sum, cnt, mine, sp = 0u;
    for (;;) {
        sum = 0u; cnt = 0u; mine = 0u;
#pragma unroll
        for (unsigned j = 0; j < 16; ++j) { const unsigned c = xb_ld(&bar[XB_XCNT(j)]); sum += c; cnt += (c > 0u) ? 1u : 0u; mine = (j == x) ? c : mine; }
        if (sum == G) break;
        __builtin_amdgcn_s_sleep(1);
        if ((++sp & 255u) == 0u) { if (xb_ld(&bar[XB_TMO])) break; if (sp > XB_SPIN_CAP) { atomicAdd(&bar[XB_TMO], 1u); break; } }
    }
    nloc = mine > 0u ? mine : 1u; nx = cnt > 0u ? cnt : 1u;
}
__device__ __forceinline__ void xcd_barrier(const XcdBarrier& b) {
    asm volatile("s_waitcnt vmcnt(0)" ::: "memory");
    __syncthreads();
    if (threadIdx.x == 0) {
        unsigned* bar = b.bar;
        __builtin_amdgcn_s_waitcnt(0);
        unsigned nloc = b.st[0], nx = b.st[1];
        if (nloc == 0u) { xcd_barrier_complete(bar, b.x, nloc, nx); b.st[0] = nloc; b.st[1] = nx; }
        const unsigned old = xb_add(&bar[XB_XSUB(b.x)], 1u);
        const unsigned gen = old / nloc;
        if (old + 1u == (gen + 1u) * nloc) {
            __builtin_amdgcn_fence(__ATOMIC_RELEASE, "agent");
            asm volatile("s_waitcnt vmcnt(0)" ::: "memory");
#pragma unroll
            for (unsigned j = 0; j < 16; ++j) (void)xb_add(&bar[XB_XGEN(j)], 1u);
        }
        const unsigned target = (gen + 1u) * nx;
        XB_SPIN(xb_ld(&bar[XB_XGEN(b.x)]) < target, bar);
        __builtin_amdgcn_fence(__ATOMIC_ACQUIRE, "agent");
        asm volatile("s_waitcnt vmcnt(0)" ::: "memory");
    }
    __syncthreads();
}
constexpr int CW_BAR = 4096;

template <int CTRL> __device__ __forceinline__ float dppf(float v) { return __builtin_bit_cast(float, __builtin_amdgcn_update_dpp(0, __builtin_bit_cast(int, v), CTRL, 0xF, 0xF, true)); }
__device__ __forceinline__ float row16_sum(float v) {
    v += dppf<0xB1>(v);
    v += dppf<0x4E>(v);
    v += dppf<0x141>(v);
    v += dppf<0x140>(v);
    return v;
}

__device__ __forceinline__ float wave_sum(float v) { v = row16_sum(v); v += __shfl_xor(v, 16); v += __shfl_xor(v, 32); return v; }

__device__ __forceinline__ void unpack8(v4u w, float (&o)[8]) { o[0] = bflo(w.x); o[1] = bfhi(w.x); o[2] = bflo(w.y); o[3] = bfhi(w.y); o[4] = bflo(w.z); o[5] = bfhi(w.z); o[6] = bflo(w.w); o[7] = bfhi(w.w); }
__device__ __forceinline__ v4u pack8(const float (&v)[8]) { v4u o; o.x = pg8::cvt_pk_bf16(v[0], v[1]); o.y = pg8::cvt_pk_bf16(v[2], v[3]); o.z = pg8::cvt_pk_bf16(v[4], v[5]); o.w = pg8::cvt_pk_bf16(v[6], v[7]); return o; }
struct Frame {
    LAS unsigned char* lds;
    int tid, lane, wave, G, bid;
    const float* in[31]; float* out; unsigned char* ws;
};

__device__ __forceinline__ void transpose_item(const float* W, int N, int k0, int n0, bf16* WT, size_t dst_row0, int dpitch, LAS float* scr, int lane) {
#pragma unroll 8
    for (int i = 0; i < 32; ++i) { const int kk = 2 * i + (lane >> 5); scr[kk * 33 + (lane & 31)] = W[(size_t)(k0 + kk) * N + n0 + (lane & 31)]; }
    LDS_WAIT(); asm volatile("" ::: "memory");
    const int c = lane & 7;
#pragma unroll
    for (int j = 0; j < 4; ++j) { const int n = (lane >> 3) + 8 * j; const LAS float* s = scr + (8 * c) * 33 + n;
        v4u o; o.x = pk2(s[0 * 33], s[1 * 33]); o.y = pk2(s[2 * 33], s[3 * 33]); o.z = pk2(s[4 * 33], s[5 * 33]); o.w = pk2(s[6 * 33], s[7 * 33]);
        *(GAS v4u*)(WT + (dst_row0 + n) * dpitch + k0 + 8 * c) = o; }
    LDS_WAIT(); asm volatile("" ::: "memory");
}

__device__ __forceinline__ void cvt_tile64(const float* W, int N, int k0, int n0, bf16* WT, size_t dst_row0, int dpitch, int lane) {
    const int c = lane & 15, kq = lane >> 4;
    const float* src = W + (size_t)(k0 + 16 * kq) * N + n0 + 4 * c;
    f32x4 x[16];
#pragma unroll
    for (int j = 0; j < 16; ++j) x[j] = __builtin_nontemporal_load((const GAS f32x4*)(src + (size_t)j * N));
#pragma unroll
    for (int e = 0; e < 4; ++e) { bf16* dst = WT + (dst_row0 + 4 * c + e) * dpitch + k0 + 16 * kq;
        v4u o0, o1;
        o0.x = pg8::cvt_pk_bf16(x[0][e], x[1][e]); o0.y = pg8::cvt_pk_bf16(x[2][e], x[3][e]); o0.z = pg8::cvt_pk_bf16(x[4][e], x[5][e]); o0.w = pg8::cvt_pk_bf16(x[6][e], x[7][e]);
        o1.x = pg8::cvt_pk_bf16(x[8][e], x[9][e]); o1.y = pg8::cvt_pk_bf16(x[10][e], x[11][e]); o1.z = pg8::cvt_pk_bf16(x[12][e], x[13][e]); o1.w = pg8::cvt_pk_bf16(x[14][e], x[15][e]);
        *(GAS v4u*)dst = o0; *(GAS v4u*)(dst + 8) = o1; }
}

__device__ __forceinline__ unsigned pk4_fp8(float a, float b, float c, float d) { int w = 0; w = __builtin_amdgcn_cvt_pk_fp8_f32(a, b, w, false); w = __builtin_amdgcn_cvt_pk_fp8_f32(c, d, w, true); return (unsigned)w; }
__device__ __forceinline__ float clamp448(float x) { return fminf(fmaxf(x, -448.f), 448.f); }
__device__ __forceinline__ void cvt_tile64_fp8(const float* W, int N, int k0, int n0, unsigned char* WT, size_t dst_row0, int dpitch, float scale, int lane) {
    const int c = lane & 15, kq = lane >> 4;
    const float* src = W + (size_t)(k0 + 16 * kq) * N + n0 + 4 * c;
    f32x4 x[16];
#pragma unroll
    for (int j = 0; j < 16; ++j) x[j] = __builtin_nontemporal_load((const GAS f32x4*)(src + (size_t)j * N)) * scale;
#pragma unroll
    for (int e = 0; e < 4; ++e) { unsigned char* dst = WT + (dst_row0 + 4 * c + e) * dpitch + k0 + 16 * kq;
        v4u o; o.x = pk4_fp8(x[0][e], x[1][e], x[2][e], x[3][e]); o.y = pk4_fp8(x[4][e], x[5][e], x[6][e], x[7][e]); o.z = pk4_fp8(x[8][e], x[9][e], x[10][e], x[11][e]); o.w = pk4_fp8(x[12][e], x[13][e], x[14][e], x[15][e]);
        *(GAS v4u*)dst = o; }
}

__device__ __forceinline__ void phase_prologue(Frame& F) {
    const float* c = F.in[1]; const float* cctx = F.in[3]; const float* w_mod = F.in[4]; const float* b_mod = F.in[5];
    float* MODV = (float*)(F.ws + WS_MOD);
    if (F.bid < 96) {
        LAS float* sil = (LAS float*)F.lds;
        LAS float* part = (LAS float*)(F.lds + 5 * 1024 * 4);
        for (int e = F.tid; e < 5 * 1024; e += NTHR) { const int r = e >> 10, k = e & 1023; const float v = (r < 4) ? c[r * 1024 + k] : cctx[k]; sil[e] = v * sigm(v); }
        __syncthreads();
        const int col = F.bid * 64 + F.lane;
        { const int kq = F.lane >> 4, c4 = (F.lane & 15) * 4; f32x4 a4[5];
#pragma unroll
          for (int r = 0; r < 5; ++r) a4[r] = (f32x4){0.f, 0.f, 0.f, 0.f};
#pragma unroll 8
          for (int it = 0; it < 32; ++it) { const int k = F.wave * 128 + it * 4 + kq; const f32x4 w = *(const GAS f32x4*)(w_mod + (size_t)k * 6144 + F.bid * 64 + c4);
#pragma unroll
              for (int r = 0; r < 5; ++r) a4[r] += w * sil[r * 1024 + k]; }
#pragma unroll
          for (int r = 0; r < 5; ++r) {
#pragma unroll
              for (int j = 0; j < 4; ++j) { float v = a4[r][j]; v += __shfl_xor(v, 16); v += __shfl_xor(v, 32); a4[r][j] = v; }
              if (kq == 0) *(LAS f32x4*)(part + (F.wave * 5 + r) * 64 + c4) = a4[r]; } }
        __syncthreads();
        if (F.wave < 5) { float s = b_mod[col];
#pragma unroll
            for (int w = 0; w < 8; ++w) s += part[(w * 5 + F.wave) * 64 + F.lane];
            MODV[F.wave * 6144 + col] = s; }
        __syncthreads();
    }
    const int gw = F.bid * NWAVES + F.wave, NGW = F.G * NWAVES;
    bf16* WinT = (bf16*)(F.ws + WS_WIN); bf16* WpaT = (bf16*)(F.ws + WS_WPA); bf16* WprT = (bf16*)(F.ws + WS_WPR); bf16* WoT = (bf16*)(F.ws + WS_WO);
    bf16* WupT = (bf16*)(F.ws + WS_LW); bf16* AupT = WupT + 2 * 512 * 64; bf16* GupT = AupT + 2 * 512 * 64;
    constexpr int I_IN = 16 * (PIN / 64), I_PA = 8 * 16, I_PR = 8 * 16, I_O = 16 * 16, I_LW = 16 + 16 + 16, I_ALL = I_IN + I_PA + I_PR + I_O + I_LW;
    for (int it = gw; it < I_ALL; it += NGW) {
        int r = it;
        if (r < I_IN) { const int nb = PIN / 64; cvt_tile64(F.in[6], PIN, 64 * (r / nb), 64 * (r % nb), WinT, (size_t)64 * (r % nb), 1024, F.lane); continue; } r -= I_IN;
        if (r < I_PA) { cvt_tile64(F.in[20], 1024, 64 * (r / 16), 64 * (r % 16), WpaT, (size_t)64 * (r % 16), 512, F.lane); continue; } r -= I_PA;
        if (r < I_PR) { cvt_tile64(F.in[21], 1024, 64 * (r / 16), 64 * (r % 16), WprT, (size_t)64 * (r % 16), 512, F.lane); continue; } r -= I_PR;
        if (r < I_O) { cvt_tile64(F.in[22], 1024, 64 * (r / 16), 64 * (r % 16), WoT, (size_t)64 * (r % 16), 1024, F.lane); continue; } r -= I_O;
        if (r < 16) { cvt_tile64(F.in[11] + (size_t)(r >> 3) * 64 * 512, 512, 0, 64 * (r & 7), WupT + (size_t)(r >> 3) * 512 * 64, (size_t)64 * (r & 7), 64, F.lane); continue; } r -= 16;
        if (r < 16) { cvt_tile64(F.in[13] + (size_t)(r >> 3) * 64 * 512, 512, 0, 64 * (r & 7), AupT + (size_t)(r >> 3) * 512 * 64, (size_t)64 * (r & 7), 64, F.lane); continue; } r -= 16;
        cvt_tile64(F.in[14], 512, 64 * (r >> 3), 64 * (r & 7), GupT, (size_t)64 * (r & 7), 128, F.lane);
    }
    { float* tab = (float*)(F.ws + WS_ROPE); const int i = F.bid * NTHR + F.tid;
      if (i < 128 * 16) { const float ang = (float)(i >> 4) * powf(10000.0f, -(float)(i & 15) / 16.0f); float sn, cs; sincosf(ang, &sn, &cs); tab[2 * i] = cs; tab[2 * i + 1] = sn; } }
    { GAS v4u* z = (GAS v4u*)(WinT + (size_t)PIN * 1024); const int n16 = (PINP - PIN) * 1024 * 2 / 16;
      for (int i = F.bid * NTHR + F.tid; i < n16; i += F.G * NTHR) z[i] = (v4u){0u, 0u, 0u, 0u}; }
}

__device__ __forceinline__ void phase_ln_mod(Frame& F) {
    const float* MODV = (const float*)(F.ws + WS_MOD);
    bf16* U = (bf16*)(F.ws + WS_U);
    const int gw = F.bid * NWAVES + F.wave, NGW = F.G * NWAVES;
    f32x4 nx[4];
    if (gw < MA) { const GAS f32x4* xr = (const GAS f32x4*)((gw < MT) ? F.in[0] + (size_t)gw * D : F.in[2] + (size_t)(gw - MT) * D) + F.lane;
#pragma unroll
        for (int j = 0; j < 4; ++j) nx[j] = xr[64 * j]; }
    for (int m = gw; m < MA; m += NGW) {
        const int mr = (m < MT) ? (m / T) : 4;
        const float* sh = MODV + mr * 6144; const float* sc = sh + 1024;
        f32x4 v[4]; float s = 0.f;
#pragma unroll
        for (int j = 0; j < 4; ++j) { v[j] = nx[j]; s += (v[j].x + v[j].y) + (v[j].z + v[j].w); }
        { const int mn = m + NGW; if (mn < MA) { const GAS f32x4* xr = (const GAS f32x4*)((mn < MT) ? F.in[0] + (size_t)mn * D : F.in[2] + (size_t)(mn - MT) * D) + F.lane;
#pragma unroll
            for (int j = 0; j < 4; ++j) nx[j] = xr[64 * j]; } }
        const float mean = wave_sum(s) * (1.f / D); float s2 = 0.f;
#pragma unroll
        for (int j = 0; j < 4; ++j) { v[j] = v[j] - mean; s2 += (v[j].x * v[j].x + v[j].y * v[j].y) + (v[j].z * v[j].z + v[j].w * v[j].w); }
        const float rstd = 1.f / sqrtf(wave_sum(s2) * (1.f / D) + LN_EPS);
        GAS unsigned long long* o8 = (GAS unsigned long long*)(U + (size_t)m * D) + F.lane;
#pragma unroll
        for (int j = 0; j < 4; ++j) { const f32x4 a = *((const f32x4*)sc + F.lane + 64 * j), b = *((const f32x4*)sh + F.lane + 64 * j);
            const f32x4 o = v[j] * rstd * (a + 1.0f) + b;
            o8[64 * j] = (unsigned long long)pk2(o.x, o.y) | ((unsigned long long)pk2(o.z, o.w) << 32); }
    }
}

__device__ __forceinline__ void phase_rope_vt(Frame& F) {
    bf16* Z = (bf16*)(F.ws + WS_Z);
    const int gw = F.bid * NWAVES + F.wave, NGW = F.G * NWAVES;
    {
        const int fh = F.lane & 1, a = (F.lane >> 1) & 1, h = (F.lane >> 2) & 7, w = F.lane >> 5;
        const float* tab = (const float*)(F.ws + WS_ROPE);
        for (int m = gw; m < MT; m += NGW) {
            const int t = m % T; const int pos = a ? (t % GW) : (t / GW);
            bf16* p1 = Z + (size_t)m * PINP + w * 512 + h * 64 + a * 32 + fh * 8;
            float x1[8], x2[8], o1[8], o2[8];
            unpack8(*(const GAS v4u*)p1, x1); unpack8(*(const GAS v4u*)(p1 + 16), x2);
            const f32x4* tp = (const f32x4*)(tab + (size_t)(pos * 16 + fh * 8) * 2);
#pragma unroll
            for (int j2 = 0; j2 < 4; ++j2) { const f32x4 cs2 = tp[j2];
                o1[2 * j2] = x1[2 * j2] * cs2.x - x2[2 * j2] * cs2.y; o2[2 * j2] = x2[2 * j2] * cs2.x + x1[2 * j2] * cs2.y;
                o1[2 * j2 + 1] = x1[2 * j2 + 1] * cs2.z - x2[2 * j2 + 1] * cs2.w; o2[2 * j2 + 1] = x2[2 * j2 + 1] * cs2.z + x1[2 * j2 + 1] * cs2.w; }
            *(GAS v4u*)p1 = pack8(o1); *(GAS v4u*)(p1 + 16) = pack8(o2);
        }
    }
    {
        bf16* VT = (bf16*)(F.ws + WS_VT); bf16* VTC = VT + VT_LAT_ELEMS;
        LAS bf16* scr = (LAS bf16*)(F.lds + F.wave * 16384);
        constexpr int NI_LAT = (MT / 64) * 8, NI = NI_LAT + (MC / 64) * 8;
        for (int it = gw; it < NI; it += NGW) {
            const bool lat = it < NI_LAT; const int r = lat ? it : it - NI_LAT;
            const int h = r & 7, tb = r >> 3;
            const int row0 = (lat ? 0 : MT) + tb * 64;
            const int b = lat ? (tb * 64) / T : (tb * 64) / LC, t0 = lat ? (tb * 64) % T : (tb * 64) % LC;
#pragma unroll 8
            for (int i = 0; i < 32; ++i) { const int tok = 2 * i + (F.lane >> 5); const unsigned w = *(const GAS unsigned*)(Z + (size_t)(row0 + tok) * PINP + ZV + h * 64 + 2 * (F.lane & 31));
                scr[tok * 66 + 2 * (F.lane & 31)] = (bf16)(w & 0xffff); scr[tok * 66 + 2 * (F.lane & 31) + 1] = (bf16)(w >> 16); }
            LDS_WAIT(); asm volatile("" ::: "memory");
            if (lat) {
                bf16* dst = VT + ((size_t)(b * 8 + h) * (T / 4) + (t0 >> 2)) * 256;
#pragma unroll
                for (int j = 0; j < 8; ++j) { const int g = 2 * j + (F.lane >> 5), dh = 2 * (F.lane & 31); const LAS bf16* s0 = scr + (4 * g) * 66 + dh;
                    v4u o; o.x = (unsigned)s0[0] | ((unsigned)s0[66] << 16); o.y = (unsigned)s0[2 * 66] | ((unsigned)s0[3 * 66] << 16);
                    o.z = (unsigned)s0[1] | ((unsigned)s0[66 + 1] << 16); o.w = (unsigned)s0[2 * 66 + 1] | ((unsigned)s0[3 * 66 + 1] << 16);
                    *(GAS v4u*)(dst + (size_t)(j * 64 + F.lane) * 8) = o; }
            } else {
                bf16* dst = VTC + ((size_t)(b * 8 + h) * 64) * LC + t0;
                const int c = F.lane & 7;
#pragma unroll
                for (int j = 0; j < 8; ++j) { const int dh = (F.lane >> 3) + 8 * j; const LAS bf16* s = scr + (8 * c) * 66 + dh;
                    v4u o; o.x = (unsigned)s[0] | ((unsigned)s[66] << 16); o.y = (unsigned)s[2 * 66] | ((unsigned)s[3 * 66] << 16); o.z = (unsigned)s[4 * 66] | ((unsigned)s[5 * 66] << 16); o.w = (unsigned)s[6 * 66] | ((unsigned)s[7 * 66] << 16);
                    *(GAS v4u*)(dst + (size_t)dh * LC + 8 * c) = o; }
            }
            LDS_WAIT(); asm volatile("" ::: "memory");
        }
    }
}

constexpr int NA_KP = 72, NA_VP = 264;
__device__ __forceinline__ void na_wave_task(Frame& F, int task, LAS float* rpbs, const LAS bf16* ck, const LAS bf16* cvt, int ocol = ZQ) {
    bf16* Z = (bf16*)(F.ws + WS_Z);
    const bf16* VT = (const bf16*)(F.ws + WS_VT);
    const int jq = task & 3, h = (task >> 2) & 7, i = (task >> 5) & 127, b = task >> 12;
    const int rs = min(max(i - 4, 0), GH - 8);
    const int cb = (jq == 0) ? 0 : (jq == 1) ? 8 : (jq == 2) ? 24 : 32;
    const int qi = F.lane & 15, qd = F.lane >> 4;
    const int j = jq * 16 + qi, cs = min(max(j - 8, 0), GW - 16);
    const size_t qrow = (size_t)b * T + i * GW + j;
    const bf16x8 q0 = *(const GAS bf16x8*)(Z + qrow * PINP + ZQ + h * 64 + qd * 8);
    const bf16x8 q1 = *(const GAS bf16x8*)(Z + qrow * PINP + ZQ + h * 64 + 32 + qd * 8);
    f32x4 s[32];
    int bidx[2][4];
#pragma unroll
    for (int half = 0; half < 2; ++half)
#pragma unroll
        for (int jj = 0; jj < 4; ++jj) { const int c = cb + half * 16 + qd * 4 + jj; const bool ok = (c >= cs) && (c < cs + 16); bidx[half][jj] = ok ? h * 465 + (rs - i + 7) * 31 + (c - j + 15) : 8 * 465; }
    LAS bf16* kb = (LAS bf16*)(F.lds + 87040 + F.wave * 4608);
    v4u kraw[4];
#pragma unroll
    for (int ii = 0; ii < 4; ++ii) kraw[ii] = *(const GAS v4u*)(Z + ((size_t)b * T + rs * GW + cb + 8 * ii + (F.lane >> 3)) * PINP + ZK + h * 64 + (F.lane & 7) * 8);
#pragma unroll
    for (int r = 0; r < 8; ++r) {
#pragma unroll
        for (int ii = 0; ii < 4; ++ii) *(LAS v4u*)(kb + (8 * ii + (F.lane >> 3)) * NA_KP + (F.lane & 7) * 8) = kraw[ii];
        if (r < 7) {
#pragma unroll
            for (int ii = 0; ii < 4; ++ii) kraw[ii] = *(const GAS v4u*)(Z + ((size_t)b * T + (rs + r + 1) * GW + cb + 8 * ii + (F.lane >> 3)) * PINP + ZK + h * 64 + (F.lane & 7) * 8); }
#pragma unroll
        for (int half = 0; half < 2; ++half) {
            const bf16x8 k0 = *(const LAS bf16x8*)(kb + (half * 16 + qi) * NA_KP + qd * 8), k1 = *(const LAS bf16x8*)(kb + (half * 16 + qi) * NA_KP + 32 + qd * 8);
            f32x4 a = (f32x4){0.f, 0.f, 0.f, 0.f};
            a = __builtin_amdgcn_mfma_f32_16x16x32_bf16(k0, q0, a, 0, 0, 0);
            a = __builtin_amdgcn_mfma_f32_16x16x32_bf16(k1, q1, a, 0, 0, 0);
#pragma unroll
            for (int jj = 0; jj < 4; ++jj) a[jj] += rpbs[bidx[half][jj] + r * 31];
            s[2 * r + half] = a; }
        __builtin_amdgcn_sched_barrier(0);
    }
#pragma unroll
    for (int tc = 0; tc < 16; ++tc) {
        const bf16x8 k0 = *(const LAS bf16x8*)(ck + (tc * 16 + qi) * NA_KP + qd * 8);
        const bf16x8 k1 = *(const LAS bf16x8*)(ck + (tc * 16 + qi) * NA_KP + 32 + qd * 8);
        f32x4 a = (f32x4){0.f, 0.f, 0.f, 0.f};
        a = __builtin_amdgcn_mfma_f32_16x16x32_bf16(k0, q0, a, 0, 0, 0);
        a = __builtin_amdgcn_mfma_f32_16x16x32_bf16(k1, q1, a, 0, 0, 0);
        s[16 + tc] = a;
        if ((tc & 1) == 1) __builtin_amdgcn_sched_barrier(0);
    }
    float mx = -1e30f;
#pragma unroll
    for (int tl = 0; tl < 32; ++tl) mx = fmaxf(fmaxf(fmaxf(s[tl][0], s[tl][1]), fmaxf(s[tl][2], s[tl][3])), mx);
    mx = fmaxf(mx, __shfl_xor(mx, 16)); mx = fmaxf(mx, __shfl_xor(mx, 32));
    float sum = 0.f; const float esc = 0.125f * 1.44269504f, mxs = mx * esc;
#pragma unroll
    for (int tl = 0; tl < 32; ++tl) {
#pragma unroll
        for (int jj = 0; jj < 4; ++jj) { const float e = __builtin_amdgcn_exp2f(__builtin_fmaf(s[tl][jj], esc, -mxs)); s[tl][jj] = e; sum += e; } }
    sum += __shfl_xor(sum, 16); sum += __shfl_xor(sum, 32);
    const float inv = 1.0f / sum;
    f32x4 o[4];
#pragma unroll
    for (int dt = 0; dt < 4; ++dt) o[dt] = (f32x4){0.f, 0.f, 0.f, 0.f};
#pragma unroll
    for (int ks = 0; ks < 16; ++ks) {
        const f32x4 p0 = s[2 * ks], p1 = s[2 * ks + 1];
        v4u pw; pw.x = pk2(p0[0], p0[1]); pw.y = pk2(p0[2], p0[3]); pw.z = pk2(p1[0], p1[1]); pw.w = pk2(p1[2], p1[3]);
        const bf16x8 pa = __builtin_bit_cast(bf16x8, pw);
        if (ks < 8) { const bf16* vb = VT + ((size_t)(b * 8 + h) * (T / 4) + (((rs + ks) * GW + cb) >> 2) + qd) * 256;
#pragma unroll
            for (int dt = 0; dt < 4; ++dt) {
                const bf16* vp = vb + (dt * 16 + qi) * 4;
                const v2u lo = *(const GAS v2u*)vp, hi = *(const GAS v2u*)(vp + 4 * 256);
                v4u vw; vw.x = lo.x; vw.y = lo.y; vw.z = hi.x; vw.w = hi.y;
                o[dt] = __builtin_amdgcn_mfma_f32_16x16x32_bf16(pa, __builtin_bit_cast(bf16x8, vw), o[dt], 0, 0, 0); } }
        else { const LAS bf16* vb = cvt + (ks - 8) * 32 + qd * 4;
#pragma unroll
            for (int dt = 0; dt < 4; ++dt) {
                const LAS bf16* vp = vb + (dt * 16 + qi) * NA_VP;
                const v2u lo = *(const LAS v2u*)vp, hi = *(const LAS v2u*)(vp + 16);
                v4u vw; vw.x = lo.x; vw.y = lo.y; vw.z = hi.x; vw.w = hi.y;
                o[dt] = __builtin_amdgcn_mfma_f32_16x16x32_bf16(pa, __builtin_bit_cast(bf16x8, vw), o[dt], 0, 0, 0); } }
        __builtin_amdgcn_sched_barrier(0);
    }
    float invq[4];
#pragma unroll
    for (int jj = 0; jj < 4; ++jj) invq[jj] = __shfl(inv, qd * 4 + jj);
#pragma unroll
    for (int dt = 0; dt < 4; ++dt)
#pragma unroll
        for (int jj = 0; jj < 4; ++jj) Z[((size_t)b * T + i * GW + jq * 16 + qd * 4 + jj) * PINP + ocol + h * 64 + dt * 16 + qi] = (bf16)f2bf(o[dt][jj] * invq[jj]);
}

constexpr int CP = 72;
constexpr int CBUF = 9216;
__device__ __forceinline__ int swz(int row, int col) { return row * 64 + (((((col >> 3) ^ (row >> 1) ^ ((row & 1) << 2)) & 7) << 3) | (col & 7)); }
constexpr int NCHK = (LC + T) / 64;
constexpr size_t PQ_UNIT = 16384, RY_UNIT = 16384;
constexpr int LDS_TOT = 15 * CBUF, LDS_CLE = LDS_TOT + 2048, LDS_MU = LDS_CLE + 256 + 2048;
#define CB(i) ((LAS bf16*)(F.lds + (i) * CBUF))
__device__ __forceinline__ bf16x8 ldsfrag(const LAS bf16* base, int row, int col) { return *(const LAS bf16x8*)(base + swz(row, col)); }
template <int MODE = 0> __device__ __forceinline__ void mm2(const LAS bf16* X, const LAS bf16* Y, int mt0, int nt, int r, int q, f32x4 (&acc)[2]) {
    if (MODE == 1) return;
    const bf16x8 y0 = ldsfrag(Y, 16 * nt + r, 8 * q), y1 = ldsfrag(Y, 16 * nt + r, 32 + 8 * q);
#pragma unroll
    for (int t = 0; t < 2; ++t) { const bf16x8 x0 = ldsfrag(X, 16 * (mt0 + t) + r, 8 * q), x1 = ldsfrag(X, 16 * (mt0 + t) + r, 32 + 8 * q);
        acc[t] = __builtin_amdgcn_mfma_f32_16x16x32_bf16(x0, y0, acc[t], 0, 0, 0); acc[t] = __builtin_amdgcn_mfma_f32_16x16x32_bf16(x1, y1, acc[t], 0, 0, 0); }
}
struct FragX { bf16x8 a[2][2]; };
struct FragY { bf16x8 b[2]; };
template <int MODE = 0> __device__ __forceinline__ FragX ldX(const LAS bf16* X, int mt0, int r, int q) { FragX f;
#pragma unroll
    for (int t = 0; t < 2; ++t) { if (MODE == 1) { f.a[t][0] = f.a[t][1] = (bf16x8){0, 0, 0, 0, 0, 0, 0, 0}; } else { f.a[t][0] = ldsfrag(X, 16 * (mt0 + t) + r, 8 * q); f.a[t][1] = ldsfrag(X, 16 * (mt0 + t) + r, 32 + 8 * q); } }
    return f; }
template <int MODE = 0> __device__ __forceinline__ FragY ldY(const LAS bf16* Y, int nt, int r, int q) { FragY f;
    if (MODE == 1) { f.b[0] = f.b[1] = (bf16x8){0, 0, 0, 0, 0, 0, 0, 0}; } else { f.b[0] = ldsfrag(Y, 16 * nt + r, 8 * q); f.b[1] = ldsfrag(Y, 16 * nt + r, 32 + 8 * q); }
    return f; }
template <int MODE = 0> __device__ __forceinline__ void mmf(const FragX& x, const FragY& y, f32x4 (&acc)[2]) {
    if (MODE == 1) return;
#pragma unroll
    for (int k = 0; k < 2; ++k)
#pragma unroll
        for (int t = 0; t < 2; ++t) acc[t] = __builtin_amdgcn_mfma_f32_16x16x32_bf16(x.a[t][k], y.b[k], acc[t], 0, 0, 0);
}
__device__ __forceinline__ v2u pack4(f32x4 v) { v2u o; o.x = pg8::cvt_pk_bf16(v[0], v[1]); o.y = pg8::cvt_pk_bf16(v[2], v[3]); return o; }
__device__ __forceinline__ f32x4 unpack4(v2u w) { return (f32x4){bflo(w.x), bfhi(w.x), bflo(w.y), bfhi(w.y)}; }
__device__ __forceinline__ void stT(LAS bf16* O, int mt, int nt, int r, int q, f32x4 v) { *(LAS v2u*)(O + swz(16 * nt + r, 16 * mt + 4 * q)) = pack4(v); }
__device__ __forceinline__ void stR(LAS bf16* O, int mt, int nt, int r, int q, f32x4 v) {
#pragma unroll
    for (int jj = 0; jj < 4; ++jj) O[swz(16 * mt + 4 * q + jj, 16 * nt + r)] = (bf16)f2bf(v[jj]); }
__device__ __forceinline__ f32x4 ldT(const LAS bf16* O, int mt, int nt, int r, int q) { return unpack4(*(const LAS v2u*)(O + swz(16 * nt + r, 16 * mt + 4 * q))); }
#define Z2 {(f32x4){0.f, 0.f, 0.f, 0.f}, (f32x4){0.f, 0.f, 0.f, 0.f}}
__device__ __forceinline__ float tanh_fast(float x) { return 1.0f - 2.0f * __builtin_amdgcn_rcpf(1.0f + __expf(2.0f * x)); }
__device__ __forceinline__ bf16 f2bf_hw(float x) { return (bf16)(pg8::cvt_pk_bf16(x, x) & 0xffffu); }
__device__ __forceinline__ void shift8(const bf16* zp, bool hasp, bool hasn, const float* mup, const float* mun, float (&o)[8]) {
    float z[8], a[8], b[8];
    unpack8(*(const GAS v4u*)zp, z);
    unpack8(hasp ? *(const GAS v4u*)(zp - PINP) : (v4u){0u, 0u, 0u, 0u}, a);
    unpack8(hasn ? *(const GAS v4u*)(zp + PINP) : (v4u){0u, 0u, 0u, 0u}, b);
    const f32x4 p0 = *(const f32x4*)mup, p1 = *(const f32x4*)(mup + 4), n0 = *(const f32x4*)mun, n1 = *(const f32x4*)(mun + 4);
#pragma unroll
    for (int e = 0; e < 8; ++e) { const float mp = e < 4 ? p0[e & 3] : p1[e & 3], mn = e < 4 ? n0[e & 3] : n1[e & 3]; o[e] = z[e] + mp * (a[e] - z[e]) + mn * (b[e] - z[e]); }
}
__device__ __forceinline__ void shift8u(const char* zu, unsigned zo, bool hasp, bool hasn, const char* mup, const char* mun, unsigned mo, float (&o)[8]) {
    float z[8], a[8], b[8];
    unpack8(*(const GAS v4u*)(zu + zo), z);
    unpack8(hasp ? *(const GAS v4u*)(zu - PINP * 2 + zo) : (v4u){0u, 0u, 0u, 0u}, a);
    unpack8(hasn ? *(const GAS v4u*)(zu + PINP * 2 + zo) : (v4u){0u, 0u, 0u, 0u}, b);
    const f32x4 p0 = *(const GAS f32x4*)(mup + mo), p1 = *(const GAS f32x4*)(mup + 16 + mo), n0 = *(const GAS f32x4*)(mun + mo), n1 = *(const GAS f32x4*)(mun + 16 + mo);
#pragma unroll
    for (int e = 0; e < 8; ++e) { const float mp = e < 4 ? p0[e & 3] : p1[e & 3], mn = e < 4 ? n0[e & 3] : n1[e & 3]; o[e] = z[e] + mp * (a[e] - z[e]) + mn * (b[e] - z[e]); }
}
__device__ __forceinline__ void shift8l(const char* zu, unsigned zo, bool hasp, bool hasn, const LAS float* mup, const LAS float* mun, float (&o)[8]) {
    float z[8], a[8], b[8];
    unpack8(*(const GAS v4u*)(zu + zo), z);
    unpack8(hasp ? *(const GAS v4u*)(zu - PINP * 2 + zo) : (v4u){0u, 0u, 0u, 0u}, a);
    unpack8(hasn ? *(const GAS v4u*)(zu + PINP * 2 + zo) : (v4u){0u, 0u, 0u, 0u}, b);
    const f32x4 p0 = *(const LAS f32x4*)mup, p1 = *(const LAS f32x4*)(mup + 4), n0 = *(const LAS f32x4*)mun, n1 = *(const LAS f32x4*)(mun + 4);
#pragma unroll
    for (int e = 0; e < 8; ++e) { const float mp = e < 4 ? p0[e & 3] : p1[e & 3], mn = e < 4 ? n0[e & 3] : n1[e & 3]; o[e] = z[e] + mp * (a[e] - z[e]) + mn * (b[e] - z[e]); }
}
struct Raw3 { v4u z, a, b; };
__device__ __forceinline__ void dma_tile(const char* gbase, unsigned zo, unsigned lds_tile, int wave, int lane) {
    const unsigned m0a = lds_tile + (unsigned)wave * 1024u;
    asm volatile("s_mov_b32 m0, %0\n\ts_nop 0\n\tglobal_load_lds_dwordx4 %1, %2" :: "s"(m0a), "v"(zo), "s"(gbase) : "memory", "m0");
    if (wave == 0) { if (lane < 16) { const char* g2 = gbase + (size_t)64 * PINP * 2; const unsigned m0b = lds_tile + 8192u;
        asm volatile("s_mov_b32 m0, %0\n\ts_nop 0\n\tglobal_load_lds_dwordx4 %1, %2" :: "s"(m0b), "v"(zo), "s"(g2) : "memory", "m0"); } }
}
__device__ __forceinline__ Raw3 rd3(const LAS unsigned char* tile, int t1, int k8) { Raw3 w; const LAS unsigned char* p = tile + t1 * 128 + k8 * 2;
    w.a = *(const LAS v4u*)p; w.z = *(const LAS v4u*)(p + 128); w.b = *(const LAS v4u*)(p + 256); return w; }
__device__ __forceinline__ Raw3 ld3(const char* zu, unsigned zo) { Raw3 w; w.z = *(const GAS v4u*)(zu + zo); w.a = *(const GAS v4u*)(zu - PINP * 2 + zo); w.b = *(const GAS v4u*)(zu + PINP * 2 + zo); return w; }
__device__ __forceinline__ void mix8(const Raw3& w, bool hasp, bool hasn, const LAS float* mup, const LAS float* mun, float (&o)[8]) {
    float z[8], a[8], b[8];
    unpack8(w.z, z); unpack8(hasp ? w.a : (v4u){0u, 0u, 0u, 0u}, a); unpack8(hasn ? w.b : (v4u){0u, 0u, 0u, 0u}, b);
    const f32x4 p0 = *(const LAS f32x4*)mup, p1 = *(const LAS f32x4*)(mup + 4), n0 = *(const LAS f32x4*)mun, n1 = *(const LAS f32x4*)(mun + 4);
#pragma unroll
    for (int e = 0; e < 8; ++e) { const float mp = e < 4 ? p0[e & 3] : p1[e & 3], mn = e < 4 ? n0[e & 3] : n1[e & 3]; o[e] = z[e] + mp * (a[e] - z[e]) + mn * (b[e] - z[e]); }
}
#define VMW(n) asm volatile("s_waitcnt vmcnt(" #n ")" ::: "memory")
__device__ __forceinline__ float sum8(float v) { v += dppf<0xB1>(v); v += dppf<0x4E>(v); v += dppf<0x141>(v); return v; }

__device__ __forceinline__ int afrag_off(int row, int col) { return ((((row >> 4) * 2 + (col >> 5)) * 64 + ((col >> 2) & 3) * 16 + (row & 15)) << 3) + ((col >> 4) & 1) * 4 + (col & 3); }
__device__ __forceinline__ int cfrag_off(int n, int m) { return ((((n >> 4) * 4 + (m >> 4)) * 64 + ((m >> 2) & 3) * 16 + (n & 15)) << 2) + (m & 3); }
template <int MODE> __device__ __forceinline__ void rwkvA_unit(Frame& F, int u, int& hl, int pre, int un) {
    int lane_ = F.lane, tid_ = F.tid; asm volatile("" : "+v"(lane_), "+v"(tid_));
    const bf16* Z = (const bf16*)(F.ws + WS_Z);
    const bf16* WupT = (const bf16*)(F.ws + WS_LW); const bf16* AupT = WupT + 2 * 512 * 64; const bf16* GupT = AupT + 2 * 512 * 64;
    const int h = u & 7, bt = u >> 3, b = bt / NCHK, blk = bt % NCHK; const bool isctx = blk < 4;
    const int seqlen = isctx ? LC : T, s0 = (isctx ? blk : blk - 4) * 64;
    const size_t row0 = (isctx ? (size_t)MT + b * LC : (size_t)b * T) + s0;
    const int ti = lane_, c8 = F.wave * 8;
    const int r = lane_ & 15, q = lane_ >> 4, nt = F.wave & 3, mt0 = 2 * (F.wave >> 2);
    const int sp = s0 + ti; const bool hasp = sp > 0, hasn = sp < seqlen - 1;
    const bf16* zrow = Z + (row0 + ti) * PINP;
    const int t1 = tid_ >> 3, k8 = (tid_ & 7) * 8; const int sp1 = s0 + t1; const bool hasp1 = sp1 > 0, hasn1 = sp1 < seqlen - 1;
    const char* Zu = (const char*)(Z + row0 * PINP); const unsigned zo = (unsigned)((t1 * PINP + k8) * 2), mo = (unsigned)(k8 * 4);
    LAS float* RSs = (LAS float*)(F.lds + 4 * CBUF); LAS float* KSs = RSs + 64 * 68; LAS bf16* VSs = (LAS bf16*)(F.lds + 4 * CBUF + 2 * 64 * 68 * 4);
    LAS float* ssp = (LAS float*)(F.lds + LDS_CLE + 256);
    const LAS float* mpL = (const LAS float*)(F.lds + LDS_MU); const LAS float* mnL = mpL + 384;
    LAS float* mpR = (LAS float*)(F.lds + 0 * CBUF + 8192); LAS float* mnR = (LAS float*)(F.lds + 1 * CBUF + 8192);
    if (h != hl) { hl = h; if (tid_ < 192) { const int gi = (tid_ >> 6) * 512 + h * 64 + (tid_ & 63); mpR[tid_] = F.in[8][gi]; mnR[tid_] = F.in[9][gi]; } __syncthreads(); }
    const unsigned ldsb = (unsigned)(size_t)F.lds;
    const char* Zm = Zu - PINP * 2;
    if (pre < 0) { dma_tile(Zm + (ZR + h * 64) * 2, zo, ldsb + 10 * CBUF, F.wave, lane_); dma_tile(Zm + (ZRK + h * 64) * 2, zo, ldsb + 11 * CBUF, F.wave, lane_); dma_tile(Zm + (ZRV + h * 64) * 2, zo, ldsb + 14 * CBUF, F.wave, lane_); VMW(0); }
    else if (pre == 4) VMW(4); else VMW(8);
    __syncthreads();
    dma_tile(Zm + ZLORA * 2, zo, ldsb + 9 * CBUF, F.wave, lane_); dma_tile(Zm + (ZLORA + 128) * 2, zo, ldsb + 12 * CBUF, F.wave, lane_); dma_tile(Zm + (ZLORA + 256) * 2, zo, ldsb + 13 * CBUF, F.wave, lane_);
    { float x[8], y[8];
      mix8(rd3(F.lds + 10 * CBUF, t1, k8), hasp1, hasn1, mpR + k8, mnR + k8, x);
      *(LAS f32x4*)(RSs + t1 * 68 + k8) = (f32x4){x[0], x[1], x[2], x[3]}; *(LAS f32x4*)(RSs + t1 * 68 + k8 + 4) = (f32x4){x[4], x[5], x[6], x[7]};
      mix8(rd3(F.lds + 11 * CBUF, t1, k8), hasp1, hasn1, mpR + 64 + k8, mnR + 64 + k8, y);
      *(LAS f32x4*)(KSs + t1 * 68 + k8) = (f32x4){y[0], y[1], y[2], y[3]}; *(LAS f32x4*)(KSs + t1 * 68 + k8 + 4) = (f32x4){y[4], y[5], y[6], y[7]};
      float ss = 0.f;
#pragma unroll
      for (int e = 0; e < 8; ++e) { const float kv = y[e] * F.in[15][h * 64 + k8 + e]; ss += kv * kv; }
      ss = sum8(ss); if ((tid_ & 7) == 0) ssp[t1] = 1.0f / sqrtf(ss + 1e-12f);
      mix8(rd3(F.lds + 14 * CBUF, t1, k8), hasp1, hasn1, mpR + 128 + k8, mnR + 128 + k8, x);
      *(LAS v4u*)(VSs + t1 * CP + k8) = pack8(x); }
    VMW(0); __syncthreads();
    float rs[8], ks[8], rn = 0.f; v4u vsp = {0u, 0u, 0u, 0u};
    LAS float* lwT = (LAS float*)(F.lds + 10 * CBUF);
    LAS float* aT = (LAS float*)(F.lds + 10 * CBUF + 64 * 68 * 4);
    LAS float* tot = (LAS float*)(F.lds + LDS_TOT); LAS float* cle = (LAS float*)(F.lds + LDS_CLE);
#pragma unroll 1
    for (int d = 0; d < 2; ++d) {
        const int ip = d ? 63 - ti : ti;
        const int chunk_p = isctx ? (d ? 3 - blk : blk) : (d ? 4 + (131 - blk) : blk);
        const bf16* wy = WupT + ((size_t)(d * 512 + h * 64 + 16 * nt + r)) * 64 + 8 * q; const bf16* ay = AupT + ((size_t)(d * 512 + h * 64 + 16 * nt + r)) * 64 + 8 * q;
        const bf16x8 wy0 = *(const GAS bf16x8*)wy, wy1 = *(const GAS bf16x8*)(wy + 32), ay0 = *(const GAS bf16x8*)ay, ay1 = *(const GAS bf16x8*)(ay + 32);
        const float w0v = F.in[10][d * 512 + h * 64 + 16 * nt + r], a0v = F.in[12][d * 512 + h * 64 + 16 * nt + r];
        { float x[8]; const int ip1 = d ? 63 - t1 : t1;
          Raw3 gB; if (d == 0) gB = ld3(Zu + (ZLORA + 256 + 64) * 2, zo);
          mix8(rd3(F.lds + (d ? 10 : 9) * CBUF, t1, k8), hasp1, hasn1, mpL + d * 64 + k8, mnL + d * 64 + k8, x);
#pragma unroll
          for (int e = 0; e < 8; ++e) x[e] = tanh_fast(x[e]);
          *(LAS v4u*)(CB(0) + swz(ip1, k8)) = pack8(x);
          mix8(rd3(F.lds + (d ? 11 : 12) * CBUF, t1, k8), hasp1, hasn1, mpL + 128 + d * 64 + k8, mnL + 128 + d * 64 + k8, x);
          *(LAS v4u*)(CB(1) + swz(ip1, k8)) = pack8(x);
          if (d == 0) {
              mix8(rd3(F.lds + 13 * CBUF, t1, k8), hasp1, hasn1, mpL + 256 + k8, mnL + 256 + k8, x);
#pragma unroll
              for (int e = 0; e < 8; ++e) x[e] = sigm(x[e]);
              *(LAS v4u*)(CB(2) + t1 * 144 + k8) = pack8(x);
              mix8(gB, hasp1, hasn1, mpL + 256 + 64 + k8, mnL + 256 + 64 + k8, x);
#pragma unroll
              for (int e = 0; e < 8; ++e) x[e] = sigm(x[e]);
              *(LAS v4u*)(CB(2) + t1 * 144 + 64 + k8) = pack8(x); } }
        __syncthreads();
        if (MODE == 5) { __syncthreads(); continue; }
        { f32x4 aw[2] = Z2, aa[2] = Z2;
          { const FragX xw = ldX<0>(CB(0), mt0, r, q), xa = ldX<0>(CB(1), mt0, r, q); FragY yw, ya; yw.b[0] = wy0; yw.b[1] = wy1; ya.b[0] = ay0; ya.b[1] = ay1;
            __builtin_amdgcn_sched_barrier(0);
            mmf<0>(xw, yw, aw); mmf<0>(xa, ya, aa); }
          const int c = 16 * nt + r;
#pragma unroll
          for (int t = 0; t < 2; ++t) { f32x4 lw, av;
#pragma unroll
              for (int jj = 0; jj < 4; ++jj) { lw[jj] = -0.60653066f * sigm(aw[t][jj] + w0v); av[jj] = sigm(aa[t][jj] + a0v); }
              *(LAS f32x4*)(lwT + c * 68 + 16 * (mt0 + t) + 4 * q) = lw; *(LAS f32x4*)(aT + c * 68 + 16 * (mt0 + t) + 4 * q) = av; }
          if (d == 0) { bf16x8 gyv[4]; { const bf16* gy = GupT + ((size_t)(h * 64 + 16 * nt + r)) * 128 + 8 * q;
#pragma unroll
              for (int k4 = 0; k4 < 4; ++k4) gyv[k4] = *(const GAS bf16x8*)(gy + 32 * k4); }
              f32x4 ag[2] = Z2;
#pragma unroll
              for (int kp = 0; kp < 2; ++kp) { bf16x8 xg[2][2];
#pragma unroll
                  for (int t = 0; t < 2; ++t)
#pragma unroll
                      for (int k2 = 0; k2 < 2; ++k2) xg[t][k2] = *(const LAS bf16x8*)(CB(2) + (16 * (mt0 + t) + r) * 144 + 32 * (2 * kp + k2) + 8 * q);
                  __builtin_amdgcn_sched_barrier(0);
#pragma unroll
                  for (int k2 = 0; k2 < 2; ++k2)
#pragma unroll
                      for (int t = 0; t < 2; ++t) ag[t] = __builtin_amdgcn_mfma_f32_16x16x32_bf16(gyv[2 * kp + k2], xg[t][k2], ag[t], 0, 0, 0); }
              if (!isctx) { bf16* G = (bf16*)(F.ws + WS_G);
#pragma unroll
                  for (int t = 0; t < 2; ++t) *(GAS v2u*)(G + (row0 + 16 * (mt0 + t) + r) * 512 + h * 64 + 16 * nt + 4 * q) = pack4(ag[t]); } } }
        __syncthreads();
        if (MODE == 4) { __syncthreads(); continue; }
        { const int c = tid_ & 63, g = tid_ >> 6; LAS float* p = lwT + c * 68 + 8 * g;
          f32x4 v0 = *(LAS f32x4*)p, v1 = *(LAS f32x4*)(p + 4);
          v0[1] += v0[0]; v0[2] += v0[1]; v0[3] += v0[2]; v1[0] += v0[3]; v1[1] += v1[0]; v1[2] += v1[1]; v1[3] += v1[2];
          tot[g * 64 + c] = v1[3];
          __syncthreads();
          float base = 0.f;
#pragma unroll
          for (int g2 = 0; g2 < 7; ++g2) base += (g2 < g) ? tot[g2 * 64 + c] : 0.f;
          v0 += base; v1 += base; *(LAS f32x4*)p = v0; *(LAS f32x4*)(p + 4) = v1;
          if (g == 7) cle[c] = v1[3]; }
        __syncthreads();
        { float at[8], btv[8], kt[8], rt[8]; float cf = 0.f;
          if (d == 0) { const f32x4 r0 = *(const LAS f32x4*)(RSs + ti * 68 + c8), r1 = *(const LAS f32x4*)(RSs + ti * 68 + c8 + 4), k0 = *(const LAS f32x4*)(KSs + ti * 68 + c8), k1 = *(const LAS f32x4*)(KSs + ti * 68 + c8 + 4);
              vsp = *(const LAS v4u*)(VSs + ti * CP + c8); rn = ssp[ti];
#pragma unroll
              for (int e = 0; e < 8; ++e) { rs[e] = e < 4 ? r0[e & 3] : r1[e & 3]; ks[e] = e < 4 ? k0[e & 3] : k1[e & 3]; }
              __syncthreads(); }
          float vs[8]; unpack8(vsp, vs);
#pragma unroll
          for (int e = 0; e < 8; ++e) { const int c = c8 + e; const float cl = lwT[c * 68 + ip], clp = ip > 0 ? lwT[c * 68 + ip - 1] : 0.f, a = aT[c * 68 + ip], ce = cle[c];
              const float G = __expf(cl), iG = __expf(-cl), Gex = __expf(clp), GeG = __expf(ce - cl);
              const float kke = ks[e] * F.in[15][h * 64 + c] * rn;
              const float km = ks[e] * (1.0f + (a - 1.0f) * F.in[16][h * 64 + c]), kb = kke * a;
              at[e] = -kke * Gex; btv[e] = kb * iG; kt[e] = km * iG; rt[e] = rs[e] * G;
              { const int so = swz(c, ip); CB(4)[so] = f2bf_hw(at[e]); CB(5)[so] = f2bf_hw(kb * GeG); CB(6)[so] = f2bf_hw(km * GeG); CB(7)[so] = f2bf_hw(vs[e]); }
              cf += rs[e] * km * F.in[17][h * 64 + c]; }
          { const int so = swz(ip, c8); *(LAS v4u*)(CB(0) + so) = pack8(at); *(LAS v4u*)(CB(1) + so) = pack8(btv); *(LAS v4u*)(CB(2) + so) = pack8(kt); *(LAS v4u*)(CB(3) + so) = pack8(rt); }
          ssp[F.wave * 64 + ti] = cf; }
        __syncthreads();
        if (!isctx && F.wave == 0) { float cf = 0.f;
#pragma unroll
            for (int w = 0; w < 8; ++w) cf += ssp[w * 64 + ti];
            ((float*)(F.ws + WS_COEF))[(row0 + ti) * 16 + h * 2 + d] = cf; }
        if (MODE == 3) { __syncthreads(); continue; }
        { f32x4 pN[2] = Z2, pLak[2] = Z2, pMrb[2] = Z2, pMrk[2] = Z2;
          { const FragX x1 = ldX<MODE>(CB(1), mt0, r, q), x2 = ldX<MODE>(CB(2), mt0, r, q); const FragY y0 = ldY<MODE>(CB(0), nt, r, q), y3 = ldY<MODE>(CB(3), nt, r, q);
            __builtin_amdgcn_sched_barrier(0);
            mmf<MODE>(x1, y0, pN); mmf<MODE>(x2, y0, pLak); mmf<MODE>(x1, y3, pMrb); mmf<MODE>(x2, y3, pMrk); }
          __builtin_amdgcn_sched_barrier(0);
          const int n = 16 * nt + r;
#pragma unroll
          for (int t = 0; t < 2; ++t) { f32x4 t0;
#pragma unroll
              for (int jj = 0; jj < 4; ++jj) { const int m = 16 * (mt0 + t) + 4 * q + jj;
                  pN[t][jj] = (m < n) ? pN[t][jj] : 0.f; t0[jj] = pN[t][jj] + ((m == n) ? 1.0f : 0.f);
                  pLak[t][jj] = (m < n) ? pLak[t][jj] : 0.f; pMrb[t][jj] = (m <= n) ? pMrb[t][jj] : 0.f; pMrk[t][jj] = (m <= n) ? pMrk[t][jj] : 0.f; }
              stT(CB(8), mt0 + t, nt, r, q, pN[t]); stT(CB(10), mt0 + t, nt, r, q, t0); stR(CB(9), mt0 + t, nt, r, q, pN[t]);
              stT(CB(11), mt0 + t, nt, r, q, pLak[t]); stT(CB(12), mt0 + t, nt, r, q, pMrb[t]); stT(CB(13), mt0 + t, nt, r, q, pMrk[t]); } }
        __syncthreads();
#define SQ_ST(a1, ONT_, ON_) do { _Pragma("unroll") for (int t = 0; t < 2; ++t) { stT(CB(ONT_), mt0 + t, nt, r, q, a1[t]); if ((ON_) >= 0) stR(CB((ON_) < 0 ? 0 : (ON_)), mt0 + t, nt, r, q, a1[t]); } } while (0)
#define TSQ_STAGE(NTB_, TOLD_, TNEW_, NB_, NTB2_, ONT_, ON_) do { f32x4 a3[2], a1[2] = Z2; \
            const FragX xt = ldX<MODE>(CB(NTB_), mt0, r, q); const FragY yt = ldY<MODE>(CB(TOLD_), nt, r, q); a3[0] = ldT(CB(TOLD_), mt0, nt, r, q); a3[1] = ldT(CB(TOLD_), mt0 + 1, nt, r, q); \
            const FragX xs = ldX<MODE>(CB(NB_), mt0, r, q); const FragY ys = ldY<MODE>(CB(NTB2_), nt, r, q); \
            __builtin_amdgcn_sched_barrier(0); \
            mmf<MODE>(xt, yt, a3); mmf<MODE>(xs, ys, a1); \
            __builtin_amdgcn_sched_barrier(0); \
            _Pragma("unroll") for (int t = 0; t < 2; ++t) stT(CB(TNEW_), mt0 + t, nt, r, q, a3[t]); \
            SQ_ST(a1, ONT_, ON_); } while (0)
        { f32x4 w1[2] = Z2, a1[2] = Z2;
          { const FragX xw = ldX<MODE>(CB(11), mt0, r, q), xs = ldX<MODE>(CB(8), mt0, r, q); const FragY yw = ldY<MODE>(CB(7), nt, r, q), ys = ldY<MODE>(CB(9), nt, r, q);
            __builtin_amdgcn_sched_barrier(0);
            mmf<MODE>(xw, yw, w1); mmf<MODE>(xs, ys, a1); }
          __builtin_amdgcn_sched_barrier(0);
          stT(CB(14), mt0, nt, r, q, w1[0]); stT(CB(14), mt0 + 1, nt, r, q, w1[1]); SQ_ST(a1, 0, 1); }
        __syncthreads();
        TSQ_STAGE(0, 10, 2, 1, 0, 8, 9);   __syncthreads();
        TSQ_STAGE(8, 2, 10, 9, 8, 0, 1);   __syncthreads();
        TSQ_STAGE(0, 10, 2, 1, 0, 8, 9);   __syncthreads();
        TSQ_STAGE(8, 2, 10, 9, 8, 0, -1);  __syncthreads();
        { f32x4 a3[2]; const FragX xt = ldX<MODE>(CB(0), mt0, r, q); const FragY yt = ldY<MODE>(CB(10), nt, r, q); a3[0] = ldT(CB(10), mt0, nt, r, q); a3[1] = ldT(CB(10), mt0 + 1, nt, r, q);
          __builtin_amdgcn_sched_barrier(0);
          mmf<MODE>(xt, yt, a3); stT(CB(2), mt0, nt, r, q, a3[0]); stT(CB(2), mt0 + 1, nt, r, q, a3[1]); }
        __syncthreads();
        if (d == 0) { dma_tile(Zm + (ZLORA + 64) * 2, zo, ldsb + 10 * CBUF, F.wave, lane_); dma_tile(Zm + (ZLORA + 128 + 64) * 2, zo, ldsb + 11 * CBUF, F.wave, lane_); }
        { f32x4 w2[2] = Z2, ah[2] = Z2;
          { const FragX xT = ldX<MODE>(CB(2), mt0, r, q); const FragY y14 = ldY<MODE>(CB(14), nt, r, q), y4 = ldY<MODE>(CB(4), nt, r, q);
            __builtin_amdgcn_sched_barrier(0);
            mmf<MODE>(xT, y14, w2); mmf<MODE>(xT, y4, ah); }
#pragma unroll
          for (int t = 0; t < 2; ++t) { stT(CB(8), mt0 + t, nt, r, q, w2[t]); stT(CB(9), mt0 + t, nt, r, q, ah[t]); } }
        __syncthreads();
        if (d == 1 && un >= 0) { const int hn = un & 7, btn = un >> 3, bn = btn / NCHK, blkn = btn % NCHK;
            const size_t rown = (blkn < 4 ? (size_t)MT + bn * LC + blkn * 64 : (size_t)bn * T + (blkn - 4) * 64);
            const char* zn = (const char*)(Z + (rown - 1) * PINP);
            dma_tile(zn + (ZR + hn * 64) * 2, zo, ldsb + 10 * CBUF, F.wave, lane_); dma_tile(zn + (ZRK + hn * 64) * 2, zo, ldsb + 11 * CBUF, F.wave, lane_); dma_tile(zn + (ZRV + hn * 64) * 2, zo, ldsb + 14 * CBUF, F.wave, lane_); }
        { const size_t ud = ((size_t)((b * 8 + h) * 2 + d)) * NCHK + chunk_p;
          bf16* Pg = (bf16*)(F.ws + WS_PQ + ud * PQ_UNIT); bf16* Qg = Pg + 4096;
          f32x4 pP[2] = Z2, pQ[2] = Z2;
          { const FragX x9 = ldX<MODE>(CB(9), mt0, r, q), x5 = ldX<MODE>(CB(5), mt0, r, q), x6 = ldX<MODE>(CB(6), mt0, r, q); const FragY y5 = ldY<MODE>(CB(5), nt, r, q), y8 = ldY<MODE>(CB(8), nt, r, q), y7 = ldY<MODE>(CB(7), nt, r, q);
            __builtin_amdgcn_sched_barrier(0);
            mmf<MODE>(x9, y5, pP); mmf<MODE>(x5, y8, pQ); mmf<MODE>(x6, y7, pQ); }
          __builtin_amdgcn_sched_barrier(0);
          const int n = 16 * nt + r; const float ge = __expf(cle[n]);
#pragma unroll
          for (int t = 0; t < 2; ++t) {
#pragma unroll
              for (int jj = 0; jj < 4; ++jj) { const int m = 16 * (mt0 + t) + 4 * q + jj; pP[t][jj] += (m == n) ? ge : 0.f; }
              *(GAS v2u*)(Pg + afrag_off(n, 16 * (mt0 + t) + 4 * q)) = pack4(pP[t]); *(GAS v2u*)(Qg + cfrag_off(n, 16 * (mt0 + t) + 4 * q)) = pack4(pQ[t]); }
          if (!isctx) { const size_t ul = ((size_t)((b * 8 + h) * 2 + d)) * 128 + (chunk_p - 4);
              bf16* Rg = (bf16*)((unsigned char*)F.out + ul * RY_UNIT); bf16* Yg = Rg + 4096;
              f32x4 pR[2], pY[2] = Z2; pR[0] = ldT(CB(3), mt0, nt, r, q); pR[1] = ldT(CB(3), mt0 + 1, nt, r, q);
              { const FragX x9 = ldX<MODE>(CB(9), mt0, r, q), x12 = ldX<MODE>(CB(12), mt0, r, q), x13 = ldX<MODE>(CB(13), mt0, r, q); const FragY y12 = ldY<MODE>(CB(12), nt, r, q), y8 = ldY<MODE>(CB(8), nt, r, q), y7 = ldY<MODE>(CB(7), nt, r, q);
                __builtin_amdgcn_sched_barrier(0);
                mmf<MODE>(x9, y12, pR); mmf<MODE>(x12, y8, pY); mmf<MODE>(x13, y7, pY); }
              __builtin_amdgcn_sched_barrier(0);
#pragma unroll
              for (int t = 0; t < 2; ++t) {
                  *(GAS v2u*)(Rg + afrag_off(d ? 63 - n : n, 16 * (mt0 + t) + 4 * q)) = pack4(pR[t]);
                  if (d) { const f32x4 rv = {pY[t][3], pY[t][2], pY[t][1], pY[t][0]}; *(GAS v2u*)(Yg + cfrag_off(n, 60 - 16 * (mt0 + t) - 4 * q)) = pack4(rv); }
                  else *(GAS v2u*)(Yg + cfrag_off(n, 16 * (mt0 + t) + 4 * q)) = pack4(pY[t]); } } }
        if (d == 0) { if (isctx) VMW(4); else VMW(8); }
        __syncthreads();
    }
#undef SQ_ST
#undef TSQ_STAGE
}

struct BSetPQ { v4u p[8]; v2u qv[4]; };
constexpr size_t XC_UNIT = 2048;
__device__ __forceinline__ void rwkvB_task(Frame& F, int task) {
    const int vsl = task & 3, chain = task >> 2;
    const int r = F.lane & 15, q = F.lane >> 4;
    const unsigned char* PQ = F.ws + WS_PQ + (size_t)chain * NCHK * PQ_UNIT;
    unsigned char* XC = F.ws + WS_YFB + ((size_t)chain * 128 * 4 + vsl) * XC_UNIT;
    f32x4 X[4];
#pragma unroll
    for (int i = 0; i < 4; ++i) X[i] = (f32x4){0.f, 0.f, 0.f, 0.f};
#define B_LOADPQ(S, c_) do { const int _c = (c_) < NCHK ? (c_) : NCHK - 1; const bf16* _P = (const bf16*)(PQ + (size_t)_c * PQ_UNIT); const bf16* _Q = _P + 4096; \
        _Pragma("unroll") for (int mt = 0; mt < 4; ++mt) { S.qv[mt] = *(const GAS v2u*)(_Q + (((vsl * 4 + mt) * 64 + F.lane) << 2)); \
            _Pragma("unroll") for (int ks = 0; ks < 2; ++ks) S.p[mt * 2 + ks] = *(const GAS v4u*)(_P + (((mt * 2 + ks) * 64 + F.lane) << 3)); } } while (0)
#define B_STEP(S, c_) do { const int _c = (c_); bf16x8 xb[2]; \
        _Pragma("unroll") for (int ks = 0; ks < 2; ++ks) { const v2u lo = pack4(X[2 * ks]), hi = pack4(X[2 * ks + 1]); const v4u xw = {lo.x, lo.y, hi.x, hi.y}; xb[ks] = __builtin_bit_cast(bf16x8, xw); \
            if (_c >= 4) *(GAS v4u*)(XC + (size_t)(_c - 4) * 4 * XC_UNIT + ks * 1024 + F.lane * 16) = xw; } \
        _Pragma("unroll") for (int mt = 0; mt < 4; ++mt) { f32x4 xn = unpack4(S.qv[mt]); \
            _Pragma("unroll") for (int ks = 0; ks < 2; ++ks) xn = __builtin_amdgcn_mfma_f32_16x16x32_bf16(__builtin_bit_cast(bf16x8, S.p[mt * 2 + ks]), xb[ks], xn, 0, 0, 0); \
            X[mt] = xn; } } while (0)
    BSetPQ SA, SB, SC;
    B_LOADPQ(SA, 0); B_LOADPQ(SB, 1);
#pragma unroll 1
    for (int c = 0; c < NCHK; c += 3) {
        B_LOADPQ(SC, c + 2); B_STEP(SA, c);
        B_LOADPQ(SA, c + 3); B_STEP(SB, c + 1);
        B_LOADPQ(SB, c + 4); B_STEP(SC, c + 2);
    }
#undef B_LOADPQ
#undef B_STEP
}

constexpr int YSP = 520;
__device__ __forceinline__ void phase_readout(Frame& F) {
    bf16* Z = (bf16*)(F.ws + WS_Z); const bf16* G = (const bf16*)(F.ws + WS_G); const float* COEF = (const float*)(F.ws + WS_COEF);
    LAS bf16* YS = (LAS bf16*)F.lds;
    const int r = F.lane & 15, q = F.lane >> 4, h = F.wave;
    const int hh = F.lane >> 3, c0 = F.lane * 8;
    float gnw[8], gnb[8];
#pragma unroll
    for (int e = 0; e < 8; ++e) { gnw[e] = F.in[18][c0 + e]; gnb[e] = F.in[19][c0 + e]; }
    for (int u = F.bid; u < NB * 128; u += F.G) {
        const int b = u >> 7, blk = u & 127;
        f32x4 y[4][4];
#pragma unroll
        for (int it = 0; it < 4; ++it)
#pragma unroll
            for (int vs = 0; vs < 4; ++vs) y[it][vs] = (f32x4){0.f, 0.f, 0.f, 0.f};
#pragma unroll
        for (int d = 0; d < 2; ++d) {
            const int chain = (b * 8 + h) * 2 + d, lc = d ? 127 - blk : blk;
            const bf16* Rg = (const bf16*)((const unsigned char*)F.out + ((size_t)chain * 128 + lc) * RY_UNIT); const bf16* Yg = Rg + 4096;
            const unsigned char* XC = F.ws + WS_YFB + ((size_t)chain * 128 + lc) * 4 * XC_UNIT;
            v4u xw[4][2], rr[4][2]; v2u yl[4][4];
#pragma unroll
            for (int vs = 0; vs < 4; ++vs) { xw[vs][0] = *(const GAS v4u*)(XC + vs * XC_UNIT + F.lane * 16); xw[vs][1] = *(const GAS v4u*)(XC + vs * XC_UNIT + 1024 + F.lane * 16); }
#pragma unroll
            for (int it = 0; it < 4; ++it) {
#pragma unroll
                for (int ks = 0; ks < 2; ++ks) rr[it][ks] = *(const GAS v4u*)(Rg + (((it * 2 + ks) * 64 + F.lane) << 3));
#pragma unroll
                for (int vs = 0; vs < 4; ++vs) yl[it][vs] = *(const GAS v2u*)(Yg + (((vs * 4 + it) * 64 + F.lane) << 2)); }
#pragma unroll
            for (int it = 0; it < 4; ++it)
#pragma unroll
                for (int vs = 0; vs < 4; ++vs) { f32x4 a = y[it][vs] + unpack4(yl[it][vs]);
#pragma unroll
                    for (int ks = 0; ks < 2; ++ks) a = __builtin_amdgcn_mfma_f32_16x16x32_bf16(__builtin_bit_cast(bf16x8, rr[it][ks]), __builtin_bit_cast(bf16x8, xw[vs][ks]), a, 0, 0, 0);
                    y[it][vs] = a; }
        }
#pragma unroll
        for (int it = 0; it < 4; ++it)
#pragma unroll
            for (int vs = 0; vs < 4; ++vs)
#pragma unroll
                for (int jj = 0; jj < 4; ++jj) YS[(16 * it + 4 * q + jj) * YSP + h * 64 + 16 * vs + r] = f2bf_hw(y[it][vs][jj]);
        __syncthreads();
#pragma unroll 2
        for (int tk = 0; tk < 8; ++tk) {
            const int tok = 8 * F.wave + tk, t = blk * 64 + tok; const size_t m = (size_t)b * T + t;
            float vsh[8], yf[8], gg[8];
            shift8(Z + m * PINP + ZRV + c0, t > 0, t < T - 1, F.in[8] + 1024 + c0, F.in[9] + 1024 + c0, vsh);
            unpack8(*(const LAS v4u*)(YS + tok * YSP + c0), yf); unpack8(*(const GAS v4u*)(G + m * 512 + c0), gg);
            const f32x2 cf2 = *(const GAS f32x2*)(COEF + m * 16 + hh * 2); const float coef = cf2.x + cf2.y;
            float sm = 0.f;
#pragma unroll
            for (int e = 0; e < 8; ++e) sm += yf[e];
            const float mean = sum8(sm) * (1.0f / 64.0f); float q2 = 0.f;
#pragma unroll
            for (int e = 0; e < 8; ++e) { yf[e] -= mean; q2 += yf[e] * yf[e]; }
            const float rstd = 1.0f / sqrtf(sum8(q2) * (1.0f / 64.0f) + GN_EPS);
            float o[8];
#pragma unroll
            for (int e = 0; e < 8; ++e) o[e] = (yf[e] * rstd * gnw[e] + gnb[e] + coef * vsh[e]) * gg[e];
            *(GAS v4u*)(Z + m * PINP + ZK + c0) = pack8(o);
        }
        __syncthreads();
    }
}

__device__ __forceinline__ void phase_ln1_router(Frame& F, float* hdst = nullptr) {
    const float* MODV = (const float*)(F.ws + WS_MOD);
    unsigned char* U2 = F.ws + WS_U2; float* AFF = (float*)(F.ws + WS_AFF);
    LAS float* wr = (LAS float*)F.lds;
    for (int e = F.tid; e < 1024 * 16; e += NTHR) { const int d = e >> 4, ex = e & 15, j = d >> 8, ln = (d & 255) >> 2, q = d & 3; wr[((j * 4 + q) * 64 + ln) * 20 + ex] = F.in[25][e]; }
    LAS float* tr = (LAS float*)(F.lds + 81920 + F.wave * 4352);
    __syncthreads();
    const int gw = F.bid * NWAVES + F.wave, NGW = F.G * NWAVES;
    for (int m = gw; m < MT; m += NGW) {
        const int b = m / T;
        const float* sh2 = MODV + b * 6144 + 3072; const float* sc2 = sh2 + 1024;
        GAS f32x4* hr = (GAS f32x4*)(F.out + (size_t)m * D) + F.lane;
        f32x4 v[4]; float s = 0.f;
#pragma unroll
        for (int j = 0; j < 4; ++j) { v[j] = hr[64 * j]; s += (v[j].x + v[j].y) + (v[j].z + v[j].w); }
        float mean = wave_sum(s) * (1.f / D); float s2 = 0.f;
#pragma unroll
        for (int j = 0; j < 4; ++j) { v[j] = v[j] - mean; s2 += (v[j].x * v[j].x + v[j].y * v[j].y) + (v[j].z * v[j].z + v[j].w * v[j].w); }
        float rstd = 1.f / sqrtf(wave_sum(s2) * (1.f / D) + LN_EPS);
        s = 0.f;
#pragma unroll
        for (int j = 0; j < 4; ++j) { const f32x4 g = *((const f32x4*)F.in[23] + F.lane + 64 * j), bb = *((const f32x4*)F.in[24] + F.lane + 64 * j);
            v[j] = v[j] * rstd * g + bb; if (hdst) ((GAS f32x4*)(hdst + (size_t)m * D) + F.lane)[64 * j] = v[j]; else hr[64 * j] = v[j]; s += (v[j].x + v[j].y) + (v[j].z + v[j].w); }
        mean = wave_sum(s) * (1.f / D); s2 = 0.f;
#pragma unroll
        for (int j = 0; j < 4; ++j) { v[j] = v[j] - mean; s2 += (v[j].x * v[j].x + v[j].y * v[j].y) + (v[j].z * v[j].z + v[j].w * v[j].w); }
        rstd = 1.f / sqrtf(wave_sum(s2) * (1.f / D) + LN_EPS);
        GAS unsigned* o4 = (GAS unsigned*)(U2 + (size_t)m * D) + F.lane;
        float lg[16];
#pragma unroll
        for (int e = 0; e < 16; ++e) lg[e] = 0.f;
#pragma unroll
        for (int j = 0; j < 4; ++j) { const f32x4 a = *((const f32x4*)sc2 + F.lane + 64 * j), bb = *((const f32x4*)sh2 + F.lane + 64 * j);
            const f32x4 o = v[j] * rstd * (a + 1.0f) + bb; v[j] = o;
            o4[64 * j] = pk4_fp8(o.x, o.y, o.z, o.w); }
#pragma unroll
        for (int j = 0; j < 4; ++j) {
#pragma unroll
            for (int q = 0; q < 4; ++q) { const LAS f32x4* wp = (const LAS f32x4*)(wr + (size_t)(((j * 4 + q) * 64 + F.lane) * 20)); const float oq = v[j][q];
#pragma unroll
                for (int e4 = 0; e4 < 4; ++e4) { const f32x4 w = wp[e4]; lg[e4 * 4 + 0] += oq * w.x; lg[e4 * 4 + 1] += oq * w.y; lg[e4 * 4 + 2] += oq * w.z; lg[e4 * 4 + 3] += oq * w.w; } }
            __builtin_amdgcn_sched_barrier(0); }
#pragma unroll
        for (int e = 0; e < 16; ++e) tr[F.lane * 17 + e] = lg[e];
        LDS_WAIT(); asm volatile("" ::: "memory");
        float lgt = 0.f;
#pragma unroll
        for (int i = 0; i < 16; ++i) lgt += tr[((F.lane >> 4) * 16 + i) * 17 + (F.lane & 15)];
        LDS_WAIT(); asm volatile("" ::: "memory");
        lgt += __shfl_xor(lgt, 16); lgt += __shfl_xor(lgt, 32);
        float mx = lgt;
        mx = fmaxf(mx, dppf<0xB1>(mx)); mx = fmaxf(mx, dppf<0x4E>(mx)); mx = fmaxf(mx, dppf<0x141>(mx)); mx = fmaxf(mx, dppf<0x140>(mx));
        const float ex = expf(lgt - mx); const float mine = ex / row16_sum(ex);
        if (F.lane < 16) AFF[(size_t)m * 16 + F.lane] = mine;
    }
}

__device__ __forceinline__ unsigned block_excl_scan(Frame& F, unsigned v, LAS unsigned* sc, unsigned& total) {
    unsigned inc = v;
#pragma unroll
    for (int o = 1; o < 64; o <<= 1) { const unsigned t = __shfl_up(inc, o); if (F.lane >= o) inc += t; }
    __syncthreads();
    if (F.lane == 63) sc[F.wave] = inc;
    __syncthreads();
    unsigned base = 0, tot = 0;
#pragma unroll
    for (int w = 0; w < 8; ++w) { const unsigned x = sc[w]; if (w < F.wave) base += x; tot += x; }
    total = tot;
    return base + inc - v;
}
__device__ __forceinline__ void topk_unit(Frame& F, int unit) {
    const int b = unit & 3, e = unit >> 2;
    const float* AFF = (const float*)(F.ws + WS_AFF);
    int* IDX = (int*)(F.ws + WS_IDX); float* GATEV = (float*)(F.ws + WS_GATEV); int* SLOT = (int*)(F.ws + WS_SLOT);
    LAS unsigned* hist = (LAS unsigned*)F.lds;
    LAS unsigned* sc = hist + 256;
    LAS unsigned* sel = sc + 16;
    LAS int* idl = (LAS int*)(sel + 16);
    unsigned key[16];
#pragma unroll
    for (int i = 0; i < 16; ++i) key[i] = __float_as_uint(AFF[((size_t)b * T + F.tid * 16 + i) * 16 + e]);
    unsigned prefix = 0, need = CAP;
#pragma unroll 1
    for (int rd = 0; rd < 4; ++rd) {
        const int shift = 24 - 8 * rd; const unsigned hmask = (rd == 0) ? 0u : (0xffffffffu << (shift + 8));
        if (F.tid < 256) hist[F.tid] = 0u;
        __syncthreads();
#pragma unroll
        for (int i = 0; i < 16; ++i) if ((key[i] & hmask) == prefix) __hip_atomic_fetch_add(&hist[(key[i] >> shift) & 255u], 1u, __ATOMIC_RELAXED, __HIP_MEMORY_SCOPE_WORKGROUP);
        __syncthreads();
        if (F.wave == 0) {
            const unsigned c0 = hist[4 * F.lane], c1 = hist[4 * F.lane + 1], c2 = hist[4 * F.lane + 2], c3 = hist[4 * F.lane + 3];
            const unsigned tot4 = (c0 + c1) + (c2 + c3); unsigned x = tot4;
#pragma unroll
            for (int o = 1; o < 64; o <<= 1) { const unsigned t = __shfl_down(x, o); if (F.lane + o < 64) x += t; }
            const unsigned excl = x - tot4;
            if (excl < need && need <= x) { unsigned cum = excl; int bin;
                if (cum + c3 >= need) bin = 4 * F.lane + 3; else { cum += c3; if (cum + c2 >= need) bin = 4 * F.lane + 2; else { cum += c2; if (cum + c1 >= need) bin = 4 * F.lane + 1; else { cum += c1; bin = 4 * F.lane; } } }
                sel[0] = (unsigned)bin; sel[1] = need - cum; } }
        __syncthreads();
        prefix |= sel[0] << shift; need = sel[1];
        __syncthreads();
    }
    unsigned neq = 0, ngt = 0;
#pragma unroll
    for (int i = 0; i < 16; ++i) { neq += (key[i] == prefix); ngt += (key[i] > prefix); }
    unsigned tot; const unsigned eqbase = block_excl_scan(F, neq, sc, tot);
    unsigned cnt = 0, eqr = eqbase; unsigned selm = 0;
#pragma unroll
    for (int i = 0; i < 16; ++i) { bool s = key[i] > prefix; if (key[i] == prefix) { s = eqr < need; ++eqr; } if (s) { selm |= 1u << i; ++cnt; } }
    const unsigned pos0 = block_excl_scan(F, cnt, sc, tot);
    unsigned pos = pos0;
#pragma unroll
    for (int i = 0; i < 16; ++i) { const int t = F.tid * 16 + i; int sl = -1;
        if (selm & (1u << i)) { sl = (int)pos; ++pos; const int slot = (e * NB + b) * CAP + sl; IDX[slot] = b * T + t; GATEV[slot] = __uint_as_float(key[i]); idl[sl] = b * T + t; }
        SLOT[((size_t)b * T + t) * 16 + e] = sl; }
    __syncthreads();
    { const unsigned char* U2 = F.ws + WS_U2; unsigned char* XS = F.ws + WS_XS + (size_t)((e * NB + b) * CAP) * D;
#pragma unroll 1
      for (int s0 = F.wave * 16; s0 < CAP; s0 += NWAVES * 16) { v4u rw[16];
#pragma unroll
          for (int k = 0; k < 16; ++k) rw[k] = *((const GAS v4u*)(U2 + (size_t)idl[s0 + k] * D) + F.lane);
#pragma unroll
          for (int k = 0; k < 16; ++k) *((GAS v4u*)(XS + (size_t)(s0 + k) * D) + F.lane) = rw[k]; } }
    __syncthreads();
}
constexpr int CV_I13 = 16 * (DE / 64), CV_I2 = (DE / 64) * 16, CV_N13 = NE * 2 * CV_I13;
constexpr int Z_EARLY_PER_WAVE = 6;
__device__ __forceinline__ int z_tail_first(int G) { return ((MA / 256) * (PINP / 256)) % G; }
__device__ __forceinline__ int z_early_tiles(int G) { const int t = z_tail_first(G); const int n = t > 0 ? (G - t) * NWAVES * Z_EARLY_PER_WAVE : 0; return n <= NE * CV_I2 - W2_EARLY_TILES ? n : 0; }
__device__ __forceinline__ void cvt_w2_tile(Frame& F, int w2t) { const int e = w2t / CV_I2, r = w2t % CV_I2, k0 = 64 * (r / 16), n0 = 64 * (r % 16);
    cvt_tile64_fp8(F.in[28] + (size_t)e * DE * 1024, 1024, k0, n0, F.ws + WS_W2 + (size_t)e * 1024 * DE, (size_t)n0, DE, W2_SCALE, F.lane); }
__device__ __forceinline__ void cvt_w13_tile(Frame& F, int it0) { const int e = it0 / (2 * CV_I13); int r = it0 % (2 * CV_I13);
    const int which = r / CV_I13; r %= CV_I13; const int nb = DE / 64, k0 = 64 * (r / nb), n0 = 64 * (r % nb);
    cvt_tile64_fp8(F.in[which ? 27 : 26] + (size_t)e * 1024 * DE, DE, k0, n0, F.ws + WS_W13 + (size_t)e * PINP * 1024, (size_t)(256 * (n0 / 128) + 128 * which + (n0 % 128)), 1024, W13_SCALE, F.lane); }
__device__ __forceinline__ void phase_topk_convert(Frame& F) {
    if (F.bid < NB * NE) topk_unit(F, F.bid);
    const int NTK = NB * NE * NWAVES, NVW = F.G * NWAVES - NTK;
    const int gwl = F.bid * NWAVES + F.wave; const int vw0 = gwl < NTK ? 0 : (gwl - NTK), nvw = gwl < NTK ? 0 : 1;
    const int w2done = z_early_tiles(F.G) + W2_EARLY_TILES, nlate = CV_N13 + NE * CV_I2 - w2done;
    for (int itb = vw0; itb < nlate; itb += NVW) for (int v = 0; v < nvw; ++v) { const int it0 = itb + v; if (it0 >= nlate) break;
        if (it0 < CV_N13) cvt_w13_tile(F, it0); else cvt_w2_tile(F, it0 - CV_N13 + w2done); }
}

__device__ __forceinline__ void phase_gather(Frame& F) {
    const int* IDX = (const int*)(F.ws + WS_IDX); const unsigned char* U2 = F.ws + WS_U2; unsigned char* XS = F.ws + WS_XS;
    const int gw = F.bid * NWAVES + F.wave, NGW = F.G * NWAVES;
    for (int s = gw; s < NSLOT; s += NGW) {
        const int src = IDX[s];
        *((GAS v4u*)(XS + (size_t)s * D) + F.lane) = *((const GAS v4u*)(U2 + (size_t)src * D) + F.lane);
    }
}

__device__ __forceinline__ void phase_final(Frame& F, float* odst = nullptr) {
    const float* MODV = (const float*)(F.ws + WS_MOD); const int* SLOT = (const int*)(F.ws + WS_SLOT); const bf16* YE = (const bf16*)(F.ws + WS_YE);
    const int gw = F.bid * NWAVES + F.wave, NGW = F.G * NWAVES;
    for (int m = gw; m < MT; m += NGW) {
        const int b = m / T;
        const float* gt2 = MODV + b * 6144 + 5120;
        GAS f32x4* hr = (GAS f32x4*)(F.out + (size_t)m * D) + F.lane;
        f32x4 acc[4];
#pragma unroll
        for (int j = 0; j < 4; ++j) acc[j] = (f32x4){0.f, 0.f, 0.f, 0.f};
        const int myslot = (F.lane < 16) ? SLOT[(size_t)m * 16 + F.lane] : -1;
        f32x4 hv[4];
#pragma unroll
        for (int j = 0; j < 4; ++j) hv[j] = hr[64 * j];
        unsigned mask = (unsigned)(__ballot(myslot >= 0) & 0xFFFFull);
        while (mask) {
            const int e0 = __builtin_ctz(mask); mask &= mask - 1; const bool two = mask != 0; const int e1 = two ? __builtin_ctz(mask) : e0; if (two) mask &= mask - 1;
            const int s0 = __shfl(myslot, e0), s1 = __shfl(myslot, e1);
            const GAS v2u* y0 = (const GAS v2u*)(YE + (size_t)((e0 * NB + b) * CAP + s0) * D) + F.lane; const GAS v2u* y1 = (const GAS v2u*)(YE + (size_t)((e1 * NB + b) * CAP + s1) * D) + F.lane;
            v2u w0[4], w1[4];
#pragma unroll
            for (int j = 0; j < 4; ++j) { w0[j] = y0[64 * j]; w1[j] = y1[64 * j]; }
            const float f1 = two ? 1.f : 0.f;
#pragma unroll
            for (int j = 0; j < 4; ++j) { acc[j].x += bflo(w0[j].x) + f1 * bflo(w1[j].x); acc[j].y += bfhi(w0[j].x) + f1 * bfhi(w1[j].x); acc[j].z += bflo(w0[j].y) + f1 * bflo(w1[j].y); acc[j].w += bfhi(w0[j].y) + f1 * bfhi(w1[j].y); } }
        f32x4 v[4]; float s = 0.f;
#pragma unroll
        for (int j = 0; j < 4; ++j) { const f32x4 g = *((const f32x4*)gt2 + F.lane + 64 * j); v[j] = hv[j] * ALPHA + g * acc[j]; s += (v[j].x + v[j].y) + (v[j].z + v[j].w); }
        const float mean = wave_sum(s) * (1.f / D); float s2 = 0.f;
#pragma unroll
        for (int j = 0; j < 4; ++j) { v[j] = v[j] - mean; s2 += (v[j].x * v[j].x + v[j].y * v[j].y) + (v[j].z * v[j].z + v[j].w * v[j].w); }
        const float rstd = 1.f / sqrtf(wave_sum(s2) * (1.f / D) + LN_EPS);
#pragma unroll
        for (int j = 0; j < 4; ++j) { const f32x4 g = *((const f32x4*)F.in[29] + F.lane + 64 * j), bb = *((const f32x4*)F.in[30] + F.lane + 64 * j); { const f32x4 ov = v[j] * rstd * g + bb; if (odst) ((GAS f32x4*)(odst + (size_t)m * D) + F.lane)[64 * j] = ov; else hr[64 * j] = ov; } }
    }
}

constexpr int N_PHASES = 16;
struct Args { const float* in[31]; float* out; unsigned char* ws; int ph_lo, ph_hi; };
__global__ void __launch_bounds__(NTHR, 2) fwd(Args args) {
    extern __shared__ __attribute__((aligned(16))) unsigned char lds[];
    Frame F;
    F.lds = (LAS unsigned char*)lds;
    F.tid = threadIdx.x; F.lane = F.tid & 63; F.wave = __builtin_amdgcn_readfirstlane(F.tid >> 6);
    F.G = gridDim.x; F.bid = blockIdx.x;
#pragma unroll
    for (int i = 0; i < 31; ++i) F.in[i] = args.in[i];
    F.out = args.out; F.ws = args.ws;
    volatile LAS unsigned* MISC = (volatile LAS unsigned*)(F.lds + MISC_OFF);
    for (int u = F.tid; u < (LDS_BYTES - LDSCTL_OFF) / 4; u += NTHR) ((LAS unsigned*)(F.lds + LDSCTL_OFF))[u] = 0u;
    __syncthreads();
    XcdBarrier bar; bar.bar = (unsigned*)(F.ws + WS_CTL) + CW_BAR; bar.x = 0; bar.st = nullptr;
    const int lo = args.ph_lo, hi = args.ph_hi;
    const bool multi = (hi - lo) > 1;
    if (multi) bar = xcd_barrier_post((unsigned*)(F.ws + WS_CTL) + CW_BAR, MISC + 8);
#ifndef PH_MASK
#define PH_MASK 0xFFFF
#endif
#define IN(k) (((PH_MASK >> (k)) & 1) && lo <= (k) && (k) < hi)
#define SEAM(k) do { if (IN(k) && IN((k) + 1)) xcd_barrier(bar); } while (0)
    LAS unsigned char* ring = F.lds;
    bf16* Z = (bf16*)(F.ws + WS_Z);

    if (IN(0)) { for (int rp = 0; rp < REPS(0); ++rp) { phase_prologue(F); if (rp + 1 < REPS(0)) xcd_barrier(bar); } SEAM(0); }
    if (IN(1)) { for (int rp = 0; rp < REPS(1); ++rp) { phase_ln_mod(F); if (rp + 1 < REPS(1)) xcd_barrier(bar); } SEAM(1); }
    if (IN(2)) {
        pg8::Gemm g{(const bf16*)(F.ws + WS_U), (const bf16*)(F.ws + WS_WIN), MA, PINP, D, D, 1 << 30, 0};
        pg8::StaticOrder S; S.init(MA, PINP, F.G, F.bid);
        pg8::EpiBf16 E{Z, PINP};
        pg8::gemm_phase<pg8::EpiBf16, pg8::StaticOrder, true, true>(ring, g, S, E);
        if (DUP(2)) { xcd_barrier(bar); pg8::gemm_phase<pg8::EpiBf16, pg8::StaticOrder, true, true>(ring, g, S, E); }
        { const int t0 = z_tail_first(F.G);
          if (z_early_tiles(F.G) > 0 && F.bid >= t0) { const int nw = (F.G - t0) * NWAVES, w0 = (F.bid - t0) * NWAVES + F.wave;
              for (int k = 0; k < Z_EARLY_PER_WAVE; ++k) cvt_w2_tile(F, w0 + k * nw); } }
        SEAM(2);
    }
    if (IN(3)) {
        phase_rope_vt(F);
        __syncthreads();
        { LAS float* mu = (LAS float*)(F.lds + LDS_MU); for (int e = F.tid; e < 768; e += NTHR) mu[e] = F.in[e < 384 ? 8 : 9][1536 + (e < 384 ? e : e - 384)]; }
        __syncthreads();
#ifdef PROBE_AMODE
        { int hl0 = -1; for (int u = F.bid; u < NB * NCHK * 8; u += F.G) rwkvA_unit<PROBE_AMODE>(F, u, hl0, -1, -1); }
        xcd_barrier(bar);
#endif
        for (int rp = 0; rp < REPS(3); ++rp) { int hl = -1, pre = -1; for (int u = F.bid; u < NB * NCHK * 8; u += F.G) { const int un = u + F.G < NB * NCHK * 8 ? u + F.G : -1; rwkvA_unit<0>(F, u, hl, pre, un); pre = (((u >> 3) % NCHK) < 4) ? 4 : 8; } if (rp + 1 < REPS(3)) xcd_barrier(bar); }
        SEAM(3);
    }
    if (IN(4)) {
        LAS float* rpbs = (LAS float*)F.lds;
        LAS bf16* ck = (LAS bf16*)(F.lds + 16384);
        LAS bf16* cvt = (LAS bf16*)(F.lds + 16384 + 36864);
        for (int e = F.tid; e < 8 * 465 + 224; e += NTHR) rpbs[e] = e < 8 * 465 ? 8.0f * F.in[7][e] : -1e30f;
        {
            const int vb = F.bid, bh = (vb >> 3) & 31, b4 = bh >> 3, h4 = bh & 7, sub = vb & 7;
            { const bf16* Zc = Z + ((size_t)MT + b4 * LC) * PINP + ZK + h4 * 64; const bf16* VTCg = (const bf16*)(F.ws + WS_VT) + VT_LAT_ELEMS + (size_t)bh * 64 * LC;
              for (int e = F.tid; e < 256 * 8; e += NTHR) { const int row = e >> 3, c8 = (e & 7) * 8; *(LAS v4u*)(ck + row * NA_KP + c8) = *(const GAS v4u*)(Zc + (size_t)row * PINP + c8); }
              for (int e = F.tid; e < 64 * 32; e += NTHR) { const int row = e >> 5, c8 = (e & 31) * 8; *(LAS v4u*)(cvt + row * NA_VP + c8) = *(const GAS v4u*)(VTCg + (size_t)row * LC + c8); } }
            __syncthreads();
            if (vb < 256) {
                if (DUP(4)) { if (F.wave > 0) for (int tk = F.wave - 1; tk < 64; tk += 7) na_wave_task(F, (b4 << 12) | ((16 * sub + (tk >> 2)) << 5) | (h4 << 2) | (tk & 3), rpbs, ck, cvt, ZV); }
                if (F.wave == 0) { rwkvB_task(F, vb);
                    { const int ze = z_early_tiles(F.G); for (int w2t = ze + vb; w2t < ze + W2_EARLY_TILES; w2t += 256) cvt_w2_tile(F, w2t); } }
                else { for (int tk = F.wave - 1; tk < 64; tk += 7) na_wave_task(F, (b4 << 12) | ((16 * sub + (tk >> 2)) << 5) | (h4 << 2) | (tk & 3), rpbs, ck, cvt); }
            }
        }
        if (REPS(4) > 1) { xcd_barrier(bar); if (F.wave == 0 && F.bid < 256) rwkvB_task(F, F.bid); }
        SEAM(4);
    }
    if (IN(5)) { for (int rp = 0; rp < REPS(5); ++rp) { phase_readout(F); if (rp + 1 < REPS(5)) xcd_barrier(bar); } SEAM(5); }
    if (IN(6)) {
        pg8::StaticOrder S; S.init(MT, D, F.G, F.bid);
        { pg8::Gemm g{Z + ZQ, (const bf16*)(F.ws + WS_WPA), MT, D, 512, PINP, 1 << 30, 0};
          pg8::EpiGate<0> E{(bf16*)(F.ws + WS_LORA), D, Z + ZGNA, PINP};
          pg8::gemm_phase<pg8::EpiGate<0>, pg8::StaticOrder, true, true>(ring, g, S, E); }
        VM_WAIT(); __syncthreads();
        { pg8::Gemm g{Z + ZK, (const bf16*)(F.ws + WS_WPR), MT, D, 512, PINP, 1 << 30, 0};
          pg8::EpiGate<1> E{(bf16*)(F.ws + WS_LORA), D, Z + ZGRW, PINP};
          pg8::gemm_phase<pg8::EpiGate<1>, pg8::StaticOrder, true, true>(ring, g, S, E); }
        if (DUP(6)) { xcd_barrier(bar);

        { pg8::Gemm g{Z + ZQ, (const bf16*)(F.ws + WS_WPA), MT, D, 512, PINP, 1 << 30, 0};
          pg8::EpiGate<0> E{(bf16*)(F.ws + WS_LORA), D, Z + ZGNA, PINP};
          pg8::gemm_phase<pg8::EpiGate<0>, pg8::StaticOrder, true, true>(ring, g, S, E); }
        VM_WAIT(); __syncthreads();
        { pg8::Gemm g{Z + ZK, (const bf16*)(F.ws + WS_WPR), MT, D, 512, PINP, 1 << 30, 0};
          pg8::EpiGate<1> E{(bf16*)(F.ws + WS_LORA), D, Z + ZGRW, PINP};
          pg8::gemm_phase<pg8::EpiGate<1>, pg8::StaticOrder, true, true>(ring, g, S, E); }
        }
        SEAM(6);
    }
    if (IN(7)) {
        pg8::Gemm g{(const bf16*)(F.ws + WS_LORA), (const bf16*)(F.ws + WS_WO), MT, D, D, D, 1 << 30, 0};
        pg8::StaticOrder S; S.init(MT, D, F.G, F.bid);
        pg8::EpiResid E{F.out, F.in[0], (const float*)(F.ws + WS_MOD) + 2048, 6144, T, ALPHA};
        pg8::gemm_phase<pg8::EpiResid, pg8::StaticOrder, true, true>(ring, g, S, E);
        if (DUP(7)) { xcd_barrier(bar); pg8::gemm_phase<pg8::EpiResid, pg8::StaticOrder, true, true>(ring, g, S, E); }
        SEAM(7);
    }
    if (IN(8)) { if (DUP(8)) { phase_ln1_router(F, (float*)(F.ws + WS_YE)); xcd_barrier(bar); } phase_ln1_router(F); SEAM(8); }
    if (IN(9)) { for (int rp = 0; rp < REPS(9); ++rp) { phase_topk_convert(F); if (rp + 1 < REPS(9)) xcd_barrier(bar); } SEAM(9); }
    if (IN(11)) {
        pg8::Gemm g{(const bf16*)(F.ws + WS_XS), (const bf16*)(F.ws + WS_W13), NSLOT, PINP, D / 2, D / 2, 16, (size_t)PINP * 1024};
        pg8::StaticOrder S; S.init(NSLOT, PINP, F.G, F.bid);
        pg8::EpiSwiglu E{F.ws + WS_HDN, DE, 1.0f / W13_SCALE, HDN_SCALE};
        pg8::gemm_phase<pg8::EpiSwiglu, pg8::StaticOrder, true, true, true>(ring, g, S, E);
        if (DUP(11)) { xcd_barrier(bar); pg8::gemm_phase<pg8::EpiSwiglu, pg8::StaticOrder, true, true, true>(ring, g, S, E); }
        SEAM(11);
    }
    if (IN(12)) {
        pg8::Gemm g{(const bf16*)(F.ws + WS_HDN), (const bf16*)(F.ws + WS_W2), NSLOT, D, DE / 2, DE / 2, 16, (size_t)1024 * DE};
        pg8::StaticOrder S; S.init(NSLOT, D, F.G, F.bid);
        pg8::EpiScaleRow E{(bf16*)(F.ws + WS_YE), D, (const float*)(F.ws + WS_GATEV), 1.0f / (W2_SCALE * HDN_SCALE)};
        pg8::gemm_phase<pg8::EpiScaleRow, pg8::StaticOrder, true, true, true>(ring, g, S, E);
        if (DUP(12)) { xcd_barrier(bar); pg8::gemm_phase<pg8::EpiScaleRow, pg8::StaticOrder, true, true, true>(ring, g, S, E); }
        if (IN(12) && IN(15)) xcd_barrier(bar);
    }
    if (IN(15)) { if (DUP(15)) { phase_final(F, (float*)(F.ws + WS_HDN)); xcd_barrier(bar); } phase_final(F); }
#undef IN
#undef SEAM
}

extern "C" void kernel_launch(void* const* d_in, const int* in_sizes, int n_in, void* d_out, int out_size, void* d_ws, size_t ws_size, hipStream_t stream) {
    static int grid = 0;
    if (grid == 0) {
        if (n_in != 31 || out_size != MT * D || ws_size < WS_END) { fprintf(stderr, "kernel_launch: unexpected shapes (n_in %d, out %d, ws %zu); nothing launched\n", n_in, out_size, ws_size); grid = -1; return; }
        int dev = 0, cus = 0, per_cu = 0;
        if (hipGetDevice(&dev) != hipSuccess || hipDeviceGetAttribute(&cus, hipDeviceAttributeMultiprocessorCount, dev) != hipSuccess) { grid = -1; return; }
        if (hipFuncSetAttribute((const void*)fwd, hipFuncAttributeMaxDynamicSharedMemorySize, LDS_BYTES) != hipSuccess) { fprintf(stderr, "kernel_launch: hipFuncSetAttribute failed\n"); grid = -1; return; }
        if (hipOccupancyMaxActiveBlocksPerMultiprocessor(&per_cu, (const void*)fwd, NTHR, LDS_BYTES) != hipSuccess || per_cu < 1) fprintf(stderr, "kernel_launch: occupancy query reports %d\n", per_cu);
        (void)hipGetLastError();
        grid = cus;
        if (grid < 256) { fprintf(stderr, "kernel_launch: this kernel needs >= 256 CUs (got %d); nothing launched\n", cus); grid = -1; return; }
    }
    if (grid < 0) return;
    (void)hipMemsetAsync((char*)d_ws + WS_CTL, 0, CTL_ZERO_BYTES, stream);
    Args a{};
    for (int i = 0; i < 31; ++i) a.in[i] = (const float*)d_in[i];
    a.out = (float*)d_out; a.ws = (unsigned char*)d_ws;
#if MK_ONE_LAUNCH
    a.ph_lo = 0; a.ph_hi = 16;
    hipLaunchKernelGGL(fwd, dim3(grid), dim3(NTHR), LDS_BYTES, stream, a);
#else
    for (int p = 0; p < 16; ++p) { a.ph_lo = p; a.ph_hi = p + 1; hipLaunchKernelGGL(fwd, dim3(grid), dim3(NTHR), LDS_BYTES, stream, a); }
#endif
}
```

```cpp
#include <hip/hip_runtime.h>
#include <cstdio>
#include <cstdint>

#ifndef PROBE_REP
#define PROBE_REP 0
#endif
#define REPS(k) (((PROBE_REP >> (k)) & 1) ? 2 : 1)
#ifndef PROBE_DUP
#define PROBE_DUP 0
#endif
#define DUP(k) ((PROBE_DUP >> (k)) & 1)
#ifndef MK_ONE_LAUNCH
#define MK_ONE_LAUNCH 1
#endif

namespace pg8 {
#define PG8_LAS __attribute__((address_space(3)))
typedef unsigned short bf16_t;
typedef short bf16x8 __attribute__((ext_vector_type(8)));
typedef float f32x4 __attribute__((ext_vector_type(4)));
typedef unsigned u32x4 __attribute__((ext_vector_type(4)));
typedef unsigned u32x2 __attribute__((ext_vector_type(2)));
constexpr int BM = 256, BK = 64, HALF = 128, HTB = HALF * BK * 2, STAGE_BYTES = 8 * HTB, NXCD = 8, WGM = 8;

__host__ __device__ __forceinline__ int lds_byte(int r, int c) { const int st = (r >> 4) * 2 + (c >> 5), rr = r & 15, cc = c & 31, ob = rr * 64 + cc * 2; return st * 1024 + (ob ^ (((ob >> 9) & 1) << 5)); }
__host__ __device__ __forceinline__ void stage_rc(int b, int& R, int& C) { const int st = b / 1024, sb = b % 1024, swz = sb ^ (((sb >> 9) & 1) << 5); R = (st >> 1) * 16 + swz / 64; C = (st & 1) * 32 + (swz % 64) / 2; }
__host__ __device__ __forceinline__ int perm32(int rho) { const int n = rho >> 4, i = rho & 15; return 8 * (i >> 2) + 4 * n + (i & 3); }

struct Unit { int pm, pn; };
struct Gemm { const bf16_t* A; const bf16_t* Bt; int M, N, K, lda; int pmg; size_t bgs; };

struct StaticOrder {
    int nM, nN, nwg, G, c;
    __host__ __device__ void init(int M, int N, int G_, int c_) { nM = M / BM; nN = N / BM; nwg = nM * nN; G = G_; c = c_; }
    __host__ __device__ bool next(int i, Unit& u) const {
        const long L = (long)i * G + c; if (L >= nwg) return false;
        int wgid = (int)L; { const int q = nwg / NXCD, r = nwg % NXCD, xcd = wgid % NXCD, off = wgid / NXCD; wgid = (xcd < r ? xcd * (q + 1) : r * (q + 1) + (xcd - r) * q) + off; }
        const int nig = WGM * nN, gid = wgid / nig, fm = gid * WGM, gsz = (nM - fm) < WGM ? (nM - fm) : WGM;
        u.pm = fm + ((wgid % nig) % gsz); u.pn = (wgid % nig) / gsz; return true;
    }
    __device__ __forceinline__ void a_ready(const Unit&) const {}
    __device__ __forceinline__ void done(const Unit&) const {}
};

typedef __bf16 bf16x2_t __attribute__((ext_vector_type(2)));
typedef float f32x2_t __attribute__((ext_vector_type(2)));
__device__ __forceinline__ unsigned cvt_pk_bf16(float lo, float hi) { const f32x2_t v = {lo, hi}; const bf16x2_t b = __builtin_convertvector(v, bf16x2_t); return __builtin_bit_cast(unsigned, b); }
__device__ __forceinline__ float bf_lo(unsigned w) { return __uint_as_float(w << 16); }
__device__ __forceinline__ float bf_hi(unsigned w) { return __uint_as_float(w & 0xffff0000u); }
__device__ __forceinline__ float sigmoidf_(float x) { return __builtin_amdgcn_rcpf(1.0f + __expf(-x)); }

struct EpiBf16 {
    static constexpr bool PERM = true;
    bf16_t* O; int ldc;
    __device__ __forceinline__ void operator()(const f32x4 (&acc)[2][2][4][2], const Unit& u, int wr, int wc, int fr, int fq) const {
        const int row0 = u.pm * BM + wr * 64 + fr, col0 = u.pn * BM + wc * 32 + 8 * fq;
#pragma unroll
        for (int ai = 0; ai < 2; ++ai)
#pragma unroll
            for (int m = 0; m < 4; ++m) { bf16_t* rowp = O + (size_t)(row0 + ai * HALF + m * 16) * ldc + col0;
#pragma unroll
                for (int bj = 0; bj < 2; ++bj) { const f32x4 v0 = acc[ai][bj][m][0], v1 = acc[ai][bj][m][1];
                    u32x4 w; w.x = cvt_pk_bf16(v0[0], v0[1]); w.y = cvt_pk_bf16(v0[2], v0[3]); w.z = cvt_pk_bf16(v1[0], v1[1]); w.w = cvt_pk_bf16(v1[2], v1[3]);
                    *(u32x4*)(rowp + bj * HALF) = w; } }
    }
};
template <int MODE> struct EpiGate {
    static constexpr bool PERM = true;
    bf16_t* O; int ldc; const bf16_t* G; int ldg;
    __device__ __forceinline__ void operator()(const f32x4 (&acc)[2][2][4][2], const Unit& u, int wr, int wc, int fr, int fq) const {
        const int row0 = u.pm * BM + wr * 64 + fr, col0 = u.pn * BM + wc * 32 + 8 * fq;
#pragma unroll
        for (int ai = 0; ai < 2; ++ai)
#pragma unroll
            for (int m = 0; m < 4; ++m) { const size_t row = (size_t)(row0 + ai * HALF + m * 16);
#pragma unroll
                for (int bj = 0; bj < 2; ++bj) { const f32x4 v0 = acc[ai][bj][m][0], v1 = acc[ai][bj][m][1];
                    const u32x4 gz = *(const u32x4*)(G + row * ldg + col0 + bj * HALF);
                    float o[8];
                    o[0] = sigmoidf_(bf_lo(gz.x)) * v0[0]; o[1] = sigmoidf_(bf_hi(gz.x)) * v0[1]; o[2] = sigmoidf_(bf_lo(gz.y)) * v0[2]; o[3] = sigmoidf_(bf_hi(gz.y)) * v0[3];
                    o[4] = sigmoidf_(bf_lo(gz.z)) * v1[0]; o[5] = sigmoidf_(bf_hi(gz.z)) * v1[1]; o[6] = sigmoidf_(bf_lo(gz.w)) * v1[2]; o[7] = sigmoidf_(bf_hi(gz.w)) * v1[3];
                    bf16_t* op = O + row * ldc + col0 + bj * HALF;
                    if (MODE == 1) { const u32x4 pz = *(const u32x4*)op;
                        o[0] += bf_lo(pz.x); o[1] += bf_hi(pz.x); o[2] += bf_lo(pz.y); o[3] += bf_hi(pz.y); o[4] += bf_lo(pz.z); o[5] += bf_hi(pz.z); o[6] += bf_lo(pz.w); o[7] += bf_hi(pz.w); }
                    u32x4 w; w.x = cvt_pk_bf16(o[0], o[1]); w.y = cvt_pk_bf16(o[2], o[3]); w.z = cvt_pk_bf16(o[4], o[5]); w.w = cvt_pk_bf16(o[6], o[7]);
                    *(u32x4*)op = w; } }
    }
};
struct EpiResid {
    static constexpr bool PERM = false;
    float* O; const float* X; const float* gt; int gt_pitch; int rows_per_b; float alpha;
    __device__ __forceinline__ void operator()(const f32x4 (&acc)[2][2][4][2], const Unit& u, int wr, int wc, int fr, int fq) const {
        const int row0 = u.pm * BM + wr * 64 + fr, col0 = u.pn * BM + wc * 32 + 4 * fq;
        const float* gtb = gt + (size_t)((u.pm * BM) / rows_per_b) * gt_pitch + col0;
        f32x4 gv[2][2];
#pragma unroll
        for (int bj = 0; bj < 2; ++bj)
#pragma unroll
            for (int n = 0; n < 2; ++n) gv[bj][n] = *(const f32x4*)(gtb + bj * HALF + n * 16);
#pragma unroll
        for (int ai = 0; ai < 2; ++ai)
#pragma unroll
            for (int m = 0; m < 4; ++m) { const size_t off = (size_t)(row0 + ai * HALF + m * 16) * 1024 + col0;
#pragma unroll
                for (int bj = 0; bj < 2; ++bj)
#pragma unroll
                    for (int n = 0; n < 2; ++n) { const f32x4 xv = *(const f32x4*)(X + off + bj * HALF + n * 16);
                        *(f32x4*)(O + off + bj * HALF + n * 16) = xv * alpha + gv[bj][n] * acc[ai][bj][m][n]; } }
    }
};
struct EpiSwiglu {
    static constexpr bool PERM = true;
    unsigned char* H; int ldh; float as, hs;
    __device__ __forceinline__ void operator()(const f32x4 (&acc)[2][2][4][2], const Unit& u, int wr, int wc, int fr, int fq) const {
        const int row0 = u.pm * BM + wr * 64 + fr, col0 = u.pn * HALF + wc * 32 + 8 * fq;
#pragma unroll
        for (int ai = 0; ai < 2; ++ai)
#pragma unroll
            for (int m = 0; m < 4; ++m) { unsigned char* rowp = H + (size_t)(row0 + ai * HALF + m * 16) * ldh + col0;
                float o[8];
#pragma unroll
                for (int n = 0; n < 2; ++n)
#pragma unroll
                    for (int j = 0; j < 4; ++j) { const float a = acc[ai][0][m][n][j] * as, b = acc[ai][1][m][n][j] * as; o[n * 4 + j] = fminf(fmaxf(a * sigmoidf_(a) * b * hs, -448.f), 448.f); }
                u32x2 w; w.x = (unsigned)__builtin_amdgcn_cvt_pk_fp8_f32(o[2], o[3], __builtin_amdgcn_cvt_pk_fp8_f32(o[0], o[1], 0, false), true);
                w.y = (unsigned)__builtin_amdgcn_cvt_pk_fp8_f32(o[6], o[7], __builtin_amdgcn_cvt_pk_fp8_f32(o[4], o[5], 0, false), true);
                *(u32x2*)rowp = w; }
    }
};
struct EpiScaleRow {
    static constexpr bool PERM = true;
    bf16_t* O; int ldc; const float* gate; float sc;
    __device__ __forceinline__ void operator()(const f32x4 (&acc)[2][2][4][2], const Unit& u, int wr, int wc, int fr, int fq) const {
        const int row0 = u.pm * BM + wr * 64 + fr, col0 = u.pn * BM + wc * 32 + 8 * fq;
#pragma unroll
        for (int ai = 0; ai < 2; ++ai)
#pragma unroll
            for (int m = 0; m < 4; ++m) { const int row = row0 + ai * HALF + m * 16; const float gsc = gate[row] * sc; bf16_t* rowp = O + (size_t)row * ldc + col0;
#pragma unroll
                for (int bj = 0; bj < 2; ++bj) { const f32x4 v0 = acc[ai][bj][m][0] * gsc, v1 = acc[ai][bj][m][1] * gsc;
                    u32x4 w; w.x = cvt_pk_bf16(v0[0], v0[1]); w.y = cvt_pk_bf16(v0[2], v0[3]); w.z = cvt_pk_bf16(v1[0], v1[1]); w.w = cvt_pk_bf16(v1[2], v1[3]);
                    *(u32x4*)(rowp + bj * HALF) = w; } }
    }
};

typedef int v8i_t __attribute__((ext_vector_type(8)));
typedef int v4i_t __attribute__((ext_vector_type(4)));
template <class Epi, class Sched, bool ALIGN_EPI = false, bool SP2 = false, bool FP8 = false>
__device__ __forceinline__ void gemm_phase(PG8_LAS unsigned char* lds, const Gemm g, const Sched& S, const Epi& E) {
    const int tid = threadIdx.x, wid = __builtin_amdgcn_readfirstlane(tid >> 6), lane = tid & 63, wr = wid >> 2, wc = wid & 3, fr = lane & 15, fq = lane >> 4;
    const int K = g.K, nt = K / BK;
    unsigned voffA[2], voffB[2];
#pragma unroll
    for (int i = 0; i < 2; ++i) { int R, C; stage_rc(tid * 16 + i * 8192, R, C); const int Rb = Epi::PERM ? ((R & ~31) + perm32(R & 31)) : R;
        voffA[i] = (unsigned)(R * g.lda + C) * 2u; voffB[i] = (unsigned)(Rb * K + C) * 2u; }
    const size_t kstep = (size_t)(BK * 2);
    const size_t hstepA = (size_t)HALF * g.lda * 2, tstepA = 2 * hstepA;
    const size_t hstepB = (size_t)HALF * K * 2, tstepB = 2 * hstepB;
    const unsigned ldsw = (unsigned)wid * 1024u;
    const int aoff = lds_byte(wr * 64 + fr, fq * 8), boff = lds_byte(wc * 32 + fr, fq * 8);
#define PG8_SA(b, h) (((b) * 2 + (h)) * HTB)
#define PG8_SB(b, h) ((4 + (b) * 2 + (h)) * HTB)
#define PG8_STAGE(bufoff, gbase, voff) do { _Pragma("unroll") for (int _i = 0; _i < 2; ++_i) \
        __builtin_amdgcn_global_load_lds((const unsigned*)((const char*)(gbase) + (voff)[_i]), (PG8_LAS unsigned*)(lds + (bufoff) + ldsw + _i * 8192), 16, 0, 0); } while (0)
#define PG8_LDA(dst, b, h) do { if constexpr (FP8) { _Pragma("unroll") for (int m = 0; m < 4; ++m) dst##8[m] = __builtin_shufflevector(*(const PG8_LAS v4i_t*)(lds + PG8_SA(b, h) + aoff + m * 2048), *(const PG8_LAS v4i_t*)(lds + PG8_SA(b, h) + aoff + m * 2048 + 1024), 0, 1, 2, 3, 4, 5, 6, 7); } \
    else { _Pragma("unroll") for (int m = 0; m < 4; ++m) _Pragma("unroll") for (int k = 0; k < 2; ++k) dst[m][k] = *(const PG8_LAS bf16x8*)(lds + PG8_SA(b, h) + aoff + m * 2048 + k * 1024); } } while (0)
#define PG8_LDB(dst, b, h) do { if constexpr (FP8) { _Pragma("unroll") for (int n = 0; n < 2; ++n) dst##8[n] = __builtin_shufflevector(*(const PG8_LAS v4i_t*)(lds + PG8_SB(b, h) + boff + n * 2048), *(const PG8_LAS v4i_t*)(lds + PG8_SB(b, h) + boff + n * 2048 + 1024), 0, 1, 2, 3, 4, 5, 6, 7); } \
    else { _Pragma("unroll") for (int n = 0; n < 2; ++n) _Pragma("unroll") for (int k = 0; k < 2; ++k) dst[n][k] = *(const PG8_LAS bf16x8*)(lds + PG8_SB(b, h) + boff + n * 2048 + k * 1024); } } while (0)
#define PG8_MMA(ai, bj, At, Bt) do { __builtin_amdgcn_s_setprio(1); _Pragma("unroll") for (int m = 0; m < 4; ++m) _Pragma("unroll") for (int n = 0; n < 2; ++n) { \
        if constexpr (FP8) { asm volatile("v_mfma_scale_f32_16x16x128_f8f6f4 %0, %1, %2, %0, %3, %3 op_sel_hi:[0,0,0]" : "+v"(acc[ai][bj][m][n]) : "v"(Bt##8[n]), "v"(At##8[m]), "v"(sc1)); } \
        else { _Pragma("unroll") for (int k = 0; k < 2; ++k) acc[ai][bj][m][n] = __builtin_amdgcn_mfma_f32_16x16x32_bf16(Bt[n][k], At[m][k], acc[ai][bj][m][n], 0, 0, 0); } } \
        __builtin_amdgcn_s_setprio(0); } while (0)
#define PG8_WAIT_V(n) asm volatile("s_waitcnt vmcnt(" #n ")" ::: "memory")
#define PG8_WAIT_L(n) asm volatile("s_waitcnt lgkmcnt(" #n ")" ::: "memory")
#define PG8_BAR __builtin_amdgcn_s_barrier()
#define PG8_SCHED __builtin_amdgcn_sched_barrier(0)
    Unit cur, nxt; int ui = 0;
    if (!S.next(0, cur)) return;
    f32x4 acc[2][2][4][2];
#pragma unroll
    for (int a = 0; a < 2; ++a)
#pragma unroll
        for (int b = 0; b < 2; ++b)
#pragma unroll
            for (int m = 0; m < 4; ++m)
#pragma unroll
                for (int n = 0; n < 2; ++n) acc[a][b][m][n] = (f32x4){0.f, 0.f, 0.f, 0.f};
    bf16x8 At[4][2], B0[2][2], B1[2][2]; v8i_t At8[4], B08[2], B18[2]; const int sc1 = 0x7f7f7f7f;
    const char* cA = (const char*)g.A + (size_t)cur.pm * tstepA; const char* cB = (const char*)g.Bt + (size_t)cur.pn * tstepB + (size_t)(cur.pm / g.pmg) * g.bgs;
    S.a_ready(cur);
    if constexpr (SP2) {
        PG8_STAGE(PG8_SB(0, 0), cB, voffB); PG8_STAGE(PG8_SB(0, 1), cB + hstepB, voffB); PG8_STAGE(PG8_SA(0, 0), cA, voffA); PG8_STAGE(PG8_SA(0, 1), cA + hstepA, voffA);
        if (wr == 1) PG8_BAR;
        PG8_WAIT_V(2); PG8_BAR;
        PG8_STAGE(PG8_SB(1, 0), cB + kstep, voffB); PG8_STAGE(PG8_SA(1, 0), cA + kstep, voffA); PG8_STAGE(PG8_SB(1, 1), cB + hstepB + kstep, voffB);
        PG8_WAIT_V(6); PG8_BAR;
    } else {
        PG8_STAGE(PG8_SB(0, 0), cB, voffB); PG8_STAGE(PG8_SA(0, 0), cA, voffA); PG8_STAGE(PG8_SB(0, 1), cB + hstepB, voffB); PG8_STAGE(PG8_SA(0, 1), cA + hstepA, voffA);
        if (wr == 1) PG8_BAR;
        PG8_WAIT_V(4); PG8_BAR;
        PG8_STAGE(PG8_SB(1, 0), cB + kstep, voffB); PG8_STAGE(PG8_SA(1, 0), cA + kstep, voffA); PG8_STAGE(PG8_SB(1, 1), cB + hstepB + kstep, voffB);
        PG8_WAIT_V(6); PG8_BAR;
    }
    for (;;) {
        const bool has_next = S.next(ui + 1, nxt);
        const char* nA = has_next ? (const char*)g.A + (size_t)nxt.pm * tstepA : cA;
        const char* nB = has_next ? (const char*)g.Bt + (size_t)nxt.pn * tstepB + (size_t)(nxt.pm / g.pmg) * g.bgs : cB;
        for (int t = 0; t < nt; t += 2) {
            const bool last = (t == nt - 2);
            const char* a1 = cA + (size_t)(t + 1) * kstep;
            const char* a2 = last ? nA : cA + (size_t)(t + 2) * kstep; const char* b2 = last ? nB : cB + (size_t)(t + 2) * kstep;
            const char* a3 = a2 + kstep; const char* b3 = b2 + kstep;
            if (last && has_next) S.a_ready(nxt);
            if constexpr (SP2) {
            PG8_LDB(B0, 0, 0); PG8_LDB(B1, 0, 1); PG8_SCHED; PG8_LDA(At, 0, 0); PG8_STAGE(PG8_SA(1, 1), a1 + hstepA, voffA);
            PG8_WAIT_V(8); PG8_WAIT_L(0); PG8_BAR; PG8_MMA(0, 0, At, B0); PG8_MMA(0, 1, At, B1); PG8_BAR; PG8_SCHED;
            PG8_LDA(At, 0, 1); PG8_STAGE(PG8_SB(0, 0), b2, voffB); PG8_STAGE(PG8_SB(0, 1), b2 + hstepB, voffB); PG8_STAGE(PG8_SA(0, 0), a2, voffA);
            PG8_WAIT_V(8); PG8_WAIT_L(0); PG8_BAR; PG8_MMA(1, 0, At, B0); PG8_MMA(1, 1, At, B1); PG8_BAR; PG8_SCHED;
            PG8_LDB(B0, 1, 0); PG8_LDB(B1, 1, 1); PG8_SCHED; PG8_LDA(At, 1, 0); PG8_STAGE(PG8_SA(0, 1), a2 + hstepA, voffA);
            PG8_WAIT_V(8); PG8_WAIT_L(0); PG8_BAR; PG8_MMA(0, 0, At, B0); PG8_MMA(0, 1, At, B1); PG8_BAR; PG8_SCHED;
            PG8_LDA(At, 1, 1); PG8_STAGE(PG8_SB(1, 0), b3, voffB); PG8_STAGE(PG8_SB(1, 1), b3 + hstepB, voffB); PG8_STAGE(PG8_SA(1, 0), a3, voffA);
            PG8_WAIT_V(8); PG8_WAIT_L(0); PG8_BAR; PG8_MMA(1, 0, At, B0); PG8_MMA(1, 1, At, B1); PG8_BAR; PG8_SCHED;
            } else {
            PG8_LDB(B0, 0, 0); PG8_SCHED; PG8_LDA(At, 0, 0); PG8_STAGE(PG8_SA(1, 1), a1 + hstepA, voffA);
            PG8_WAIT_L(8); PG8_BAR; PG8_WAIT_L(0); PG8_MMA(0, 0, At, B0); PG8_BAR; PG8_SCHED;
            PG8_LDB(B1, 0, 1); PG8_STAGE(PG8_SB(0, 0), b2, voffB);
            PG8_BAR; PG8_WAIT_L(0); PG8_MMA(0, 1, At, B1); PG8_BAR;
            PG8_LDA(At, 0, 1); PG8_STAGE(PG8_SA(0, 0), a2, voffA);
            PG8_BAR; PG8_WAIT_L(0); PG8_MMA(1, 0, At, B0); PG8_BAR; PG8_SCHED;
            PG8_STAGE(PG8_SB(0, 1), b2 + hstepB, voffB);
            PG8_WAIT_V(6); PG8_BAR; PG8_MMA(1, 1, At, B1); PG8_BAR;
            PG8_LDB(B0, 1, 0); PG8_SCHED; PG8_LDA(At, 1, 0); PG8_STAGE(PG8_SA(0, 1), a2 + hstepA, voffA);
            PG8_WAIT_L(8); PG8_BAR; PG8_WAIT_L(0); PG8_MMA(0, 0, At, B0); PG8_BAR; PG8_SCHED;
            PG8_LDB(B1, 1, 1); PG8_STAGE(PG8_SB(1, 0), b3, voffB);
            PG8_BAR; PG8_WAIT_L(0); PG8_MMA(0, 1, At, B1); PG8_BAR;
            PG8_LDA(At, 1, 1); PG8_STAGE(PG8_SA(1, 0), a3, voffA);
            PG8_BAR; PG8_WAIT_L(0); PG8_MMA(1, 0, At, B0); PG8_BAR; PG8_SCHED;
            PG8_STAGE(PG8_SB(1, 1), b3 + hstepB, voffB);
            PG8_WAIT_V(6); PG8_BAR; PG8_MMA(1, 1, At, B1); PG8_BAR;
            }
        }
        if constexpr (ALIGN_EPI) { if (wr == 0) PG8_BAR; }
        if constexpr (FP8) asm volatile("s_nop 15\n\ts_nop 15" ::: "memory");
        E(acc, cur, wr, wc, fr, fq); S.done(cur);
        if (!has_next) break;
#pragma unroll
        for (int a = 0; a < 2; ++a)
#pragma unroll
            for (int b = 0; b < 2; ++b)
#pragma unroll
                for (int m = 0; m < 4; ++m)
#pragma unroll
                    for (int n = 0; n < 2; ++n) acc[a][b][m][n] = (f32x4){0.f, 0.f, 0.f, 0.f};
        cur = nxt; cA = nA; cB = nB; ++ui;
        if constexpr (FP8) asm volatile("s_nop 7" ::: "memory");
        if constexpr (ALIGN_EPI) { if (wr == 1) PG8_BAR; }
    }
    PG8_WAIT_V(0);
    if constexpr (!ALIGN_EPI) { if (wr == 0) PG8_BAR; }
    PG8_BAR;
#undef PG8_SA
#undef PG8_SB
#undef PG8_STAGE
#undef PG8_LDA
#undef PG8_LDB
#undef PG8_MMA
#undef PG8_WAIT_V
#undef PG8_WAIT_L
#undef PG8_BAR
#undef PG8_SCHED
}
}

constexpr int NWAVES = 8, NTHR = 512;
constexpr int NB = 4, T = 8192, D = 1024, LC = 256, GW = 64, GH = 128;
constexpr int MT = NB * T, MC = NB * LC, MA = MT + MC;
constexpr int PIN = 5504, PINP = 5632;
constexpr int ZQ = 0, ZK = 512, ZV = 1024, ZRW = 1536, ZR = 1536, ZRK = 2048, ZRV = 2560, ZLORA = 3072, ZG = 3456, ZGNA = 3456, ZGRW = 4480;
constexpr int NE = 16, CAP = 1024, DE = 2816, NSLOT = NB * NE * CAP;
constexpr float ALPHA = 1.189207115f;
constexpr float LN_EPS = 1e-6f, GN_EPS = 64e-5f;
constexpr int LORAW = 2560;

constexpr size_t MiB = 1u << 20;
constexpr size_t WS_CTL = 0, CTL_ZERO_BYTES = 1 * MiB;
constexpr size_t WS_MOD = 1 * MiB;
constexpr size_t WS_WIN = 2 * MiB;
constexpr size_t WS_WPA = 13 * MiB, WS_WPR = 14 * MiB, WS_WO = 15 * MiB;
constexpr size_t WS_AFF = 17 * MiB;
constexpr size_t WS_IDX = 19 * MiB;
constexpr size_t WS_GATEV = 19 * MiB + 256 * 1024;
constexpr size_t WS_SLOT = 20 * MiB;
constexpr size_t WS_U = 22 * MiB;
constexpr size_t WS_Z = 88 * MiB;
constexpr size_t WS_LORA = 451 * MiB;
constexpr size_t WS_ROPE = 1 * MiB + 128 * 1024;
constexpr size_t WS_LW = 1 * MiB + 512 * 1024;
constexpr size_t WS_COEF = 17 * MiB;
constexpr size_t WS_YFB = 22 * MiB;
constexpr size_t WS_PQ = 451 * MiB;
constexpr size_t WS_G = 583 * MiB;
constexpr size_t WS_VT = 616 * MiB;
constexpr size_t WS_END1 = 616 * MiB;
constexpr size_t WS_U2 = 22 * MiB;
constexpr size_t WS_W13 = 54 * MiB;
constexpr size_t WS_W2 = 654 * MiB;
constexpr size_t WS_XS = 186 * MiB;
constexpr size_t WS_HDN = 250 * MiB;
constexpr size_t WS_YE = 426 * MiB;
constexpr float W13_SCALE = 64.f, W2_SCALE = 128.f, HDN_SCALE = 8.f;
constexpr size_t WS_END = 698 * MiB;
constexpr int W2_EARLY_TILES = 256 * 12;
static_assert(WS_VT + (size_t)34 * MiB <= WS_END, "ws map");
constexpr size_t VT_LAT_ELEMS = (size_t)NB * 8 * 64 * T, VT_CTX_ELEMS = (size_t)NB * 8 * 64 * LC;

constexpr int RING_BYTES = 131072, LDS_BYTES = 147456, LDSCTL_OFF = LDS_BYTES - 512, MISC_OFF = LDSCTL_OFF + 320;

#define GAS __attribute__((address_space(1)))
#define LAS __attribute__((address_space(3)))
typedef unsigned short bf16;
typedef unsigned v4u __attribute__((ext_vector_type(4)));
typedef unsigned v2u __attribute__((ext_vector_type(2)));
typedef float f32x4 __attribute__((ext_vector_type(4)));
typedef float f32x2 __attribute__((ext_vector_type(2)));
typedef short bf16x8 __attribute__((ext_vector_type(8)));
typedef short bf16x4 __attribute__((ext_vector_type(4)));
typedef GAS unsigned gu32;
#define RLX_AGENT __ATOMIC_RELAXED, __HIP_MEMORY_SCOPE_AGENT
#define LDS_WAIT() asm volatile("s_waitcnt lgkmcnt(0)" ::: "memory")
#define VM_WAIT() asm volatile("s_waitcnt vmcnt(0)" ::: "memory")
__device__ __forceinline__ unsigned f2bf(float f) { return pg8::cvt_pk_bf16(f, f) & 0xffffu; }
__device__ __forceinline__ unsigned pk2(float lo, float hi) { return pg8::cvt_pk_bf16(lo, hi); }
__device__ __forceinline__ float bf2f(bf16 b) { return __uint_as_float(((unsigned)b) << 16); }
__device__ __forceinline__ float bflo(unsigned w) { return __uint_as_float(w << 16); }
__device__ __forceinline__ float bfhi(unsigned w) { return __uint_as_float(w & 0xffff0000u); }
__device__ __forceinline__ float sigm(float x) { return 1.0f / (1.0f + __expf(-x)); }

#define XB_TMO      128
#define XB_XCNT(j)  (256  + 64 * (j))
#define XB_XSUB(j)  (1280 + 64 * (j))
#define XB_XGEN(j)  (2304 + 64 * (j))
#define XB_TOP      3328
#define XB_TOPGEN   3392
#define XCD_BAR_WORDS 3456
#define XB_SPIN_CAP (1u << 18)
__device__ __forceinline__ unsigned xb_ld(unsigned* p)              { return __hip_atomic_load(p, __ATOMIC_RELAXED, __HIP_MEMORY_SCOPE_AGENT); }
__device__ __forceinline__ unsigned xb_add(unsigned* p, unsigned v) { return __hip_atomic_fetch_add(p, v, __ATOMIC_RELAXED, __HIP_MEMORY_SCOPE_AGENT); }
__device__ __forceinline__ unsigned xb_xcc_id() { return (unsigned)__builtin_amdgcn_s_getreg((3 << 11) | 20) & 0xFu; }
#define XB_SPIN(cond, bar) do { unsigned _sp = 0; while (cond) { __builtin_amdgcn_s_sleep(1); \
    if ((++_sp & 255u) == 0u) { if (xb_ld(&(bar)[XB_TMO])) break; if (_sp > XB_SPIN_CAP) { atomicAdd(&(bar)[XB_TMO], 1u); break; } } } } while (0)
struct XcdBarrier { unsigned* bar; unsigned x; volatile LAS unsigned* st; };
__device__ __forceinline__ XcdBarrier xcd_barrier_post(unsigned* bar, volatile LAS unsigned* st) {
    XcdBarrier b; b.bar = bar; b.x = xb_xcc_id(); b.st = st;
    if (threadIdx.x == 0) (void)xb_add(&bar[XB_XCNT(b.x)], 1u);
    return b;
}
__device__ __forceinline__ void xcd_barrier_complete(unsigned* bar, unsigned x, unsigned& nloc, unsigned& nx) {
    const unsigned G = gridDim.x * gridDim.y * gridDim.z;
    unsigned sum, cnt, mine, sp = 0u;
    for (;;) {
        sum = 0u; cnt = 0u; mine = 0u;
#pragma unroll
        for (unsigned j = 0; j < 16; ++j) { const unsigned c = xb_ld(&bar[XB_XCNT(j)]); sum += c; cnt += (c > 0u) ? 1u : 0u; mine = (j == x) ? c : mine; }
        if (sum == G) break;
        __builtin_amdgcn_s_sleep(1);
        if ((++sp & 255u) == 0u) { if (xb_ld(&bar[XB_TMO])) break; if (sp > XB_SPIN_CAP) { atomicAdd(&bar[XB_TMO], 1u); break; } }
    }
    nloc = mine > 0u ? mine : 1u; nx = cnt > 0u ? cnt : 1u;
}
__device__ __forceinline__ void xcd_barrier(const XcdBarrier& b) {
    asm volatile("s_waitcnt vmcnt(0)" ::: "memory");
    __syncthreads();
    if (threadIdx.x == 0) {
        unsigned* bar = b.bar;
        __builtin_amdgcn_s_waitcnt(0);
        unsigned nloc = b.st[0], nx = b.st[1];
        if (nloc == 0u) { xcd_barrier_complete(bar, b.x, nloc, nx); b.st[0] = nloc; b.st[1] = nx; }
        const unsigned old = xb_add(&bar[XB_XSUB(b.x)], 1u);
        const unsigned gen = old / nloc;
        if (old + 1u == (gen + 1u) * nloc) {
            __builtin_amdgcn_fence(__ATOMIC_RELEASE, "agent");
            asm volatile("s_waitcnt vmcnt(0)" ::: "memory");
#pragma unroll
            for (unsigned j = 0; j < 16; ++j) (void)xb_add(&bar[XB_XGEN(j)], 1u);
        }
        const unsigned target = (gen + 1u) * nx;
        XB_SPIN(xb_ld(&bar[XB_XGEN(b.x)]) < target, bar);
        __builtin_amdgcn_fence(__ATOMIC_ACQUIRE, "agent");
        asm volatile("s_waitcnt vmcnt(0)" ::: "memory");
    }
    __syncthreads();
}
constexpr int CW_BAR = 4096;

template <int CTRL> __device__ __forceinline__ float dppf(float v) { return __builtin_bit_cast(float, __builtin_amdgcn_update_dpp(0, __builtin_bit_cast(int, v), CTRL, 0xF, 0xF, true)); }
__device__ __forceinline__ float row16_sum(float v) {
    v += dppf<0xB1>(v);
    v += dppf<0x4E>(v);
    v += dppf<0x141>(v);
    v += dppf<0x140>(v);
    return v;
}

__device__ __forceinline__ float wave_sum(float v) { v = row16_sum(v); v += __shfl_xor(v, 16); v += __shfl_xor(v, 32); return v; }

__device__ __forceinline__ void unpack8(v4u w, float (&o)[8]) { o[0] = bflo(w.x); o[1] = bfhi(w.x); o[2] = bflo(w.y); o[3] = bfhi(w.y); o[4] = bflo(w.z); o[5] = bfhi(w.z); o[6] = bflo(w.w); o[7] = bfhi(w.w); }
__device__ __forceinline__ v4u pack8(const float (&v)[8]) { v4u o; o.x = pg8::cvt_pk_bf16(v[0], v[1]); o.y = pg8::cvt_pk_bf16(v[2], v[3]); o.z = pg8::cvt_pk_bf16(v[4], v[5]); o.w = pg8::cvt_pk_bf16(v[6], v[7]); return o; }
struct Frame {
    LAS unsigned char* lds;
    int tid, lane, wave, G, bid;
    const float* in[31]; float* out; unsigned char* ws;
};

__device__ __forceinline__ void transpose_item(const float* W, int N, int k0, int n0, bf16* WT, size_t dst_row0, int dpitch, LAS float* scr, int lane) {
#pragma unroll 8
    for (int i = 0; i < 32; ++i) { const int kk = 2 * i + (lane >> 5); scr[kk * 33 + (lane & 31)] = W[(size_t)(k0 + kk) * N + n0 + (lane & 31)]; }
    LDS_WAIT(); asm volatile("" ::: "memory");
    const int c = lane & 7;
#pragma unroll
    for (int j = 0; j < 4; ++j) { const int n = (lane >> 3) + 8 * j; const LAS float* s = scr + (8 * c) * 33 + n;
        v4u o; o.x = pk2(s[0 * 33], s[1 * 33]); o.y = pk2(s[2 * 33], s[3 * 33]); o.z = pk2(s[4 * 33], s[5 * 33]); o.w = pk2(s[6 * 33], s[7 * 33]);
        *(GAS v4u*)(WT + (dst_row0 + n) * dpitch + k0 + 8 * c) = o; }
    LDS_WAIT(); asm volatile("" ::: "memory");
}

__device__ __forceinline__ void cvt_tile64(const float* W, int N, int k0, int n0, bf16* WT, size_t dst_row0, int dpitch, int lane) {
    const int c = lane & 15, kq = lane >> 4;
    const float* src = W + (size_t)(k0 + 16 * kq) * N + n0 + 4 * c;
    f32x4 x[16];
#pragma unroll
    for (int j = 0; j < 16; ++j) x[j] = __builtin_nontemporal_load((const GAS f32x4*)(src + (size_t)j * N));
#pragma unroll
    for (int e = 0; e < 4; ++e) { bf16* dst = WT + (dst_row0 + 4 * c + e) * dpitch + k0 + 16 * kq;
        v4u o0, o1;
        o0.x = pg8::cvt_pk_bf16(x[0][e], x[1][e]); o0.y = pg8::cvt_pk_bf16(x[2][e], x[3][e]); o0.z = pg8::cvt_pk_bf16(x[4][e], x[5][e]); o0.w = pg8::cvt_pk_bf16(x[6][e], x[7][e]);
        o1.x = pg8::cvt_pk_bf16(x[8][e], x[9][e]); o1.y = pg8::cvt_pk_bf16(x[10][e], x[11][e]); o1.z = pg8::cvt_pk_bf16(x[12][e], x[13][e]); o1.w = pg8::cvt_pk_bf16(x[14][e], x[15][e]);
        *(GAS v4u*)dst = o0; *(GAS v4u*)(dst + 8) = o1; }
}

__device__ __forceinline__ unsigned pk4_fp8(float a, float b, float c, float d) { int w = 0; w = __builtin_amdgcn_cvt_pk_fp8_f32(a, b, w, false); w = __builtin_amdgcn_cvt_pk_fp8_f32(c, d, w, true); return (unsigned)w; }
__device__ __forceinline__ float clamp448(float x) { return fminf(fmaxf(x, -448.f), 448.f); }
__device__ __forceinline__ void cvt_tile64_fp8(const float* W, int N, int k0, int n0, unsigned char* WT, size_t dst_row0, int dpitch, float scale, int lane) {
    const int c = lane & 15, kq = lane >> 4;
    const float* src = W + (size_t)(k0 + 16 * kq) * N + n0 + 4 * c;
    f32x4 x[16];
#pragma unroll
    for (int j = 0; j < 16; ++j) x[j] = __builtin_nontemporal_load((const GAS f32x4*)(src + (size_t)j * N)) * scale;
#pragma unroll
    for (int e = 0; e < 4; ++e) { unsigned char* dst = WT + (dst_row0 + 4 * c + e) * dpitch + k0 + 16 * kq;
        v4u o; o.x = pk4_fp8(x[0][e], x[1][e], x[2][e], x[3][e]); o.y = pk4_fp8(x[4][e], x[5][e], x[6][e], x[7][e]); o.z = pk4_fp8(x[8][e], x[9][e], x[10][e], x[11][e]); o.w = pk4_fp8(x[12][e], x[13][e], x[14][e], x[15][e]);
        *(GAS v4u*)dst = o; }
}

__device__ __forceinline__ void phase_prologue(Frame& F) {
    const float* c = F.in[1]; const float* cctx = F.in[3]; const float* w_mod = F.in[4]; const float* b_mod = F.in[5];
    float* MODV = (float*)(F.ws + WS_MOD);
    if (F.bid < 96) {
        LAS float* sil = (LAS float*)F.lds;
        LAS float* part = (LAS float*)(F.lds + 5 * 1024 * 4);
        for (int e = F.tid; e < 5 * 1024; e += NTHR) { const int r = e >> 10, k = e & 1023; const float v = (r < 4) ? c[r * 1024 + k] : cctx[k]; sil[e] = v * sigm(v); }
        __syncthreads();
        const int col = F.bid * 64 + F.lane;
        { const int kq = F.lane >> 4, c4 = (F.lane & 15) * 4; f32x4 a4[5];
#pragma unroll
          for (int r = 0; r < 5; ++r) a4[r] = (f32x4){0.f, 0.f, 0.f, 0.f};
#pragma unroll 8
          for (int it = 0; it < 32; ++it) { const int k = F.wave * 128 + it * 4 + kq; const f32x4 w = *(const GAS f32x4*)(w_mod + (size_t)k * 6144 + F.bid * 64 + c4);
#pragma unroll
              for (int r = 0; r < 5; ++r) a4[r] += w * sil[r * 1024 + k]; }
#pragma unroll
          for (int r = 0; r < 5; ++r) {
#pragma unroll
              for (int j = 0; j < 4; ++j) { float v = a4[r][j]; v += __shfl_xor(v, 16); v += __shfl_xor(v, 32); a4[r][j] = v; }
              if (kq == 0) *(LAS f32x4*)(part + (F.wave * 5 + r) * 64 + c4) = a4[r]; } }
        __syncthreads();
        if (F.wave < 5) { float s = b_mod[col];
#pragma unroll
            for (int w = 0; w < 8; ++w) s += part[(w * 5 + F.wave) * 64 + F.lane];
            MODV[F.wave * 6144 + col] = s; }
        __syncthreads();
    }
    const int gw = F.bid * NWAVES + F.wave, NGW = F.G * NWAVES;
    bf16* WinT = (bf16*)(F.ws + WS_WIN); bf16* WpaT = (bf16*)(F.ws + WS_WPA); bf16* WprT = (bf16*)(F.ws + WS_WPR); bf16* WoT = (bf16*)(F.ws + WS_WO);
    bf16* WupT = (bf16*)(F.ws + WS_LW); bf16* AupT = WupT + 2 * 512 * 64; bf16* GupT = AupT + 2 * 512 * 64;
    constexpr int I_IN = 16 * (PIN / 64), I_PA = 8 * 16, I_PR = 8 * 16, I_O = 16 * 16, I_LW = 16 + 16 + 16, I_ALL = I_IN + I_PA + I_PR + I_O + I_LW;
    for (int it = gw; it < I_ALL; it += NGW) {
        int r = it;
        if (r < I_IN) { const int nb = PIN / 64; cvt_tile64(F.in[6], PIN, 64 * (r / nb), 64 * (r % nb), WinT, (size_t)64 * (r % nb), 1024, F.lane); continue; } r -= I_IN;
        if (r < I_PA) { cvt_tile64(F.in[20], 1024, 64 * (r / 16), 64 * (r % 16), WpaT, (size_t)64 * (r % 16), 512, F.lane); continue; } r -= I_PA;
        if (r < I_PR) { cvt_tile64(F.in[21], 1024, 64 * (r / 16), 64 * (r % 16), WprT, (size_t)64 * (r % 16), 512, F.lane); continue; } r -= I_PR;
        if (r < I_O) { cvt_tile64(F.in[22], 1024, 64 * (r / 16), 64 * (r % 16), WoT, (size_t)64 * (r % 16), 1024, F.lane); continue; } r -= I_O;
        if (r < 16) { cvt_tile64(F.in[11] + (size_t)(r >> 3) * 64 * 512, 512, 0, 64 * (r & 7), WupT + (size_t)(r >> 3) * 512 * 64, (size_t)64 * (r & 7), 64, F.lane); continue; } r -= 16;
        if (r < 16) { cvt_tile64(F.in[13] + (size_t)(r >> 3) * 64 * 512, 512, 0, 64 * (r & 7), AupT + (size_t)(r >> 3) * 512 * 64, (size_t)64 * (r & 7), 64, F.lane); continue; } r -= 16;
        cvt_tile64(F.in[14], 512, 64 * (r >> 3), 64 * (r & 7), GupT, (size_t)64 * (r & 7), 128, F.lane);
    }
    { float* tab = (float*)(F.ws + WS_ROPE); const int i = F.bid * NTHR + F.tid;
      if (i < 128 * 16) { const float ang = (float)(i >> 4) * powf(10000.0f, -(float)(i & 15) / 16.0f); float sn, cs; sincosf(ang, &sn, &cs); tab[2 * i] = cs; tab[2 * i + 1] = sn; } }
    { GAS v4u* z = (GAS v4u*)(WinT + (size_t)PIN * 1024); const int n16 = (PINP - PIN) * 1024 * 2 / 16;
      for (int i = F.bid * NTHR + F.tid; i < n16; i += F.G * NTHR) z[i] = (v4u){0u, 0u, 0u, 0u}; }
}

__device__ __forceinline__ void phase_ln_mod(Frame& F) {
    const float* MODV = (const float*)(F.ws + WS_MOD);
    bf16* U = (bf16*)(F.ws + WS_U);
    const int gw = F.bid * NWAVES + F.wave, NGW = F.G * NWAVES;
    f32x4 nx[4];
    if (gw < MA) { const GAS f32x4* xr = (const GAS f32x4*)((gw < MT) ? F.in[0] + (size_t)gw * D : F.in[2] + (size_t)(gw - MT) * D) + F.lane;
#pragma unroll
        for (int j = 0; j < 4; ++j) nx[j] = xr[64 * j]; }
    for (int m = gw; m < MA; m += NGW) {
        const int mr = (m < MT) ? (m / T) : 4;
        const float* sh = MODV + mr * 6144; const float* sc = sh + 1024;
        f32x4 v[4]; float s = 0.f;
#pragma unroll
        for (int j = 0; j < 4; ++j) { v[j] = nx[j]; s += (v[j].x + v[j].y) + (v[j].z + v[j].w); }
        { const int mn = m + NGW; if (mn < MA) { const GAS f32x4* xr = (const GAS f32x4*)((mn < MT) ? F.in[0] + (size_t)mn * D : F.in[2] + (size_t)(mn - MT) * D) + F.lane;
#pragma unroll
            for (int j = 0; j < 4; ++j) nx[j] = xr[64 * j]; } }
        const float mean = wave_sum(s) * (1.f / D); float s2 = 0.f;
#pragma unroll
        for (int j = 0; j < 4; ++j) { v[j] = v[j] - mean; s2 += (v[j].x * v[j].x + v[j].y * v[j].y) + (v[j].z * v[j].z + v[j].w * v[j].w); }
        const float rstd = 1.f / sqrtf(wave_sum(s2) * (1.f / D) + LN_EPS);
        GAS unsigned long long* o8 = (GAS unsigned long long*)(U + (size_t)m * D) + F.lane;
#pragma unroll
        for (int j = 0; j < 4; ++j) { const f32x4 a = *((const f32x4*)sc + F.lane + 64 * j), b = *((const f32x4*)sh + F.lane + 64 * j);
            const f32x4 o = v[j] * rstd * (a + 1.0f) + b;
            o8[64 * j] = (unsigned long long)pk2(o.x, o.y) | ((unsigned long long)pk2(o.z, o.w) << 32); }
    }
}

__device__ __forceinline__ void phase_rope_vt(Frame& F) {
    bf16* Z = (bf16*)(F.ws + WS_Z);
    const int gw = F.bid * NWAVES + F.wave, NGW = F.G * NWAVES;
    {
        const int fh = F.lane & 1, a = (F.lane >> 1) & 1, h = (F.lane >> 2) & 7, w = F.lane >> 5;
        const float* tab = (const float*)(F.ws + WS_ROPE);
        for (int m = gw; m < MT; m += NGW) {
            const int t = m % T; const int pos = a ? (t % GW) : (t / GW);
            bf16* p1 = Z + (size_t)m * PINP + w * 512 + h * 64 + a * 32 + fh * 8;
            float x1[8], x2[8], o1[8], o2[8];
            unpack8(*(const GAS v4u*)p1, x1); unpack8(*(const GAS v4u*)(p1 + 16), x2);
            const f32x4* tp = (const f32x4*)(tab + (size_t)(pos * 16 + fh * 8) * 2);
#pragma unroll
            for (int j2 = 0; j2 < 4; ++j2) { const f32x4 cs2 = tp[j2];
                o1[2 * j2] = x1[2 * j2] * cs2.x - x2[2 * j2] * cs2.y; o2[2 * j2] = x2[2 * j2] * cs2.x + x1[2 * j2] * cs2.y;
                o1[2 * j2 + 1] = x1[2 * j2 + 1] * cs2.z - x2[2 * j2 + 1] * cs2.w; o2[2 * j2 + 1] = x2[2 * j2 + 1] * cs2.z + x1[2 * j2 + 1] * cs2.w; }
            *(GAS v4u*)p1 = pack8(o1); *(GAS v4u*)(p1 + 16) = pack8(o2);
        }
    }
    {
        bf16* VT = (bf16*)(F.ws + WS_VT); bf16* VTC = VT + VT_LAT_ELEMS;
        LAS bf16* scr = (LAS bf16*)(F.lds + F.wave * 16384);
        constexpr int NI_LAT = (MT / 64) * 8, NI = NI_LAT + (MC / 64) * 8;
        for (int it = gw; it < NI; it += NGW) {
            const bool lat = it < NI_LAT; const int r = lat ? it : it - NI_LAT;
            const int h = r & 7, tb = r >> 3;
            const int row0 = (lat ? 0 : MT) + tb * 64;
            const int b = lat ? (tb * 64) / T : (tb * 64) / LC, t0 = lat ? (tb * 64) % T : (tb * 64) % LC;
#pragma unroll 8
            for (int i = 0; i < 32; ++i) { const int tok = 2 * i + (F.lane >> 5); const unsigned w = *(const GAS unsigned*)(Z + (size_t)(row0 + tok) * PINP + ZV + h * 64 + 2 * (F.lane & 31));
                scr[tok * 66 + 2 * (F.lane & 31)] = (bf16)(w & 0xffff); scr[tok * 66 + 2 * (F.lane & 31) + 1] = (bf16)(w >> 16); }
            LDS_WAIT(); asm volatile("" ::: "memory");
            if (lat) {
                bf16* dst = VT + ((size_t)(b * 8 + h) * (T / 4) + (t0 >> 2)) * 256;
#pragma unroll
                for (int j = 0; j < 8; ++j) { const int g = 2 * j + (F.lane >> 5), dh = 2 * (F.lane & 31); const LAS bf16* s0 = scr + (4 * g) * 66 + dh;
                    v4u o; o.x = (unsigned)s0[0] | ((unsigned)s0[66] << 16); o.y = (unsigned)s0[2 * 66] | ((unsigned)s0[3 * 66] << 16);
                    o.z = (unsigned)s0[1] | ((unsigned)s0[66 + 1] << 16); o.w = (unsigned)s0[2 * 66 + 1] | ((unsigned)s0[3 * 66 + 1] << 16);
                    *(GAS v4u*)(dst + (size_t)(j * 64 + F.lane) * 8) = o; }
            } else {
                bf16* dst = VTC + ((size_t)(b * 8 + h) * 64) * LC + t0;
                const int c = F.lane & 7;
#pragma unroll
                for (int j = 0; j < 8; ++j) { const int dh = (F.lane >> 3) + 8 * j; const LAS bf16* s = scr + (8 * c) * 66 + dh;
                    v4u o; o.x = (unsigned)s[0] | ((unsigned)s[66] << 16); o.y = (unsigned)s[2 * 66] | ((unsigned)s[3 * 66] << 16); o.z = (unsigned)s[4 * 66] | ((unsigned)s[5 * 66] << 16); o.w = (unsigned)s[6 * 66] | ((unsigned)s[7 * 66] << 16);
                    *(GAS v4u*)(dst + (size_t)dh * LC + 8 * c) = o; }
            }
            LDS_WAIT(); asm volatile("" ::: "memory");
        }
    }
}

constexpr int NA_KP = 72, NA_VP = 264;
__device__ __forceinline__ void na_wave_task(Frame& F, int task, LAS float* rpbs, const LAS bf16* ck, const LAS bf16* cvt, int ocol = ZQ) {
    bf16* Z = (bf16*)(F.ws + WS_Z);
    const bf16* VT = (const bf16*)(F.ws + WS_VT);
    const int jq = task & 3, h = (task >> 2) & 7, i = (task >> 5) & 127, b = task >> 12;
    const int rs = min(max(i - 4, 0), GH - 8);
    const int cb = (jq == 0) ? 0 : (jq == 1) ? 8 : (jq == 2) ? 24 : 32;
    const int qi = F.lane & 15, qd = F.lane >> 4;
    const int j = jq * 16 + qi, cs = min(max(j - 8, 0), GW - 16);
    const size_t qrow = (size_t)b * T + i * GW + j;
    const bf16x8 q0 = *(const GAS bf16x8*)(Z + qrow * PINP + ZQ + h * 64 + qd * 8);
    const bf16x8 q1 = *(const GAS bf16x8*)(Z + qrow * PINP + ZQ + h * 64 + 32 + qd * 8);
    f32x4 s[32];
    int bidx[2][4];
#pragma unroll
    for (int half = 0; half < 2; ++half)
#pragma unroll
        for (int jj = 0; jj < 4; ++jj) { const int c = cb + half * 16 + qd * 4 + jj; const bool ok = (c >= cs) && (c < cs + 16); bidx[half][jj] = ok ? h * 465 + (rs - i + 7) * 31 + (c - j + 15) : 8 * 465; }
    LAS bf16* kb = (LAS bf16*)(F.lds + 87040 + F.wave * 4608);
    v4u kraw[4];
#pragma unroll
    for (int ii = 0; ii < 4; ++ii) kraw[ii] = *(const GAS v4u*)(Z + ((size_t)b * T + rs * GW + cb + 8 * ii + (F.lane >> 3)) * PINP + ZK + h * 64 + (F.lane & 7) * 8);
#pragma unroll
    for (int r = 0; r < 8; ++r) {
#pragma unroll
        for (int ii = 0; ii < 4; ++ii) *(LAS v4u*)(kb + (8 * ii + (F.lane >> 3)) * NA_KP + (F.lane & 7) * 8) = kraw[ii];
        if (r < 7) {
#pragma unroll
            for (int ii = 0; ii < 4; ++ii) kraw[ii] = *(const GAS v4u*)(Z + ((size_t)b * T + (rs + r + 1) * GW + cb + 8 * ii + (F.lane >> 3)) * PINP + ZK + h * 64 + (F.lane & 7) * 8); }
#pragma unroll
        for (int half = 0; half < 2; ++half) {
            const bf16x8 k0 = *(const LAS bf16x8*)(kb + (half * 16 + qi) * NA_KP + qd * 8), k1 = *(const LAS bf16x8*)(kb + (half * 16 + qi) * NA_KP + 32 + qd * 8);
            f32x4 a = (f32x4){0.f, 0.f, 0.f, 0.f};
            a = __builtin_amdgcn_mfma_f32_16x16x32_bf16(k0, q0, a, 0, 0, 0);
            a = __builtin_amdgcn_mfma_f32_16x16x32_bf16(k1, q1, a, 0, 0, 0);
#pragma unroll
            for (int jj = 0; jj < 4; ++jj) a[jj] += rpbs[bidx[half][jj] + r * 31];
            s[2 * r + half] = a; }
        __builtin_amdgcn_sched_barrier(0);
    }
#pragma unroll
    for (int tc = 0; tc < 16; ++tc) {
        const bf16x8 k0 = *(const LAS bf16x8*)(ck + (tc * 16 + qi) * NA_KP + qd * 8);
        const bf16x8 k1 = *(const LAS bf16x8*)(ck + (tc * 16 + qi) * NA_KP + 32 + qd * 8);
        f32x4 a = (f32x4){0.f, 0.f, 0.f, 0.f};
        a = __builtin_amdgcn_mfma_f32_16x16x32_bf16(k0, q0, a, 0, 0, 0);
        a = __builtin_amdgcn_mfma_f32_16x16x32_bf16(k1, q1, a, 0, 0, 0);
        s[16 + tc] = a;
        if ((tc & 1) == 1) __builtin_amdgcn_sched_barrier(0);
    }
    float mx = -1e30f;
#pragma unroll
    for (int tl = 0; tl < 32; ++tl) mx = fmaxf(fmaxf(fmaxf(s[tl][0], s[tl][1]), fmaxf(s[tl][2], s[tl][3])), mx);
    mx = fmaxf(mx, __shfl_xor(mx, 16)); mx = fmaxf(mx, __shfl_xor(mx, 32));
    float sum = 0.f; const float esc = 0.125f * 1.44269504f, mxs = mx * esc;
#pragma unroll
    for (int tl = 0; tl < 32; ++tl) {
#pragma unroll
        for (int jj = 0; jj < 4; ++jj) { const float e = __builtin_amdgcn_exp2f(__builtin_fmaf(s[tl][jj], esc, -mxs)); s[tl][jj] = e; sum += e; } }
    sum += __shfl_xor(sum, 16); sum += __shfl_xor(sum, 32);
    const float inv = 1.0f / sum;
    f32x4 o[4];
#pragma unroll
    for (int dt = 0; dt < 4; ++dt) o[dt] = (f32x4){0.f, 0.f, 0.f, 0.f};
#pragma unroll
    for (int ks = 0; ks < 16; ++ks) {
        const f32x4 p0 = s[2 * ks], p1 = s[2 * ks + 1];
        v4u pw; pw.x = pk2(p0[0], p0[1]); pw.y = pk2(p0[2], p0[3]); pw.z = pk2(p1[0], p1[1]); pw.w = pk2(p1[2], p1[3]);
        const bf16x8 pa = __builtin_bit_cast(bf16x8, pw);
        if (ks < 8) { const bf16* vb = VT + ((size_t)(b * 8 + h) * (T / 4) + (((rs + ks) * GW + cb) >> 2) + qd) * 256;
#pragma unroll
            for (int dt = 0; dt < 4; ++dt) {
                const bf16* vp = vb + (dt * 16 + qi) * 4;
                const v2u lo = *(const GAS v2u*)vp, hi = *(const GAS v2u*)(vp + 4 * 256);
                v4u vw; vw.x = lo.x; vw.y = lo.y; vw.z = hi.x; vw.w = hi.y;
                o[dt] = __builtin_amdgcn_mfma_f32_16x16x32_bf16(pa, __builtin_bit_cast(bf16x8, vw), o[dt], 0, 0, 0); } }
        else { const LAS bf16* vb = cvt + (ks - 8) * 32 + qd * 4;
#pragma unroll
            for (int dt = 0; dt < 4; ++dt) {
                const LAS bf16* vp = vb + (dt * 16 + qi) * NA_VP;
                const v2u lo = *(const LAS v2u*)vp, hi = *(const LAS v2u*)(vp + 16);
                v4u vw; vw.x = lo.x; vw.y = lo.y; vw.z = hi.x; vw.w = hi.y;
                o[dt] = __builtin_amdgcn_mfma_f32_16x16x32_bf16(pa, __builtin_bit_cast(bf16x8, vw), o[dt], 0, 0, 0); } }
        __builtin_amdgcn_sched_barrier(0);
    }
    float invq[4];
#pragma unroll
    for (int jj = 0; jj < 4; ++jj) invq[jj] = __shfl(inv, qd * 4 + jj);
#pragma unroll
    for (int dt = 0; dt < 4; ++dt)
#pragma unroll
        for (int jj = 0; jj < 4; ++jj) Z[((size_t)b * T + i * GW + jq * 16 + qd * 4 + jj) * PINP + ocol + h * 64 + dt * 16 + qi] = (bf16)f2bf(o[dt][jj] * invq[jj]);
}

constexpr int CP = 72;
constexpr int CBUF = 9216;
__device__ __forceinline__ int swz(int row, int col) { return row * 64 + (((((col >> 3) ^ (row >> 1) ^ ((row & 1) << 2)) & 7) << 3) | (col & 7)); }
constexpr int NCHK = (LC + T) / 64;
constexpr size_t PQ_UNIT = 16384, RY_UNIT = 16384;
constexpr int LDS_TOT = 15 * CBUF, LDS_CLE = LDS_TOT + 2048, LDS_MU = LDS_CLE + 256 + 2048;
#define CB(i) ((LAS bf16*)(F.lds + (i) * CBUF))
__device__ __forceinline__ bf16x8 ldsfrag(const LAS bf16* base, int row, int col) { return *(const LAS bf16x8*)(base + swz(row, col)); }
template <int MODE = 0> __device__ __forceinline__ void mm2(const LAS bf16* X, const LAS bf16* Y, int mt0, int nt, int r, int q, f32x4 (&acc)[2]) {
    if (MODE == 1) return;
    const bf16x8 y0 = ldsfrag(Y, 16 * nt + r, 8 * q), y1 = ldsfrag(Y, 16 * nt + r, 32 + 8 * q);
#pragma unroll
    for (int t = 0; t < 2; ++t) { const bf16x8 x0 = ldsfrag(X, 16 * (mt0 + t) + r, 8 * q), x1 = ldsfrag(X, 16 * (mt0 + t) + r, 32 + 8 * q);
        acc[t] = __builtin_amdgcn_mfma_f32_16x16x32_bf16(x0, y0, acc[t], 0, 0, 0); acc[t] = __builtin_amdgcn_mfma_f32_16x16x32_bf16(x1, y1, acc[t], 0, 0, 0); }
}
struct FragX { bf16x8 a[2][2]; };
struct FragY { bf16x8 b[2]; };
template <int MODE = 0> __device__ __forceinline__ FragX ldX(const LAS bf16* X, int mt0, int r, int q) { FragX f;
#pragma unroll
    for (int t = 0; t < 2; ++t) { if (MODE == 1) { f.a[t][0] = f.a[t][1] = (bf16x8){0, 0, 0, 0, 0, 0, 0, 0}; } else { f.a[t][0] = ldsfrag(X, 16 * (mt0 + t) + r, 8 * q); f.a[t][1] = ldsfrag(X, 16 * (mt0 + t) + r, 32 + 8 * q); } }
    return f; }
template <int MODE = 0> __device__ __forceinline__ FragY ldY(const LAS bf16* Y, int nt, int r, int q) { FragY f;
    if (MODE == 1) { f.b[0] = f.b[1] = (bf16x8){0, 0, 0, 0, 0, 0, 0, 0}; } else { f.b[0] = ldsfrag(Y, 16 * nt + r, 8 * q); f.b[1] = ldsfrag(Y, 16 * nt + r, 32 + 8 * q); }
    return f; }
template <int MODE = 0> __device__ __forceinline__ void mmf(const FragX& x, const FragY& y, f32x4 (&acc)[2]) {
    if (MODE == 1) return;
#pragma unroll
    for (int k = 0; k < 2; ++k)
#pragma unroll
        for (int t = 0; t < 2; ++t) acc[t] = __builtin_amdgcn_mfma_f32_16x16x32_bf16(x.a[t][k], y.b[k], acc[t], 0, 0, 0);
}
__device__ __forceinline__ v2u pack4(f32x4 v) { v2u o; o.x = pg8::cvt_pk_bf16(v[0], v[1]); o.y = pg8::cvt_pk_bf16(v[2], v[3]); return o; }
__device__ __forceinline__ f32x4 unpack4(v2u w) { return (f32x4){bflo(w.x), bfhi(w.x), bflo(w.y), bfhi(w.y)}; }
__device__ __forceinline__ void stT(LAS bf16* O, int mt, int nt, int r, int q, f32x4 v) { *(LAS v2u*)(O + swz(16 * nt + r, 16 * mt + 4 * q)) = pack4(v); }
__device__ __forceinline__ void stR(LAS bf16* O, int mt, int nt, int r, int q, f32x4 v) {
#pragma unroll
    for (int jj = 0; jj < 4; ++jj) O[swz(16 * mt + 4 * q + jj, 16 * nt + r)] = (bf16)f2bf(v[jj]); }
__device__ __forceinline__ f32x4 ldT(const LAS bf16* O, int mt, int nt, int r, int q) { return unpack4(*(const LAS v2u*)(O + swz(16 * nt + r, 16 * mt + 4 * q))); }
#define Z2 {(f32x4){0.f, 0.f, 0.f, 0.f}, (f32x4){0.f, 0.f, 0.f, 0.f}}
__device__ __forceinline__ float tanh_fast(float x) { return 1.0f - 2.0f * __builtin_amdgcn_rcpf(1.0f + __expf(2.0f * x)); }
__device__ __forceinline__ bf16 f2bf_hw(float x) { return (bf16)(pg8::cvt_pk_bf16(x, x) & 0xffffu); }
__device__ __forceinline__ void shift8(const bf16* zp, bool hasp, bool hasn, const float* mup, const float* mun, float (&o)[8]) {
    float z[8], a[8], b[8];
    unpack8(*(const GAS v4u*)zp, z);
    unpack8(hasp ? *(const GAS v4u*)(zp - PINP) : (v4u){0u, 0u, 0u, 0u}, a);
    unpack8(hasn ? *(const GAS v4u*)(zp + PINP) : (v4u){0u, 0u, 0u, 0u}, b);
    const f32x4 p0 = *(const f32x4*)mup, p1 = *(const f32x4*)(mup + 4), n0 = *(const f32x4*)mun, n1 = *(const f32x4*)(mun + 4);
#pragma unroll
    for (int e = 0; e < 8; ++e) { const float mp = e < 4 ? p0[e & 3] : p1[e & 3], mn = e < 4 ? n0[e & 3] : n1[e & 3]; o[e] = z[e] + mp * (a[e] - z[e]) + mn * (b[e] - z[e]); }
}
__device__ __forceinline__ void shift8u(const char* zu, unsigned zo, bool hasp, bool hasn, const char* mup, const char* mun, unsigned mo, float (&o)[8]) {
    float z[8], a[8], b[8];
    unpack8(*(const GAS v4u*)(zu + zo), z);
    unpack8(hasp ? *(const GAS v4u*)(zu - PINP * 2 + zo) : (v4u){0u, 0u, 0u, 0u}, a);
    unpack8(hasn ? *(const GAS v4u*)(zu + PINP * 2 + zo) : (v4u){0u, 0u, 0u, 0u}, b);
    const f32x4 p0 = *(const GAS f32x4*)(mup + mo), p1 = *(const GAS f32x4*)(mup + 16 + mo), n0 = *(const GAS f32x4*)(mun + mo), n1 = *(const GAS f32x4*)(mun + 16 + mo);
#pragma unroll
    for (int e = 0; e < 8; ++e) { const float mp = e < 4 ? p0[e & 3] : p1[e & 3], mn = e < 4 ? n0[e & 3] : n1[e & 3]; o[e] = z[e] + mp * (a[e] - z[e]) + mn * (b[e] - z[e]); }
}
__device__ __forceinline__ void shift8l(const char* zu, unsigned zo, bool hasp, bool hasn, const LAS float* mup, const LAS float* mun, float (&o)[8]) {
    float z[8], a[8], b[8];
    unpack8(*(const GAS v4u*)(zu + zo), z);
    unpack8(hasp ? *(const GAS v4u*)(zu - PINP * 2 + zo) : (v4u){0u, 0u, 0u, 0u}, a);
    unpack8(hasn ? *(const GAS v4u*)(zu + PINP * 2 + zo) : (v4u){0u, 0u, 0u, 0u}, b);
    const f32x4 p0 = *(const LAS f32x4*)mup, p1 = *(const LAS f32x4*)(mup + 4), n0 = *(const LAS f32x4*)mun, n1 = *(const LAS f32x4*)(mun + 4);
#pragma unroll
    for (int e = 0; e < 8; ++e) { const float mp = e < 4 ? p0[e & 3] : p1[e & 3], mn = e < 4 ? n0[e & 3] : n1[e & 3]; o[e] = z[e] + mp * (a[e] - z[e]) + mn * (b[e] - z[e]); }
}
struct Raw3 { v4u z, a, b; };
__device__ __forceinline__ void dma_tile(const char* gbase, unsigned zo, unsigned lds_tile, int wave, int lane) {
    const unsigned m0a = lds_tile + (unsigned)wave * 1024u;
    asm volatile("s_mov_b32 m0, %0\n\ts_nop 0\n\tglobal_load_lds_dwordx4 %1, %2" :: "s"(m0a), "v"(zo), "s"(gbase) : "memory", "m0");
    if (wave == 0) { if (lane < 16) { const char* g2 = gbase + (size_t)64 * PINP * 2; const unsigned m0b = lds_tile + 8192u;
        asm volatile("s_mov_b32 m0, %0\n\ts_nop 0\n\tglobal_load_lds_dwordx4 %1, %2" :: "s"(m0b), "v"(zo), "s"(g2) : "memory", "m0"); } }
}
__device__ __forceinline__ Raw3 rd3(const LAS unsigned char* tile, int t1, int k8) { Raw3 w; const LAS unsigned char* p = tile + t1 * 128 + k8 * 2;
    w.a = *(const LAS v4u*)p; w.z = *(const LAS v4u*)(p + 128); w.b = *(const LAS v4u*)(p + 256); return w; }
__device__ __forceinline__ Raw3 ld3(const char* zu, unsigned zo) { Raw3 w; w.z = *(const GAS v4u*)(zu + zo); w.a = *(const GAS v4u*)(zu - PINP * 2 + zo); w.b = *(const GAS v4u*)(zu + PINP * 2 + zo); return w; }
__device__ __forceinline__ void mix8(const Raw3& w, bool hasp, bool hasn, const LAS float* mup, const LAS float* mun, float (&o)[8]) {
    float z[8], a[8], b[8];
    unpack8(w.z, z); unpack8(hasp ? w.a : (v4u){0u, 0u, 0u, 0u}, a); unpack8(hasn ? w.b : (v4u){0u, 0u, 0u, 0u}, b);
    const f32x4 p0 = *(const LAS f32x4*)mup, p1 = *(const LAS f32x4*)(mup + 4), n0 = *(const LAS f32x4*)mun, n1 = *(const LAS f32x4*)(mun + 4);
#pragma unroll
    for (int e = 0; e < 8; ++e) { const float mp = e < 4 ? p0[e & 3] : p1[e & 3], mn = e < 4 ? n0[e & 3] : n1[e & 3]; o[e] = z[e] + mp * (a[e] - z[e]) + mn * (b[e] - z[e]); }
}
#define VMW(n) asm volatile("s_waitcnt vmcnt(" #n ")" ::: "memory")
__device__ __forceinline__ float sum8(float v) { v += dppf<0xB1>(v); v += dppf<0x4E>(v); v += dppf<0x141>(v); return v; }

__device__ __forceinline__ int afrag_off(int row, int col) { return ((((row >> 4) * 2 + (col >> 5)) * 64 + ((col >> 2) & 3) * 16 + (row & 15)) << 3) + ((col >> 4) & 1) * 4 + (col & 3); }
__device__ __forceinline__ int cfrag_off(int n, int m) { return ((((n >> 4) * 4 + (m >> 4)) * 64 + ((m >> 2) & 3) * 16 + (n & 15)) << 2) + (m & 3); }
template <int MODE> __device__ __forceinline__ void rwkvA_unit(Frame& F, int u, int& hl, int pre, int un) {
    int lane_ = F.lane, tid_ = F.tid; asm volatile("" : "+v"(lane_), "+v"(tid_));
    const bf16* Z = (const bf16*)(F.ws + WS_Z);
    const bf16* WupT = (const bf16*)(F.ws + WS_LW); const bf16* AupT = WupT + 2 * 512 * 64; const bf16* GupT = AupT + 2 * 512 * 64;
    const int h = u & 7, bt = u >> 3, b = bt / NCHK, blk = bt % NCHK; const bool isctx = blk < 4;
    const int seqlen = isctx ? LC : T, s0 = (isctx ? blk : blk - 4) * 64;
    const size_t row0 = (isctx ? (size_t)MT + b * LC : (size_t)b * T) + s0;
    const int ti = lane_, c8 = F.wave * 8;
    const int r = lane_ & 15, q = lane_ >> 4, nt = F.wave & 3, mt0 = 2 * (F.wave >> 2);
    const int sp = s0 + ti; const bool hasp = sp > 0, hasn = sp < seqlen - 1;
    const bf16* zrow = Z + (row0 + ti) * PINP;
    const int t1 = tid_ >> 3, k8 = (tid_ & 7) * 8; const int sp1 = s0 + t1; const bool hasp1 = sp1 > 0, hasn1 = sp1 < seqlen - 1;
    const char* Zu = (const char*)(Z + row0 * PINP); const unsigned zo = (unsigned)((t1 * PINP + k8) * 2), mo = (unsigned)(k8 * 4);
    LAS float* RSs = (LAS float*)(F.lds + 4 * CBUF); LAS float* KSs = RSs + 64 * 68; LAS bf16* VSs = (LAS bf16*)(F.lds + 4 * CBUF + 2 * 64 * 68 * 4);
    LAS float* ssp = (LAS float*)(F.lds + LDS_CLE + 256);
    const LAS float* mpL = (const LAS float*)(F.lds + LDS_MU); const LAS float* mnL = mpL + 384;
    LAS float* mpR = (LAS float*)(F.lds + 0 * CBUF + 8192); LAS float* mnR = (LAS float*)(F.lds + 1 * CBUF + 8192);
    if (h != hl) { hl = h; if (tid_ < 192) { const int gi = (tid_ >> 6) * 512 + h * 64 + (tid_ & 63); mpR[tid_] = F.in[8][gi]; mnR[tid_] = F.in[9][gi]; } __syncthreads(); }
    const unsigned ldsb = (unsigned)(size_t)F.lds;
    const char* Zm = Zu - PINP * 2;
    if (pre < 0) { dma_tile(Zm + (ZR + h * 64) * 2, zo, ldsb + 10 * CBUF, F.wave, lane_); dma_tile(Zm + (ZRK + h * 64) * 2, zo, ldsb + 11 * CBUF, F.wave, lane_); dma_tile(Zm + (ZRV + h * 64) * 2, zo, ldsb + 14 * CBUF, F.wave, lane_); VMW(0); }
    else if (pre == 4) VMW(4); else VMW(8);
    __syncthreads();
    dma_tile(Zm + ZLORA * 2, zo, ldsb + 9 * CBUF, F.wave, lane_); dma_tile(Zm + (ZLORA + 128) * 2, zo, ldsb + 12 * CBUF, F.wave, lane_); dma_tile(Zm + (ZLORA + 256) * 2, zo, ldsb + 13 * CBUF, F.wave, lane_);
    { float x[8], y[8];
      mix8(rd3(F.lds + 10 * CBUF, t1, k8), hasp1, hasn1, mpR + k8, mnR + k8, x);
      *(LAS f32x4*)(RSs + t1 * 68 + k8) = (f32x4){x[0], x[1], x[2], x[3]}; *(LAS f32x4*)(RSs + t1 * 68 + k8 + 4) = (f32x4){x[4], x[5], x[6], x[7]};
      mix8(rd3(F.lds + 11 * CBUF, t1, k8), hasp1, hasn1, mpR + 64 + k8, mnR + 64 + k8, y);
      *(LAS f32x4*)(KSs + t1 * 68 + k8) = (f32x4){y[0], y[1], y[2], y[3]}; *(LAS f32x4*)(KSs + t1 * 68 + k8 + 4) = (f32x4){y[4], y[5], y[6], y[7]};
      float ss = 0.f;
#pragma unroll
      for (int e = 0; e < 8; ++e) { const float kv = y[e] * F.in[15][h * 64 + k8 + e]; ss += kv * kv; }
      ss = sum8(ss); if ((tid_ & 7) == 0) ssp[t1] = 1.0f / sqrtf(ss + 1e-12f);
      mix8(rd3(F.lds + 14 * CBUF, t1, k8), hasp1, hasn1, mpR + 128 + k8, mnR + 128 + k8, x);
      *(LAS v4u*)(VSs + t1 * CP + k8) = pack8(x); }
    VMW(0); __syncthreads();
    float rs[8], ks[8], rn = 0.f; v4u vsp = {0u, 0u, 0u, 0u};
    LAS float* lwT = (LAS float*)(F.lds + 10 * CBUF);
    LAS float* aT = (LAS float*)(F.lds + 10 * CBUF + 64 * 68 * 4);
    LAS float* tot = (LAS float*)(F.lds + LDS_TOT); LAS float* cle = (LAS float*)(F.lds + LDS_CLE);
#pragma unroll 1
    for (int d = 0; d < 2; ++d) {
        const int ip = d ? 63 - ti : ti;
        const int chunk_p = isctx ? (d ? 3 - blk : blk) : (d ? 4 + (131 - blk) : blk);
        const bf16* wy = WupT + ((size_t)(d * 512 + h * 64 + 16 * nt + r)) * 64 + 8 * q; const bf16* ay = AupT + ((size_t)(d * 512 + h * 64 + 16 * nt + r)) * 64 + 8 * q;
        const bf16x8 wy0 = *(const GAS bf16x8*)wy, wy1 = *(const GAS bf16x8*)(wy + 32), ay0 = *(const GAS bf16x8*)ay, ay1 = *(const GAS bf16x8*)(ay + 32);
        const float w0v = F.in[10][d * 512 + h * 64 + 16 * nt + r], a0v = F.in[12][d * 512 + h * 64 + 16 * nt + r];
        { float x[8]; const int ip1 = d ? 63 - t1 : t1;
          Raw3 gB; if (d == 0) gB = ld3(Zu + (ZLORA + 256 + 64) * 2, zo);
          mix8(rd3(F.lds + (d ? 10 : 9) * CBUF, t1, k8), hasp1, hasn1, mpL + d * 64 + k8, mnL + d * 64 + k8, x);
#pragma unroll
          for (int e = 0; e < 8; ++e) x[e] = tanh_fast(x[e]);
          *(LAS v4u*)(CB(0) + swz(ip1, k8)) = pack8(x);
          mix8(rd3(F.lds + (d ? 11 : 12) * CBUF, t1, k8), hasp1, hasn1, mpL + 128 + d * 64 + k8, mnL + 128 + d * 64 + k8, x);
          *(LAS v4u*)(CB(1) + swz(ip1, k8)) = pack8(x);
          if (d == 0) {
              mix8(rd3(F.lds + 13 * CBUF, t1, k8), hasp1, hasn1, mpL + 256 + k8, mnL + 256 + k8, x);
#pragma unroll
              for (int e = 0; e < 8; ++e) x[e] = sigm(x[e]);
              *(LAS v4u*)(CB(2) + t1 * 144 + k8) = pack8(x);
              mix8(gB, hasp1, hasn1, mpL + 256 + 64 + k8, mnL + 256 + 64 + k8, x);
#pragma unroll
              for (int e = 0; e < 8; ++e) x[e] = sigm(x[e]);
              *(LAS v4u*)(CB(2) + t1 * 144 + 64 + k8) = pack8(x); } }
        __syncthreads();
        if (MODE == 5) { __syncthreads(); continue; }
        { f32x4 aw[2] = Z2, aa[2] = Z2;
          { const FragX xw = ldX<0>(CB(0), mt0, r, q), xa = ldX<0>(CB(1), mt0, r, q); FragY yw, ya; yw.b[0] = wy0; yw.b[1] = wy1; ya.b[0] = ay0; ya.b[1] = ay1;
            __builtin_amdgcn_sched_barrier(0);
            mmf<0>(xw, yw, aw); mmf<0>(xa, ya, aa); }
          const int c = 16 * nt + r;
#pragma unroll
          for (int t = 0; t < 2; ++t) { f32x4 lw, av;
#pragma unroll
              for (int jj = 0; jj < 4; ++jj) { lw[jj] = -0.60653066f * sigm(aw[t][jj] + w0v); av[jj] = sigm(aa[t][jj] + a0v); }
              *(LAS f32x4*)(lwT + c * 68 + 16 * (mt0 + t) + 4 * q) = lw; *(LAS f32x4*)(aT + c * 68 + 16 * (mt0 + t) + 4 * q) = av; }
          if (d == 0) { bf16x8 gyv[4]; { const bf16* gy = GupT + ((size_t)(h * 64 + 16 * nt + r)) * 128 + 8 * q;
#pragma unroll
              for (int k4 = 0; k4 < 4; ++k4) gyv[k4] = *(const GAS bf16x8*)(gy + 32 * k4); }
              f32x4 ag[2] = Z2;
#pragma unroll
              for (int kp = 0; kp < 2; ++kp) { bf16x8 xg[2][2];
#pragma unroll
                  for (int t = 0; t < 2; ++t)
#pragma unroll
                      for (int k2 = 0; k2 < 2; ++k2) xg[t][k2] = *(const LAS bf16x8*)(CB(2) + (16 * (mt0 + t) + r) * 144 + 32 * (2 * kp + k2) + 8 * q);
                  __builtin_amdgcn_sched_barrier(0);
#pragma unroll
                  for (int k2 = 0; k2 < 2; ++k2)
#pragma unroll
                      for (int t = 0; t < 2; ++t) ag[t] = __builtin_amdgcn_mfma_f32_16x16x32_bf16(gyv[2 * kp + k2], xg[t][k2], ag[t], 0, 0, 0); }
              if (!isctx) { bf16* G = (bf16*)(F.ws + WS_G);
#pragma unroll
                  for (int t = 0; t < 2; ++t) *(GAS v2u*)(G + (row0 + 16 * (mt0 + t) + r) * 512 + h * 64 + 16 * nt + 4 * q) = pack4(ag[t]); } } }
        __syncthreads();
        if (MODE == 4) { __syncthreads(); continue; }
        { const int c = tid_ & 63, g = tid_ >> 6; LAS float* p = lwT + c * 68 + 8 * g;
          f32x4 v0 = *(LAS f32x4*)p, v1 = *(LAS f32x4*)(p + 4);
          v0[1] += v0[0]; v0[2] += v0[1]; v0[3] += v0[2]; v1[0] += v0[3]; v1[1] += v1[0]; v1[2] += v1[1]; v1[3] += v1[2];
          tot[g * 64 + c] = v1[3];
          __syncthreads();
          float base = 0.f;
#pragma unroll
          for (int g2 = 0; g2 < 7; ++g2) base += (g2 < g) ? tot[g2 * 64 + c] : 0.f;
          v0 += base; v1 += base; *(LAS f32x4*)p = v0; *(LAS f32x4*)(p + 4) = v1;
          if (g == 7) cle[c] = v1[3]; }
        __syncthreads();
        { float at[8], btv[8], kt[8], rt[8]; float cf = 0.f;
          if (d == 0) { const f32x4 r0 = *(const LAS f32x4*)(RSs + ti * 68 + c8), r1 = *(const LAS f32x4*)(RSs + ti * 68 + c8 + 4), k0 = *(const LAS f32x4*)(KSs + ti * 68 + c8), k1 = *(const LAS f32x4*)(KSs + ti * 68 + c8 + 4);
              vsp = *(const LAS v4u*)(VSs + ti * CP + c8); rn = ssp[ti];
#pragma unroll
              for (int e = 0; e < 8; ++e) { rs[e] = e < 4 ? r0[e & 3] : r1[e & 3]; ks[e] = e < 4 ? k0[e & 3] : k1[e & 3]; }
              __syncthreads(); }
          float vs[8]; unpack8(vsp, vs);
#pragma unroll
          for (int e = 0; e < 8; ++e) { const int c = c8 + e; const float cl = lwT[c * 68 + ip], clp = ip > 0 ? lwT[c * 68 + ip - 1] : 0.f, a = aT[c * 68 + ip], ce = cle[c];
              const float G = __expf(cl), iG = __expf(-cl), Gex = __expf(clp), GeG = __expf(ce - cl);
              const float kke = ks[e] * F.in[15][h * 64 + c] * rn;
              const float km = ks[e] * (1.0f + (a - 1.0f) * F.in[16][h * 64 + c]), kb = kke * a;
              at[e] = -kke * Gex; btv[e] = kb * iG; kt[e] = km * iG; rt[e] = rs[e] * G;
              { const int so = swz(c, ip); CB(4)[so] = f2bf_hw(at[e]); CB(5)[so] = f2bf_hw(kb * GeG); CB(6)[so] = f2bf_hw(km * GeG); CB(7)[so] = f2bf_hw(vs[e]); }
              cf += rs[e] * km * F.in[17][h * 64 + c]; }
          { const int so = swz(ip, c8); *(LAS v4u*)(CB(0) + so) = pack8(at); *(LAS v4u*)(CB(1) + so) = pack8(btv); *(LAS v4u*)(CB(2) + so) = pack8(kt); *(LAS v4u*)(CB(3) + so) = pack8(rt); }
          ssp[F.wave * 64 + ti] = cf; }
        __syncthreads();
        if (!isctx && F.wave == 0) { float cf = 0.f;
#pragma unroll
            for (int w = 0; w < 8; ++w) cf += ssp[w * 64 + ti];
            ((float*)(F.ws + WS_COEF))[(row0 + ti) * 16 + h * 2 + d] = cf; }
        if (MODE == 3) { __syncthreads(); continue; }
        { f32x4 pN[2] = Z2, pLak[2] = Z2, pMrb[2] = Z2, pMrk[2] = Z2;
          { const FragX x1 = ldX<MODE>(CB(1), mt0, r, q), x2 = ldX<MODE>(CB(2), mt0, r, q); const FragY y0 = ldY<MODE>(CB(0), nt, r, q), y3 = ldY<MODE>(CB(3), nt, r, q);
            __builtin_amdgcn_sched_barrier(0);
            mmf<MODE>(x1, y0, pN); mmf<MODE>(x2, y0, pLak); mmf<MODE>(x1, y3, pMrb); mmf<MODE>(x2, y3, pMrk); }
          __builtin_amdgcn_sched_barrier(0);
          const int n = 16 * nt + r;
#pragma unroll
          for (int t = 0; t < 2; ++t) { f32x4 t0;
#pragma unroll
              for (int jj = 0; jj < 4; ++jj) { const int m = 16 * (mt0 + t) + 4 * q + jj;
                  pN[t][jj] = (m < n) ? pN[t][jj] : 0.f; t0[jj] = pN[t][jj] + ((m == n) ? 1.0f : 0.f);
                  pLak[t][jj] = (m < n) ? pLak[t][jj] : 0.f; pMrb[t][jj] = (m <= n) ? pMrb[t][jj] : 0.f; pMrk[t][jj] = (m <= n) ? pMrk[t][jj] : 0.f; }
              stT(CB(8), mt0 + t, nt, r, q, pN[t]); stT(CB(10), mt0 + t, nt, r, q, t0); stR(CB(9), mt0 + t, nt, r, q, pN[t]);
              stT(CB(11), mt0 + t, nt, r, q, pLak[t]); stT(CB(12), mt0 + t, nt, r, q, pMrb[t]); stT(CB(13), mt0 + t, nt, r, q, pMrk[t]); } }
        __syncthreads();
#define SQ_ST(a1, ONT_, ON_) do { _Pragma("unroll") for (int t = 0; t < 2; ++t) { stT(CB(ONT_), mt0 + t, nt, r, q, a1[t]); if ((ON_) >= 0) stR(CB((ON_) < 0 ? 0 : (ON_)), mt0 + t, nt, r, q, a1[t]); } } while (0)
#define TSQ_STAGE(NTB_, TOLD_, TNEW_, NB_, NTB2_, ONT_, ON_) do { f32x4 a3[2], a1[2] = Z2; \
            const FragX xt = ldX<MODE>(CB(NTB_), mt0, r, q); const FragY yt = ldY<MODE>(CB(TOLD_), nt, r, q); a3[0] = ldT(CB(TOLD_), mt0, nt, r, q); a3[1] = ldT(CB(TOLD_), mt0 + 1, nt, r, q); \
            const FragX xs = ldX<MODE>(CB(NB_), mt0, r, q); const FragY ys = ldY<MODE>(CB(NTB2_), nt, r, q); \
            __builtin_amdgcn_sched_barrier(0); \
            mmf<MODE>(xt, yt, a3); mmf<MODE>(xs, ys, a1); \
            __builtin_amdgcn_sched_barrier(0); \
            _Pragma("unroll") for (int t = 0; t < 2; ++t) stT(CB(TNEW_), mt0 + t, nt, r, q, a3[t]); \
            SQ_ST(a1, ONT_, ON_); } while (0)
        { f32x4 w1[2] = Z2, a1[2] = Z2;
          { const FragX xw = ldX<MODE>(CB(11), mt0, r, q), xs = ldX<MODE>(CB(8), mt0, r, q); const FragY yw = ldY<MODE>(CB(7), nt, r, q), ys = ldY<MODE>(CB(9), nt, r, q);
            __builtin_amdgcn_sched_barrier(0);
            mmf<MODE>(xw, yw, w1); mmf<MODE>(xs, ys, a1); }
          __builtin_amdgcn_sched_barrier(0);
          stT(CB(14), mt0, nt, r, q, w1[0]); stT(CB(14), mt0 + 1, nt, r, q, w1[1]); SQ_ST(a1, 0, 1); }
        __syncthreads();
        TSQ_STAGE(0, 10, 2, 1, 0, 8, 9);   __syncthreads();
        TSQ_STAGE(8, 2, 10, 9, 8, 0, 1);   __syncthreads();
        TSQ_STAGE(0, 10, 2, 1, 0, 8, 9);   __syncthreads();
        TSQ_STAGE(8, 2, 10, 9, 8, 0, -1);  __syncthreads();
        { f32x4 a3[2]; const FragX xt = ldX<MODE>(CB(0), mt0, r, q); const FragY yt = ldY<MODE>(CB(10), nt, r, q); a3[0] = ldT(CB(10), mt0, nt, r, q); a3[1] = ldT(CB(10), mt0 + 1, nt, r, q);
          __builtin_amdgcn_sched_barrier(0);
          mmf<MODE>(xt, yt, a3); stT(CB(2), mt0, nt, r, q, a3[0]); stT(CB(2), mt0 + 1, nt, r, q, a3[1]); }
        __syncthreads();
        if (d == 0) { dma_tile(Zm + (ZLORA + 64) * 2, zo, ldsb + 10 * CBUF, F.wave, lane_); dma_tile(Zm + (ZLORA + 128 + 64) * 2, zo, ldsb + 11 * CBUF, F.wave, lane_); }
        { f32x4 w2[2] = Z2, ah[2] = Z2;
          { const FragX xT = ldX<MODE>(CB(2), mt0, r, q); const FragY y14 = ldY<MODE>(CB(14), nt, r, q), y4 = ldY<MODE>(CB(4), nt, r, q);
            __builtin_amdgcn_sched_barrier(0);
            mmf<MODE>(xT, y14, w2); mmf<MODE>(xT, y4, ah); }
#pragma unroll
          for (int t = 0; t < 2; ++t) { stT(CB(8), mt0 + t, nt, r, q, w2[t]); stT(CB(9), mt0 + t, nt, r, q, ah[t]); } }
        __syncthreads();
        if (d == 1 && un >= 0) { const int hn = un & 7, btn = un >> 3, bn = btn / NCHK, blkn = btn % NCHK;
            const size_t rown = (blkn < 4 ? (size_t)MT + bn * LC + blkn * 64 : (size_t)bn * T + (blkn - 4) * 64);
            const char* zn = (const char*)(Z + (rown - 1) * PINP);
            dma_tile(zn + (ZR + hn * 64) * 2, zo, ldsb + 10 * CBUF, F.wave, lane_); dma_tile(zn + (ZRK + hn * 64) * 2, zo, ldsb + 11 * CBUF, F.wave, lane_); dma_tile(zn + (ZRV + hn * 64) * 2, zo, ldsb + 14 * CBUF, F.wave, lane_); }
        { const size_t ud = ((size_t)((b * 8 + h) * 2 + d)) * NCHK + chunk_p;
          bf16* Pg = (bf16*)(F.ws + WS_PQ + ud * PQ_UNIT); bf16* Qg = Pg + 4096;
          f32x4 pP[2] = Z2, pQ[2] = Z2;
          { const FragX x9 = ldX<MODE>(CB(9), mt0, r, q), x5 = ldX<MODE>(CB(5), mt0, r, q), x6 = ldX<MODE>(CB(6), mt0, r, q); const FragY y5 = ldY<MODE>(CB(5), nt, r, q), y8 = ldY<MODE>(CB(8), nt, r, q), y7 = ldY<MODE>(CB(7), nt, r, q);
            __builtin_amdgcn_sched_barrier(0);
            mmf<MODE>(x9, y5, pP); mmf<MODE>(x5, y8, pQ); mmf<MODE>(x6, y7, pQ); }
          __builtin_amdgcn_sched_barrier(0);
          const int n = 16 * nt + r; const float ge = __expf(cle[n]);
#pragma unroll
          for (int t = 0; t < 2; ++t) {
#pragma unroll
              for (int jj = 0; jj < 4; ++jj) { const int m = 16 * (mt0 + t) + 4 * q + jj; pP[t][jj] += (m == n) ? ge : 0.f; }
              *(GAS v2u*)(Pg + afrag_off(n, 16 * (mt0 + t) + 4 * q)) = pack4(pP[t]); *(GAS v2u*)(Qg + cfrag_off(n, 16 * (mt0 + t) + 4 * q)) = pack4(pQ[t]); }
          if (!isctx) { const size_t ul = ((size_t)((b * 8 + h) * 2 + d)) * 128 + (chunk_p - 4);
              bf16* Rg = (bf16*)((unsigned char*)F.out + ul * RY_UNIT); bf16* Yg = Rg + 4096;
              f32x4 pR[2], pY[2] = Z2; pR[0] = ldT(CB(3), mt0, nt, r, q); pR[1] = ldT(CB(3), mt0 + 1, nt, r, q);
              { const FragX x9 = ldX<MODE>(CB(9), mt0, r, q), x12 = ldX<MODE>(CB(12), mt0, r, q), x13 = ldX<MODE>(CB(13), mt0, r, q); const FragY y12 = ldY<MODE>(CB(12), nt, r, q), y8 = ldY<MODE>(CB(8), nt, r, q), y7 = ldY<MODE>(CB(7), nt, r, q);
                __builtin_amdgcn_sched_barrier(0);
                mmf<MODE>(x9, y12, pR); mmf<MODE>(x12, y8, pY); mmf<MODE>(x13, y7, pY); }
              __builtin_amdgcn_sched_barrier(0);
#pragma unroll
              for (int t = 0; t < 2; ++t) {
                  *(GAS v2u*)(Rg + afrag_off(d ? 63 - n : n, 16 * (mt0 + t) + 4 * q)) = pack4(pR[t]);
                  if (d) { const f32x4 rv = {pY[t][3], pY[t][2], pY[t][1], pY[t][0]}; *(GAS v2u*)(Yg + cfrag_off(n, 60 - 16 * (mt0 + t) - 4 * q)) = pack4(rv); }
                  else *(GAS v2u*)(Yg + cfrag_off(n, 16 * (mt0 + t) + 4 * q)) = pack4(pY[t]); } } }
        if (d == 0) { if (isctx) VMW(4); else VMW(8); }
        __syncthreads();
    }
#undef SQ_ST
#undef TSQ_STAGE
}

struct BSetPQ { v4u p[8]; v2u qv[4]; };
constexpr size_t XC_UNIT = 2048;
__device__ __forceinline__ void rwkvB_task(Frame& F, int task) {
    const int vsl = task & 3, chain = task >> 2;
    const int r = F.lane & 15, q = F.lane >> 4;
    const unsigned char* PQ = F.ws + WS_PQ + (size_t)chain * NCHK * PQ_UNIT;
    unsigned char* XC = F.ws + WS_YFB + ((size_t)chain * 128 * 4 + vsl) * XC_UNIT;
    f32x4 X[4];
#pragma unroll
    for (int i = 0; i < 4; ++i) X[i] = (f32x4){0.f, 0.f, 0.f, 0.f};
#define B_LOADPQ(S, c_) do { const int _c = (c_) < NCHK ? (c_) : NCHK - 1; const bf16* _P = (const bf16*)(PQ + (size_t)_c * PQ_UNIT); const bf16* _Q = _P + 4096; \
        _Pragma("unroll") for (int mt = 0; mt < 4; ++mt) { S.qv[mt] = *(const GAS v2u*)(_Q + (((vsl * 4 + mt) * 64 + F.lane) << 2)); \
            _Pragma("unroll") for (int ks = 0; ks < 2; ++ks) S.p[mt * 2 + ks] = *(const GAS v4u*)(_P + (((mt * 2 + ks) * 64 + F.lane) << 3)); } } while (0)
#define B_STEP(S, c_) do { const int _c = (c_); bf16x8 xb[2]; \
        _Pragma("unroll") for (int ks = 0; ks < 2; ++ks) { const v2u lo = pack4(X[2 * ks]), hi = pack4(X[2 * ks + 1]); const v4u xw = {lo.x, lo.y, hi.x, hi.y}; xb[ks] = __builtin_bit_cast(bf16x8, xw); \
            if (_c >= 4) *(GAS v4u*)(XC + (size_t)(_c - 4) * 4 * XC_UNIT + ks * 1024 + F.lane * 16) = xw; } \
        _Pragma("unroll") for (int mt = 0; mt < 4; ++mt) { f32x4 xn = unpack4(S.qv[mt]); \
            _Pragma("unroll") for (int ks = 0; ks < 2; ++ks) xn = __builtin_amdgcn_mfma_f32_16x16x32_bf16(__builtin_bit_cast(bf16x8, S.p[mt * 2 + ks]), xb[ks], xn, 0, 0, 0); \
            X[mt] = xn; } } while (0)
    BSetPQ SA, SB, SC;
    B_LOADPQ(SA, 0); B_LOADPQ(SB, 1);
#pragma unroll 1
    for (int c = 0; c < NCHK; c += 3) {
        B_LOADPQ(SC, c + 2); B_STEP(SA, c);
        B_LOADPQ(SA, c + 3); B_STEP(SB, c + 1);
        B_LOADPQ(SB, c + 4); B_STEP(SC, c + 2);
    }
#undef B_LOADPQ
#undef B_STEP
}

constexpr int YSP = 520;
__device__ __forceinline__ void phase_readout(Frame& F) {
    bf16* Z = (bf16*)(F.ws + WS_Z); const bf16* G = (const bf16*)(F.ws + WS_G); const float* COEF = (const float*)(F.ws + WS_COEF);
    LAS bf16* YS = (LAS bf16*)F.lds;
    const int r = F.lane & 15, q = F.lane >> 4, h = F.wave;
    const int hh = F.lane >> 3, c0 = F.lane * 8;
    float gnw[8], gnb[8];
#pragma unroll
    for (int e = 0; e < 8; ++e) { gnw[e] = F.in[18][c0 + e]; gnb[e] = F.in[19][c0 + e]; }
    for (int u = F.bid; u < NB * 128; u += F.G) {
        const int b = u >> 7, blk = u & 127;
        f32x4 y[4][4];
#pragma unroll
        for (int it = 0; it < 4; ++it)
#pragma unroll
            for (int vs = 0; vs < 4; ++vs) y[it][vs] = (f32x4){0.f, 0.f, 0.f, 0.f};
#pragma unroll
        for (int d = 0; d < 2; ++d) {
            const int chain = (b * 8 + h) * 2 + d, lc = d ? 127 - blk : blk;
            const bf16* Rg = (const bf16*)((const unsigned char*)F.out + ((size_t)chain * 128 + lc) * RY_UNIT); const bf16* Yg = Rg + 4096;
            const unsigned char* XC = F.ws + WS_YFB + ((size_t)chain * 128 + lc) * 4 * XC_UNIT;
            v4u xw[4][2], rr[4][2]; v2u yl[4][4];
#pragma unroll
            for (int vs = 0; vs < 4; ++vs) { xw[vs][0] = *(const GAS v4u*)(XC + vs * XC_UNIT + F.lane * 16); xw[vs][1] = *(const GAS v4u*)(XC + vs * XC_UNIT + 1024 + F.lane * 16); }
#pragma unroll
            for (int it = 0; it < 4; ++it) {
#pragma unroll
                for (int ks = 0; ks < 2; ++ks) rr[it][ks] = *(const GAS v4u*)(Rg + (((it * 2 + ks) * 64 + F.lane) << 3));
#pragma unroll
                for (int vs = 0; vs < 4; ++vs) yl[it][vs] = *(const GAS v2u*)(Yg + (((vs * 4 + it) * 64 + F.lane) << 2)); }
#pragma unroll
            for (int it = 0; it < 4; ++it)
#pragma unroll
                for (int vs = 0; vs < 4; ++vs) { f32x4 a = y[it][vs] + unpack4(yl[it][vs]);
#pragma unroll
                    for (int ks = 0; ks < 2; ++ks) a = __builtin_amdgcn_mfma_f32_16x16x32_bf16(__builtin_bit_cast(bf16x8, rr[it][ks]), __builtin_bit_cast(bf16x8, xw[vs][ks]), a, 0, 0, 0);
                    y[it][vs] = a; }
        }
#pragma unroll
        for (int it = 0; it < 4; ++it)
#pragma unroll
            for (int vs = 0; vs < 4; ++vs)
#pragma unroll
                for (int jj = 0; jj < 4; ++jj) YS[(16 * it + 4 * q + jj) * YSP + h * 64 + 16 * vs + r] = f2bf_hw(y[it][vs][jj]);
        __syncthreads();
#pragma unroll 2
        for (int tk = 0; tk < 8; ++tk) {
            const int tok = 8 * F.wave + tk, t = blk * 64 + tok; const size_t m = (size_t)b * T + t;
            float vsh[8], yf[8], gg[8];
            shift8(Z + m * PINP + ZRV + c0, t > 0, t < T - 1, F.in[8] + 1024 + c0, F.in[9] + 1024 + c0, vsh);
            unpack8(*(const LAS v4u*)(YS + tok * YSP + c0), yf); unpack8(*(const GAS v4u*)(G + m * 512 + c0), gg);
            const f32x2 cf2 = *(const GAS f32x2*)(COEF + m * 16 + hh * 2); const float coef = cf2.x + cf2.y;
            float sm = 0.f;
#pragma unroll
            for (int e = 0; e < 8; ++e) sm += yf[e];
            const float mean = sum8(sm) * (1.0f / 64.0f); float q2 = 0.f;
#pragma unroll
            for (int e = 0; e < 8; ++e) { yf[e] -= mean; q2 += yf[e] * yf[e]; }
            const float rstd = 1.0f / sqrtf(sum8(q2) * (1.0f / 64.0f) + GN_EPS);
            float o[8];
#pragma unroll
            for (int e = 0; e < 8; ++e) o[e] = (yf[e] * rstd * gnw[e] + gnb[e] + coef * vsh[e]) * gg[e];
            *(GAS v4u*)(Z + m * PINP + ZK + c0) = pack8(o);
        }
        __syncthreads();
    }
}

__device__ __forceinline__ void phase_ln1_router(Frame& F, float* hdst = nullptr) {
    const float* MODV = (const float*)(F.ws + WS_MOD);
    unsigned char* U2 = F.ws + WS_U2; float* AFF = (float*)(F.ws + WS_AFF);
    LAS float* wr = (LAS float*)F.lds;
    for (int e = F.tid; e < 1024 * 16; e += NTHR) { const int d = e >> 4, ex = e & 15, j = d >> 8, ln = (d & 255) >> 2, q = d & 3; wr[((j * 4 + q) * 64 + ln) * 20 + ex] = F.in[25][e]; }
    LAS float* tr = (LAS float*)(F.lds + 81920 + F.wave * 4352);
    __syncthreads();
    const int gw = F.bid * NWAVES + F.wave, NGW = F.G * NWAVES;
    f32x4 nx[4];
    if (gw < MT) {
#pragma unroll
        for (int j = 0; j < 4; ++j) nx[j] = ((const GAS f32x4*)(F.out + (size_t)gw * D) + F.lane)[64 * j]; }
    for (int m = gw; m < MT; m += NGW) {
        const int b = m / T;
        const float* sh2 = MODV + b * 6144 + 3072; const float* sc2 = sh2 + 1024;
        GAS f32x4* hr = (GAS f32x4*)(F.out + (size_t)m * D) + F.lane;
        f32x4 v[4]; float s = 0.f;
#pragma unroll
        for (int j = 0; j < 4; ++j) { v[j] = nx[j]; s += (v[j].x + v[j].y) + (v[j].z + v[j].w); }
        if (m + NGW < MT) {
#pragma unroll
            for (int j = 0; j < 4; ++j) nx[j] = ((const GAS f32x4*)(F.out + (size_t)(m + NGW) * D) + F.lane)[64 * j]; }
        float mean = wave_sum(s) * (1.f / D); float s2 = 0.f;
#pragma unroll
        for (int j = 0; j < 4; ++j) { v[j] = v[j] - mean; s2 += (v[j].x * v[j].x + v[j].y * v[j].y) + (v[j].z * v[j].z + v[j].w * v[j].w); }
        float rstd = 1.f / sqrtf(wave_sum(s2) * (1.f / D) + LN_EPS);
        s = 0.f;
#pragma unroll
        for (int j = 0; j < 4; ++j) { const f32x4 g = *((const f32x4*)F.in[23] + F.lane + 64 * j), bb = *((const f32x4*)F.in[24] + F.lane + 64 * j);
            v[j] = v[j] * rstd * g + bb; if (hdst) ((GAS f32x4*)(hdst + (size_t)m * D) + F.lane)[64 * j] = v[j]; else hr[64 * j] = v[j]; s += (v[j].x + v[j].y) + (v[j].z + v[j].w); }
        mean = wave_sum(s) * (1.f / D); s2 = 0.f;
#pragma unroll
        for (int j = 0; j < 4; ++j) { v[j] = v[j] - mean; s2 += (v[j].x * v[j].x + v[j].y * v[j].y) + (v[j].z * v[j].z + v[j].w * v[j].w); }
        rstd = 1.f / sqrtf(wave_sum(s2) * (1.f / D) + LN_EPS);
        GAS unsigned* o4 = (GAS unsigned*)(U2 + (size_t)m * D) + F.lane;
        float lg[16];
#pragma unroll
        for (int e = 0; e < 16; ++e) lg[e] = 0.f;
#pragma unroll
        for (int j = 0; j < 4; ++j) { const f32x4 a = *((const f32x4*)sc2 + F.lane + 64 * j), bb = *((const f32x4*)sh2 + F.lane + 64 * j);
            const f32x4 o = v[j] * rstd * (a + 1.0f) + bb; v[j] = o;
            o4[64 * j] = pk4_fp8(o.x, o.y, o.z, o.w); }
#pragma unroll
        for (int j = 0; j < 4; ++j) {
#pragma unroll
            for (int q = 0; q < 4; ++q) { const LAS f32x4* wp = (const LAS f32x4*)(wr + (size_t)(((j * 4 + q) * 64 + F.lane) * 20)); const float oq = v[j][q];
#pragma unroll
                for (int e4 = 0; e4 < 4; ++e4) { const f32x4 w = wp[e4]; lg[e4 * 4 + 0] += oq * w.x; lg[e4 * 4 + 1] += oq * w.y; lg[e4 * 4 + 2] += oq * w.z; lg[e4 * 4 + 3] += oq * w.w; } }
            __builtin_amdgcn_sched_barrier(0); }
#pragma unroll
        for (int e = 0; e < 16; ++e) tr[F.lane * 17 + e] = lg[e];
        LDS_WAIT(); asm volatile("" ::: "memory");
        float lgt = 0.f;
#pragma unroll
        for (int i = 0; i < 16; ++i) lgt += tr[((F.lane >> 4) * 16 + i) * 17 + (F.lane & 15)];
        LDS_WAIT(); asm volatile("" ::: "memory");
        lgt += __shfl_xor(lgt, 16); lgt += __shfl_xor(lgt, 32);
        float mx = lgt;
        mx = fmaxf(mx, dppf<0xB1>(mx)); mx = fmaxf(mx, dppf<0x4E>(mx)); mx = fmaxf(mx, dppf<0x141>(mx)); mx = fmaxf(mx, dppf<0x140>(mx));
        const float ex = expf(lgt - mx); const float mine = ex / row16_sum(ex);
        if (F.lane < 16) AFF[(size_t)m * 16 + F.lane] = mine;
    }
}

__device__ __forceinline__ unsigned block_excl_scan(Frame& F, unsigned v, LAS unsigned* sc, unsigned& total) {
    unsigned inc = v;
#pragma unroll
    for (int o = 1; o < 64; o <<= 1) { const unsigned t = __shfl_up(inc, o); if (F.lane >= o) inc += t; }
    __syncthreads();
    if (F.lane == 63) sc[F.wave] = inc;
    __syncthreads();
    unsigned base = 0, tot = 0;
#pragma unroll
    for (int w = 0; w < 8; ++w) { const unsigned x = sc[w]; if (w < F.wave) base += x; tot += x; }
    total = tot;
    return base + inc - v;
}
__device__ __forceinline__ void topk_unit(Frame& F, int unit) {
    const int b = unit & 3, e = unit >> 2;
    const float* AFF = (const float*)(F.ws + WS_AFF);
    int* IDX = (int*)(F.ws + WS_IDX); float* GATEV = (float*)(F.ws + WS_GATEV); int* SLOT = (int*)(F.ws + WS_SLOT);
    LAS unsigned* hist = (LAS unsigned*)F.lds;
    LAS unsigned* sc = hist + 256;
    LAS unsigned* sel = sc + 16;
    LAS int* idl = (LAS int*)(sel + 16);
    unsigned key[16];
#pragma unroll
    for (int i = 0; i < 16; ++i) key[i] = __float_as_uint(AFF[((size_t)b * T + F.tid * 16 + i) * 16 + e]);
    unsigned prefix = 0, need = CAP;
#pragma unroll 1
    for (int rd = 0; rd < 4; ++rd) {
        const int shift = 24 - 8 * rd; const unsigned hmask = (rd == 0) ? 0u : (0xffffffffu << (shift + 8));
        if (F.tid < 256) hist[F.tid] = 0u;
        __syncthreads();
#pragma unroll
        for (int i = 0; i < 16; ++i) if ((key[i] & hmask) == prefix) __hip_atomic_fetch_add(&hist[(key[i] >> shift) & 255u], 1u, __ATOMIC_RELAXED, __HIP_MEMORY_SCOPE_WORKGROUP);
        __syncthreads();
        if (F.wave == 0) {
            const unsigned c0 = hist[4 * F.lane], c1 = hist[4 * F.lane + 1], c2 = hist[4 * F.lane + 2], c3 = hist[4 * F.lane + 3];
            const unsigned tot4 = (c0 + c1) + (c2 + c3); unsigned x = tot4;
#pragma unroll
            for (int o = 1; o < 64; o <<= 1) { const unsigned t = __shfl_down(x, o); if (F.lane + o < 64) x += t; }
            const unsigned excl = x - tot4;
            if (excl < need && need <= x) { unsigned cum = excl; int bin;
                if (cum + c3 >= need) bin = 4 * F.lane + 3; else { cum += c3; if (cum + c2 >= need) bin = 4 * F.lane + 2; else { cum += c2; if (cum + c1 >= need) bin = 4 * F.lane + 1; else { cum += c1; bin = 4 * F.lane; } } }
                sel[0] = (unsigned)bin; sel[1] = need - cum; } }
        __syncthreads();
        prefix |= sel[0] << shift; need = sel[1];
        __syncthreads();
    }
    unsigned neq = 0, ngt = 0;
#pragma unroll
    for (int i = 0; i < 16; ++i) { neq += (key[i] == prefix); ngt += (key[i] > prefix); }
    unsigned tot; const unsigned eqbase = block_excl_scan(F, neq, sc, tot);
    unsigned cnt = 0, eqr = eqbase; unsigned selm = 0;
#pragma unroll
    for (int i = 0; i < 16; ++i) { bool s = key[i] > prefix; if (key[i] == prefix) { s = eqr < need; ++eqr; } if (s) { selm |= 1u << i; ++cnt; } }
    const unsigned pos0 = block_excl_scan(F, cnt, sc, tot);
    unsigned pos = pos0;
#pragma unroll
    for (int i = 0; i < 16; ++i) { const int t = F.tid * 16 + i; int sl = -1;
        if (selm & (1u << i)) { sl = (int)pos; ++pos; const int slot = (e * NB + b) * CAP + sl; IDX[slot] = b * T + t; GATEV[slot] = __uint_as_float(key[i]); idl[sl] = b * T + t; }
        SLOT[((size_t)b * T + t) * 16 + e] = sl; }
    __syncthreads();
    { const unsigned char* U2 = F.ws + WS_U2; unsigned char* XS = F.ws + WS_XS + (size_t)((e * NB + b) * CAP) * D;
#pragma unroll 1
      for (int s0 = F.wave * 16; s0 < CAP; s0 += NWAVES * 16) { v4u rw[16];
#pragma unroll
          for (int k = 0; k < 16; ++k) rw[k] = *((const GAS v4u*)(U2 + (size_t)idl[s0 + k] * D) + F.lane);
#pragma unroll
          for (int k = 0; k < 16; ++k) *((GAS v4u*)(XS + (size_t)(s0 + k) * D) + F.lane) = rw[k]; } }
    __syncthreads();
}
constexpr int CV_I13 = 16 * (DE / 64), CV_I2 = (DE / 64) * 16, CV_N13 = NE * 2 * CV_I13;
constexpr int Z_EARLY_PER_WAVE = 6;
__device__ __forceinline__ int z_tail_first(int G) { return ((MA / 256) * (PINP / 256)) % G; }
__device__ __forceinline__ int z_early_tiles(int G) { const int t = z_tail_first(G); const int n = t > 0 ? (G - t) * NWAVES * Z_EARLY_PER_WAVE : 0; return n <= NE * CV_I2 - W2_EARLY_TILES ? n : 0; }
__device__ __forceinline__ void cvt_w2_tile(Frame& F, int w2t) { const int e = w2t / CV_I2, r = w2t % CV_I2, k0 = 64 * (r / 16), n0 = 64 * (r % 16);
    cvt_tile64_fp8(F.in[28] + (size_t)e * DE * 1024, 1024, k0, n0, F.ws + WS_W2 + (size_t)e * 1024 * DE, (size_t)n0, DE, W2_SCALE, F.lane); }
__device__ __forceinline__ void cvt_w13_tile(Frame& F, int it0) { const int e = it0 / (2 * CV_I13); int r = it0 % (2 * CV_I13);
    const int which = r / CV_I13; r %= CV_I13; const int nb = DE / 64, k0 = 64 * (r / nb), n0 = 64 * (r % nb);
    cvt_tile64_fp8(F.in[which ? 27 : 26] + (size_t)e * 1024 * DE, DE, k0, n0, F.ws + WS_W13 + (size_t)e * PINP * 1024, (size_t)(256 * (n0 / 128) + 128 * which + (n0 % 128)), 1024, W13_SCALE, F.lane); }
__device__ __forceinline__ void phase_topk_convert(Frame& F) {
    if (F.bid < NB * NE) topk_unit(F, F.bid);
    const int NTK = NB * NE * NWAVES, NVW = F.G * NWAVES - NTK;
    const int gwl = F.bid * NWAVES + F.wave; const int vw0 = gwl < NTK ? 0 : (gwl - NTK), nvw = gwl < NTK ? 0 : 1;
    const int w2done = z_early_tiles(F.G) + W2_EARLY_TILES, nlate = CV_N13 + NE * CV_I2 - w2done;
    for (int itb = vw0; itb < nlate; itb += NVW) for (int v = 0; v < nvw; ++v) { const int it0 = itb + v; if (it0 >= nlate) break;
        if (it0 < CV_N13) cvt_w13_tile(F, it0); else cvt_w2_tile(F, it0 - CV_N13 + w2done); }
}

__device__ __forceinline__ void phase_gather(Frame& F) {
    const int* IDX = (const int*)(F.ws + WS_IDX); const unsigned char* U2 = F.ws + WS_U2; unsigned char* XS = F.ws + WS_XS;
    const int gw = F.bid * NWAVES + F.wave, NGW = F.G * NWAVES;
    for (int s = gw; s < NSLOT; s += NGW) {
        const int src = IDX[s];
        *((GAS v4u*)(XS + (size_t)s * D) + F.lane) = *((const GAS v4u*)(U2 + (size_t)src * D) + F.lane);
    }
}

__device__ __forceinline__ void phase_final(Frame& F, float* odst = nullptr) {
    const float* MODV = (const float*)(F.ws + WS_MOD); const int* SLOT = (const int*)(F.ws + WS_SLOT); const bf16* YE = (const bf16*)(F.ws + WS_YE);
    const int gw = F.bid * NWAVES + F.wave, NGW = F.G * NWAVES;
    int nslot = -1; f32x4 nhv[4];
    if (gw < MT) { nslot = (F.lane < 16) ? SLOT[(size_t)gw * 16 + F.lane] : -1;
#pragma unroll
        for (int j = 0; j < 4; ++j) nhv[j] = ((const GAS f32x4*)(F.out + (size_t)gw * D) + F.lane)[64 * j]; }
    for (int m = gw; m < MT; m += NGW) {
        const int b = m / T;
        const float* gt2 = MODV + b * 6144 + 5120;
        GAS f32x4* hr = (GAS f32x4*)(F.out + (size_t)m * D) + F.lane;
        f32x4 acc[4];
#pragma unroll
        for (int j = 0; j < 4; ++j) acc[j] = (f32x4){0.f, 0.f, 0.f, 0.f};
        const int myslot = nslot;
        f32x4 hv[4];
#pragma unroll
        for (int j = 0; j < 4; ++j) hv[j] = nhv[j];
        if (m + NGW < MT) { nslot = (F.lane < 16) ? SLOT[(size_t)(m + NGW) * 16 + F.lane] : -1;
#pragma unroll
            for (int j = 0; j < 4; ++j) nhv[j] = ((const GAS f32x4*)(F.out + (size_t)(m + NGW) * D) + F.lane)[64 * j]; }
        unsigned mask = (unsigned)(__ballot(myslot >= 0) & 0xFFFFull);
        while (mask) {
            const int e0 = __builtin_ctz(mask); mask &= mask - 1; const bool two = mask != 0; const int e1 = two ? __builtin_ctz(mask) : e0; if (two) mask &= mask - 1;
            const int s0 = __shfl(myslot, e0), s1 = __shfl(myslot, e1);
            const GAS v2u* y0 = (const GAS v2u*)(YE + (size_t)((e0 * NB + b) * CAP + s0) * D) + F.lane; const GAS v2u* y1 = (const GAS v2u*)(YE + (size_t)((e1 * NB + b) * CAP + s1) * D) + F.lane;
            v2u w0[4], w1[4];
#pragma unroll
            for (int j = 0; j < 4; ++j) { w0[j] = y0[64 * j]; w1[j] = y1[64 * j]; }
            const float f1 = two ? 1.f : 0.f;
#pragma unroll
            for (int j = 0; j < 4; ++j) { acc[j].x += bflo(w0[j].x) + f1 * bflo(w1[j].x); acc[j].y += bfhi(w0[j].x) + f1 * bfhi(w1[j].x); acc[j].z += bflo(w0[j].y) + f1 * bflo(w1[j].y); acc[j].w += bfhi(w0[j].y) + f1 * bfhi(w1[j].y); } }
        f32x4 v[4]; float s = 0.f;
#pragma unroll
        for (int j = 0; j < 4; ++j) { const f32x4 g = *((const f32x4*)gt2 + F.lane + 64 * j); v[j] = hv[j] * ALPHA + g * acc[j]; s += (v[j].x + v[j].y) + (v[j].z + v[j].w); }
        const float mean = wave_sum(s) * (1.f / D); float s2 = 0.f;
#pragma unroll
        for (int j = 0; j < 4; ++j) { v[j] = v[j] - mean; s2 += (v[j].x * v[j].x + v[j].y * v[j].y) + (v[j].z * v[j].z + v[j].w * v[j].w); }
        const float rstd = 1.f / sqrtf(wave_sum(s2) * (1.f / D) + LN_EPS);
#pragma unroll
        for (int j = 0; j < 4; ++j) { const f32x4 g = *((const f32x4*)F.in[29] + F.lane + 64 * j), bb = *((const f32x4*)F.in[30] + F.lane + 64 * j); { const f32x4 ov = v[j] * rstd * g + bb; if (odst) ((GAS f32x4*)(odst + (size_t)m * D) + F.lane)[64 * j] = ov; else hr[64 * j] = ov; } }
    }
}

constexpr int N_PHASES = 16;
struct Args { const float* in[31]; float* out; unsigned char* ws; int ph_lo, ph_hi; };
__global__ void __launch_bounds__(NTHR, 2) fwd(Args args) {
    extern __shared__ __attribute__((aligned(16))) unsigned char lds[];
    Frame F;
    F.lds = (LAS unsigned char*)lds;
    F.tid = threadIdx.x; F.lane = F.tid & 63; F.wave = __builtin_amdgcn_readfirstlane(F.tid >> 6);
    F.G = gridDim.x; F.bid = blockIdx.x;
#pragma unroll
    for (int i = 0; i < 31; ++i) F.in[i] = args.in[i];
    F.out = args.out; F.ws = args.ws;
    volatile LAS unsigned* MISC = (volatile LAS unsigned*)(F.lds + MISC_OFF);
    for (int u = F.tid; u < (LDS_BYTES - LDSCTL_OFF) / 4; u += NTHR) ((LAS unsigned*)(F.lds + LDSCTL_OFF))[u] = 0u;
    __syncthreads();
    XcdBarrier bar; bar.bar = (unsigned*)(F.ws + WS_CTL) + CW_BAR; bar.x = 0; bar.st = nullptr;
    const int lo = args.ph_lo, hi = args.ph_hi;
    const bool multi = (hi - lo) > 1;
    if (multi) bar = xcd_barrier_post((unsigned*)(F.ws + WS_CTL) + CW_BAR, MISC + 8);
#ifndef PH_MASK
#define PH_MASK 0xFFFF
#endif
#define IN(k) (((PH_MASK >> (k)) & 1) && lo <= (k) && (k) < hi)
#define SEAM(k) do { if (IN(k) && IN((k) + 1)) xcd_barrier(bar); } while (0)
    LAS unsigned char* ring = F.lds;
    bf16* Z = (bf16*)(F.ws + WS_Z);

    if (IN(0)) { for (int rp = 0; rp < REPS(0); ++rp) { phase_prologue(F); if (rp + 1 < REPS(0)) xcd_barrier(bar); } SEAM(0); }
    if (IN(1)) { for (int rp = 0; rp < REPS(1); ++rp) { phase_ln_mod(F); if (rp + 1 < REPS(1)) xcd_barrier(bar); } SEAM(1); }
    if (IN(2)) {
        pg8::Gemm g{(const bf16*)(F.ws + WS_U), (const bf16*)(F.ws + WS_WIN), MA, PINP, D, D, 1 << 30, 0};
        pg8::StaticOrder S; S.init(MA, PINP, F.G, F.bid);
        pg8::EpiBf16 E{Z, PINP};
        pg8::gemm_phase<pg8::EpiBf16, pg8::StaticOrder, true, true>(ring, g, S, E);
        if (DUP(2)) { xcd_barrier(bar); pg8::gemm_phase<pg8::EpiBf16, pg8::StaticOrder, true, true>(ring, g, S, E); }
        { const int t0 = z_tail_first(F.G);
          if (z_early_tiles(F.G) > 0 && F.bid >= t0) { const int nw = (F.G - t0) * NWAVES, w0 = (F.bid - t0) * NWAVES + F.wave;
              for (int k = 0; k < Z_EARLY_PER_WAVE; ++k) cvt_w2_tile(F, w0 + k * nw); } }
        SEAM(2);
    }
    if (IN(3)) {
        phase_rope_vt(F);
        __syncthreads();
        { LAS float* mu = (LAS float*)(F.lds + LDS_MU); for (int e = F.tid; e < 768; e += NTHR) mu[e] = F.in[e < 384 ? 8 : 9][1536 + (e < 384 ? e : e - 384)]; }
        __syncthreads();
#ifdef PROBE_AMODE
        { int hl0 = -1; for (int u = F.bid; u < NB * NCHK * 8; u += F.G) rwkvA_unit<PROBE_AMODE>(F, u, hl0, -1, -1); }
        xcd_barrier(bar);
#endif
        for (int rp = 0; rp < REPS(3); ++rp) { int hl = -1, pre = -1; for (int u = F.bid; u < NB * NCHK * 8; u += F.G) { const int un = u + F.G < NB * NCHK * 8 ? u + F.G : -1; rwkvA_unit<0>(F, u, hl, pre, un); pre = (((u >> 3) % NCHK) < 4) ? 4 : 8; } if (rp + 1 < REPS(3)) xcd_barrier(bar); }
        SEAM(3);
    }
    if (IN(4)) {
        LAS float* rpbs = (LAS float*)F.lds;
        LAS bf16* ck = (LAS bf16*)(F.lds + 16384);
        LAS bf16* cvt = (LAS bf16*)(F.lds + 16384 + 36864);
        for (int e = F.tid; e < 8 * 465 + 224; e += NTHR) rpbs[e] = e < 8 * 465 ? 8.0f * F.in[7][e] : -1e30f;
        {
            const int vb = F.bid, bh = (vb >> 3) & 31, b4 = bh >> 3, h4 = bh & 7, sub = vb & 7;
            { const bf16* Zc = Z + ((size_t)MT + b4 * LC) * PINP + ZK + h4 * 64; const bf16* VTCg = (const bf16*)(F.ws + WS_VT) + VT_LAT_ELEMS + (size_t)bh * 64 * LC;
              for (int e = F.tid; e < 256 * 8; e += NTHR) { const int row = e >> 3, c8 = (e & 7) * 8; *(LAS v4u*)(ck + row * NA_KP + c8) = *(const GAS v4u*)(Zc + (size_t)row * PINP + c8); }
              for (int e = F.tid; e < 64 * 32; e += NTHR) { const int row = e >> 5, c8 = (e & 31) * 8; *(LAS v4u*)(cvt + row * NA_VP + c8) = *(const GAS v4u*)(VTCg + (size_t)row * LC + c8); } }
            __syncthreads();
            if (vb < 256) {
                if (DUP(4)) { if (F.wave > 0) for (int tk = F.wave - 1; tk < 64; tk += 7) na_wave_task(F, (b4 << 12) | ((16 * sub + (tk >> 2)) << 5) | (h4 << 2) | (tk & 3), rpbs, ck, cvt, ZV); }
                if (F.wave == 0) { rwkvB_task(F, vb);
                    { const int ze = z_early_tiles(F.G); for (int w2t = ze + vb; w2t < ze + W2_EARLY_TILES; w2t += 256) cvt_w2_tile(F, w2t); } }
                else { for (int tk = F.wave - 1; tk < 64; tk += 7) na_wave_task(F, (b4 << 12) | ((16 * sub + (tk >> 2)) << 5) | (h4 << 2) | (tk & 3), rpbs, ck, cvt); }
            }
        }
        if (REPS(4) > 1) { xcd_barrier(bar); if (F.wave == 0 && F.bid < 256) rwkvB_task(F, F.bid); }
        SEAM(4);
    }
    if (IN(5)) { for (int rp = 0; rp < REPS(5); ++rp) { phase_readout(F); if (rp + 1 < REPS(5)) xcd_barrier(bar); } SEAM(5); }
    if (IN(6)) {
        pg8::StaticOrder S; S.init(MT, D, F.G, F.bid);
        { pg8::Gemm g{Z + ZQ, (const bf16*)(F.ws + WS_WPA), MT, D, 512, PINP, 1 << 30, 0};
          pg8::EpiGate<0> E{(bf16*)(F.ws + WS_LORA), D, Z + ZGNA, PINP};
          pg8::gemm_phase<pg8::EpiGate<0>, pg8::StaticOrder, true, true>(ring, g, S, E); }
        VM_WAIT(); __syncthreads();
        { pg8::Gemm g{Z + ZK, (const bf16*)(F.ws + WS_WPR), MT, D, 512, PINP, 1 << 30, 0};
          pg8::EpiGate<1> E{(bf16*)(F.ws + WS_LORA), D, Z + ZGRW, PINP};
          pg8::gemm_phase<pg8::EpiGate<1>, pg8::StaticOrder, true, true>(ring, g, S, E); }
        if (DUP(6)) { xcd_barrier(bar);

        { pg8::Gemm g{Z + ZQ, (const bf16*)(F.ws + WS_WPA), MT, D, 512, PINP, 1 << 30, 0};
          pg8::EpiGate<0> E{(bf16*)(F.ws + WS_LORA), D, Z + ZGNA, PINP};
          pg8::gemm_phase<pg8::EpiGate<0>, pg8::StaticOrder, true, true>(ring, g, S, E); }
        VM_WAIT(); __syncthreads();
        { pg8::Gemm g{Z + ZK, (const bf16*)(F.ws + WS_WPR), MT, D, 512, PINP, 1 << 30, 0};
          pg8::EpiGate<1> E{(bf16*)(F.ws + WS_LORA), D, Z + ZGRW, PINP};
          pg8::gemm_phase<pg8::EpiGate<1>, pg8::StaticOrder, true, true>(ring, g, S, E); }
        }
        SEAM(6);
    }
    if (IN(7)) {
        pg8::Gemm g{(const bf16*)(F.ws + WS_LORA), (const bf16*)(F.ws + WS_WO), MT, D, D, D, 1 << 30, 0};
        pg8::StaticOrder S; S.init(MT, D, F.G, F.bid);
        pg8::EpiResid E{F.out, F.in[0], (const float*)(F.ws + WS_MOD) + 2048, 6144, T, ALPHA};
        pg8::gemm_phase<pg8::EpiResid, pg8::StaticOrder, true, true>(ring, g, S, E);
        if (DUP(7)) { xcd_barrier(bar); pg8::gemm_phase<pg8::EpiResid, pg8::StaticOrder, true, true>(ring, g, S, E); }
        SEAM(7);
    }
    if (IN(8)) { if (DUP(8)) { phase_ln1_router(F, (float*)(F.ws + WS_YE)); xcd_barrier(bar); } phase_ln1_router(F); SEAM(8); }
    if (IN(9)) { for (int rp = 0; rp < REPS(9); ++rp) { phase_topk_convert(F); if (rp + 1 < REPS(9)) xcd_barrier(bar); } SEAM(9); }
    if (IN(11)) {
        pg8::Gemm g{(const bf16*)(F.ws + WS_XS), (const bf16*)(F.ws + WS_W13), NSLOT, PINP, D / 2, D / 2, 16, (size_t)PINP * 1024};
        pg8::StaticOrder S; S.init(NSLOT, PINP, F.G, F.bid);
        pg8::EpiSwiglu E{F.ws + WS_HDN, DE, 1.0f / W13_SCALE, HDN_SCALE};
        pg8::gemm_phase<pg8::EpiSwiglu, pg8::StaticOrder, true, true, true>(ring, g, S, E);
        if (DUP(11)) { xcd_barrier(bar); pg8::gemm_phase<pg8::EpiSwiglu, pg8::StaticOrder, true, true, true>(ring, g, S, E); }
        SEAM(11);
    }
    if (IN(12)) {
        pg8::Gemm g{(const bf16*)(F.ws + WS_HDN), (const bf16*)(F.ws + WS_W2), NSLOT, D, DE / 2, DE / 2, 16, (size_t)1024 * DE};
        pg8::StaticOrder S; S.init(NSLOT, D, F.G, F.bid);
        pg8::EpiScaleRow E{(bf16*)(F.ws + WS_YE), D, (const float*)(F.ws + WS_GATEV), 1.0f / (W2_SCALE * HDN_SCALE)};
        pg8::gemm_phase<pg8::EpiScaleRow, pg8::StaticOrder, true, true, true>(ring, g, S, E);
        if (DUP(12)) { xcd_barrier(bar); pg8::gemm_phase<pg8::EpiScaleRow, pg8::StaticOrder, true, true, true>(ring, g, S, E); }
        if (IN(12) && IN(15)) xcd_barrier(bar);
    }
    if (IN(15)) { if (DUP(15)) { phase_final(F, (float*)(F.ws + WS_HDN)); xcd_barrier(bar); } phase_final(F); }
#undef IN
#undef SEAM
}

extern "C" void kernel_launch(void* const* d_in, const int* in_sizes, int n_in, void* d_out, int out_size, void* d_ws, size_t ws_size, hipStream_t stream) {
    static int grid = 0;
    if (grid == 0) {
        if (n_in != 31 || out_size != MT * D || ws_size < WS_END) { fprintf(stderr, "kernel_launch: unexpected shapes (n_in %d, out %d, ws %zu); nothing launched\n", n_in, out_size, ws_size); grid = -1; return; }
        int dev = 0, cus = 0, per_cu = 0;
        if (hipGetDevice(&dev) != hipSuccess || hipDeviceGetAttribute(&cus, hipDeviceAttributeMultiprocessorCount, dev) != hipSuccess) { grid = -1; return; }
        if (hipFuncSetAttribute((const void*)fwd, hipFuncAttributeMaxDynamicSharedMemorySize, LDS_BYTES) != hipSuccess) { fprintf(stderr, "kernel_launch: hipFuncSetAttribute failed\n"); grid = -1; return; }
        if (hipOccupancyMaxActiveBlocksPerMultiprocessor(&per_cu, (const void*)fwd, NTHR, LDS_BYTES) != hipSuccess || per_cu < 1) fprintf(stderr, "kernel_launch: occupancy query reports %d\n", per_cu);
        (void)hipGetLastError();
        grid = cus;
        if (grid < 256) { fprintf(stderr, "kernel_launch: this kernel needs >= 256 CUs (got %d); nothing launched\n", cus); grid = -1; return; }
    }
    if (grid < 0) return;
    (void)hipMemsetAsync((char*)d_ws + WS_CTL, 0, CTL_ZERO_BYTES, stream);
    Args a{};
    for (int i = 0; i < 31; ++i) a.in[i] = (const float*)d_in[i];
    a.out = (float*)d_out; a.ws = (unsigned char*)d_ws;
#if MK_ONE_LAUNCH
    a.ph_lo = 0; a.ph_hi = 16;
    hipLaunchKernelGGL(fwd, dim3(grid), dim3(NTHR), LDS_BYTES, stream, a);
#else
    for (int p = 0; p < 16; ++p) { a.ph_lo = p; a.ph_hi = p + 1; hipLaunchKernelGGL(fwd, dim3(grid), dim3(NTHR), LDS_BYTES, stream, a); }
#endif
}
```

```cpp
#include <hip/hip_runtime.h>
#include <cstdio>
#include <cstdint>

#ifndef PROBE_REP
#define PROBE_REP 0
#endif
#define REPS(k) (((PROBE_REP >> (k)) & 1) ? 2 : 1)
#ifndef PROBE_DUP
#define PROBE_DUP 0
#endif
#define DUP(k) ((PROBE_DUP >> (k)) & 1)
#ifndef MK_ONE_LAUNCH
#define MK_ONE_LAUNCH 1
#endif

namespace pg8 {
#define PG8_LAS __attribute__((address_space(3)))
typedef unsigned short bf16_t;
typedef short bf16x8 __attribute__((ext_vector_type(8)));
typedef float f32x4 __attribute__((ext_vector_type(4)));
typedef unsigned u32x4 __attribute__((ext_vector_type(4)));
typedef unsigned u32x2 __attribute__((ext_vector_type(2)));
constexpr int BM = 256, BK = 64, HALF = 128, HTB = HALF * BK * 2, STAGE_BYTES = 8 * HTB, NXCD = 8, WGM = 8;

__host__ __device__ __forceinline__ int lds_byte(int r, int c) { const int st = (r >> 4) * 2 + (c >> 5), rr = r & 15, cc = c & 31, ob = rr * 64 + cc * 2; return st * 1024 + (ob ^ (((ob >> 9) & 1) << 5)); }
__host__ __device__ __forceinline__ void stage_rc(int b, int& R, int& C) { const int st = b / 1024, sb = b % 1024, swz = sb ^ (((sb >> 9) & 1) << 5); R = (st >> 1) * 16 + swz / 64; C = (st & 1) * 32 + (swz % 64) / 2; }
__host__ __device__ __forceinline__ int perm32(int rho) { const int n = rho >> 4, i = rho & 15; return 8 * (i >> 2) + 4 * n + (i & 3); }

struct Unit { int pm, pn; };
struct Gemm { const bf16_t* A; const bf16_t* Bt; int M, N, K, lda; int pmg; size_t bgs; };

struct StaticOrder {
    int nM, nN, nwg, G, c;
    __host__ __device__ void init(int M, int N, int G_, int c_) { nM = M / BM; nN = N / BM; nwg = nM * nN; G = G_; c = c_; }
    __host__ __device__ bool next(int i, Unit& u) const {
        const long L = (long)i * G + c; if (L >= nwg) return false;
        int wgid = (int)L; { const int q = nwg / NXCD, r = nwg % NXCD, xcd = wgid % NXCD, off = wgid / NXCD; wgid = (xcd < r ? xcd * (q + 1) : r * (q + 1) + (xcd - r) * q) + off; }
        const int nig = WGM * nN, gid = wgid / nig, fm = gid * WGM, gsz = (nM - fm) < WGM ? (nM - fm) : WGM;
        u.pm = fm + ((wgid % nig) % gsz); u.pn = (wgid % nig) / gsz; return true;
    }
    __device__ __forceinline__ void a_ready(const Unit&) const {}
    __device__ __forceinline__ void done(const Unit&) const {}
};

typedef __bf16 bf16x2_t __attribute__((ext_vector_type(2)));
typedef float f32x2_t __attribute__((ext_vector_type(2)));
__device__ __forceinline__ unsigned cvt_pk_bf16(float lo, float hi) { const f32x2_t v = {lo, hi}; const bf16x2_t b = __builtin_convertvector(v, bf16x2_t); return __builtin_bit_cast(unsigned, b); }
__device__ __forceinline__ float bf_lo(unsigned w) { return __uint_as_float(w << 16); }
__device__ __forceinline__ float bf_hi(unsigned w) { return __uint_as_float(w & 0xffff0000u); }
__device__ __forceinline__ float sigmoidf_(float x) { return __builtin_amdgcn_rcpf(1.0f + __expf(-x)); }

struct EpiBf16 {
    static constexpr bool PERM = true;
    bf16_t* O; int ldc;
    __device__ __forceinline__ void operator()(const f32x4 (&acc)[2][2][4][2], const Unit& u, int wr, int wc, int fr, int fq) const {
        const int row0 = u.pm * BM + wr * 64 + fr, col0 = u.pn * BM + wc * 32 + 8 * fq;
#pragma unroll
        for (int ai = 0; ai < 2; ++ai)
#pragma unroll
            for (int m = 0; m < 4; ++m) { bf16_t* rowp = O + (size_t)(row0 + ai * HALF + m * 16) * ldc + col0;
#pragma unroll
                for (int bj = 0; bj < 2; ++bj) { const f32x4 v0 = acc[ai][bj][m][0], v1 = acc[ai][bj][m][1];
                    u32x4 w; w.x = cvt_pk_bf16(v0[0], v0[1]); w.y = cvt_pk_bf16(v0[2], v0[3]); w.z = cvt_pk_bf16(v1[0], v1[1]); w.w = cvt_pk_bf16(v1[2], v1[3]);
                    *(u32x4*)(rowp + bj * HALF) = w; } }
    }
};
template <int MODE> struct EpiGate {
    static constexpr bool PERM = true;
    bf16_t* O; int ldc; const bf16_t* G; int ldg;
    __device__ __forceinline__ void operator()(const f32x4 (&acc)[2][2][4][2], const Unit& u, int wr, int wc, int fr, int fq) const {
        const int row0 = u.pm * BM + wr * 64 + fr, col0 = u.pn * BM + wc * 32 + 8 * fq;
#pragma unroll
        for (int ai = 0; ai < 2; ++ai)
#pragma unroll
            for (int m = 0; m < 4; ++m) { const size_t row = (size_t)(row0 + ai * HALF + m * 16);
#pragma unroll
                for (int bj = 0; bj < 2; ++bj) { const f32x4 v0 = acc[ai][bj][m][0], v1 = acc[ai][bj][m][1];
                    const u32x4 gz = *(const u32x4*)(G + row * ldg + col0 + bj * HALF);
                    float o[8];
                    o[0] = sigmoidf_(bf_lo(gz.x)) * v0[0]; o[1] = sigmoidf_(bf_hi(gz.x)) * v0[1]; o[2] = sigmoidf_(bf_lo(gz.y)) * v0[2]; o[3] = sigmoidf_(bf_hi(gz.y)) * v0[3];
                    o[4] = sigmoidf_(bf_lo(gz.z)) * v1[0]; o[5] = sigmoidf_(bf_hi(gz.z)) * v1[1]; o[6] = sigmoidf_(bf_lo(gz.w)) * v1[2]; o[7] = sigmoidf_(bf_hi(gz.w)) * v1[3];
                    bf16_t* op = O + row * ldc + col0 + bj * HALF;
                    if (MODE == 1) { const u32x4 pz = *(const u32x4*)op;
                        o[0] += bf_lo(pz.x); o[1] += bf_hi(pz.x); o[2] += bf_lo(pz.y); o[3] += bf_hi(pz.y); o[4] += bf_lo(pz.z); o[5] += bf_hi(pz.z); o[6] += bf_lo(pz.w); o[7] += bf_hi(pz.w); }
                    u32x4 w; w.x = cvt_pk_bf16(o[0], o[1]); w.y = cvt_pk_bf16(o[2], o[3]); w.z = cvt_pk_bf16(o[4], o[5]); w.w = cvt_pk_bf16(o[6], o[7]);
                    *(u32x4*)op = w; } }
    }
};
struct EpiResid {
    static constexpr bool PERM = false;
    float* O; const float* X; const float* gt; int gt_pitch; int rows_per_b; float alpha;
    __device__ __forceinline__ void operator()(const f32x4 (&acc)[2][2][4][2], const Unit& u, int wr, int wc, int fr, int fq) const {
        const int row0 = u.pm * BM + wr * 64 + fr, col0 = u.pn * BM + wc * 32 + 4 * fq;
        const float* gtb = gt + (size_t)((u.pm * BM) / rows_per_b) * gt_pitch + col0;
        f32x4 gv[2][2];
#pragma unroll
        for (int bj = 0; bj < 2; ++bj)
#pragma unroll
            for (int n = 0; n < 2; ++n) gv[bj][n] = *(const f32x4*)(gtb + bj * HALF + n * 16);
#pragma unroll
        for (int ai = 0; ai < 2; ++ai)
#pragma unroll
            for (int m = 0; m < 4; ++m) { const size_t off = (size_t)(row0 + ai * HALF + m * 16) * 1024 + col0;
#pragma unroll
                for (int bj = 0; bj < 2; ++bj)
#pragma unroll
                    for (int n = 0; n < 2; ++n) { const f32x4 xv = *(const f32x4*)(X + off + bj * HALF + n * 16);
                        *(f32x4*)(O + off + bj * HALF + n * 16) = xv * alpha + gv[bj][n] * acc[ai][bj][m][n]; } }
    }
};
struct EpiSwiglu {
    static constexpr bool PERM = true;
    unsigned char* H; int ldh; float as, hs;
    __device__ __forceinline__ void operator()(const f32x4 (&acc)[2][2][4][2], const Unit& u, int wr, int wc, int fr, int fq) const {
        const int row0 = u.pm * BM + wr * 64 + fr, col0 = u.pn * HALF + wc * 32 + 8 * fq;
#pragma unroll
        for (int ai = 0; ai < 2; ++ai)
#pragma unroll
            for (int m = 0; m < 4; ++m) { unsigned char* rowp = H + (size_t)(row0 + ai * HALF + m * 16) * ldh + col0;
                float o[8];
#pragma unroll
                for (int n = 0; n < 2; ++n)
#pragma unroll
                    for (int j = 0; j < 4; ++j) { const float a = acc[ai][0][m][n][j] * as, b = acc[ai][1][m][n][j] * as; o[n * 4 + j] = fminf(fmaxf(a * sigmoidf_(a) * b * hs, -448.f), 448.f); }
                u32x2 w; w.x = (unsigned)__builtin_amdgcn_cvt_pk_fp8_f32(o[2], o[3], __builtin_amdgcn_cvt_pk_fp8_f32(o[0], o[1], 0, false), true);
                w.y = (unsigned)__builtin_amdgcn_cvt_pk_fp8_f32(o[6], o[7], __builtin_amdgcn_cvt_pk_fp8_f32(o[4], o[5], 0, false), true);
                *(u32x2*)rowp = w; }
    }
};
struct EpiScaleRow {
    static constexpr bool PERM = true;
    bf16_t* O; int ldc; const float* gate; float sc;
    __device__ __forceinline__ void operator()(const f32x4 (&acc)[2][2][4][2], const Unit& u, int wr, int wc, int fr, int fq) const {
        const int row0 = u.pm * BM + wr * 64 + fr, col0 = u.pn * BM + wc * 32 + 8 * fq;
#pragma unroll
        for (int ai = 0; ai < 2; ++ai)
#pragma unroll
            for (int m = 0; m < 4; ++m) { const int row = row0 + ai * HALF + m * 16; const float gsc = gate[row] * sc; bf16_t* rowp = O + (size_t)row * ldc + col0;
#pragma unroll
                for (int bj = 0; bj < 2; ++bj) { const f32x4 v0 = acc[ai][bj][m][0] * gsc, v1 = acc[ai][bj][m][1] * gsc;
                    u32x4 w; w.x = cvt_pk_bf16(v0[0], v0[1]); w.y = cvt_pk_bf16(v0[2], v0[3]); w.z = cvt_pk_bf16(v1[0], v1[1]); w.w = cvt_pk_bf16(v1[2], v1[3]);
                    *(u32x4*)(rowp + bj * HALF) = w; } }
    }
};

typedef int v8i_t __attribute__((ext_vector_type(8)));
typedef int v4i_t __attribute__((ext_vector_type(4)));
template <class Epi, class Sched, bool ALIGN_EPI = false, bool SP2 = false, bool FP8 = false>
__device__ __forceinline__ void gemm_phase(PG8_LAS unsigned char* lds, const Gemm g, const Sched& S, const Epi& E) {
    const int tid = threadIdx.x, wid = __builtin_amdgcn_readfirstlane(tid >> 6), lane = tid & 63, wr = wid >> 2, wc = wid & 3, fr = lane & 15, fq = lane >> 4;
    const int K = g.K, nt = K / BK;
    unsigned voffA[2], voffB[2];
#pragma unroll
    for (int i = 0; i < 2; ++i) { int R, C; stage_rc(tid * 16 + i * 8192, R, C); const int Rb = Epi::PERM ? ((R & ~31) + perm32(R & 31)) : R;
        voffA[i] = (unsigned)(R * g.lda + C) * 2u; voffB[i] = (unsigned)(Rb * K + C) * 2u; }
    const size_t kstep = (size_t)(BK * 2);
    const size_t hstepA = (size_t)HALF * g.lda * 2, tstepA = 2 * hstepA;
    const size_t hstepB = (size_t)HALF * K * 2, tstepB = 2 * hstepB;
    const unsigned ldsw = (unsigned)wid * 1024u;
    const int aoff = lds_byte(wr * 64 + fr, fq * 8), boff = lds_byte(wc * 32 + fr, fq * 8);
#define PG8_SA(b, h) (((b) * 2 + (h)) * HTB)
#define PG8_SB(b, h) ((4 + (b) * 2 + (h)) * HTB)
#define PG8_STAGE(bufoff, gbase, voff) do { _Pragma("unroll") for (int _i = 0; _i < 2; ++_i) \
        __builtin_amdgcn_global_load_lds((const unsigned*)((const char*)(gbase) + (voff)[_i]), (PG8_LAS unsigned*)(lds + (bufoff) + ldsw + _i * 8192), 16, 0, 0); } while (0)
#define PG8_LDA(dst, b, h) do { if constexpr (FP8) { _Pragma("unroll") for (int m = 0; m < 4; ++m) dst##8[m] = __builtin_shufflevector(*(const PG8_LAS v4i_t*)(lds + PG8_SA(b, h) + aoff + m * 2048), *(const PG8_LAS v4i_t*)(lds + PG8_SA(b, h) + aoff + m * 2048 + 1024), 0, 1, 2, 3, 4, 5, 6, 7); } \
    else { _Pragma("unroll") for (int m = 0; m < 4; ++m) _Pragma("unroll") for (int k = 0; k < 2; ++k) dst[m][k] = *(const PG8_LAS bf16x8*)(lds + PG8_SA(b, h) + aoff + m * 2048 + k * 1024); } } while (0)
#define PG8_LDB(dst, b, h) do { if constexpr (FP8) { _Pragma("unroll") for (int n = 0; n < 2; ++n) dst##8[n] = __builtin_shufflevector(*(const PG8_LAS v4i_t*)(lds + PG8_SB(b, h) + boff + n * 2048), *(const PG8_LAS v4i_t*)(lds + PG8_SB(b, h) + boff + n * 2048 + 1024), 0, 1, 2, 3, 4, 5, 6, 7); } \
    else { _Pragma("unroll") for (int n = 0; n < 2; ++n) _Pragma("unroll") for (int k = 0; k < 2; ++k) dst[n][k] = *(const PG8_LAS bf16x8*)(lds + PG8_SB(b, h) + boff + n * 2048 + k * 1024); } } while (0)
#define PG8_MMA(ai, bj, At, Bt) do { __builtin_amdgcn_s_setprio(1); _Pragma("unroll") for (int m = 0; m < 4; ++m) _Pragma("unroll") for (int n = 0; n < 2; ++n) { \
        if constexpr (FP8) { asm volatile("v_mfma_scale_f32_16x16x128_f8f6f4 %0, %1, %2, %0, %3, %3 op_sel_hi:[0,0,0]" : "+v"(acc[ai][bj][m][n]) : "v"(Bt##8[n]), "v"(At##8[m]), "v"(sc1)); } \
        else { _Pragma("unroll") for (int k = 0; k < 2; ++k) acc[ai][bj][m][n] = __builtin_amdgcn_mfma_f32_16x16x32_bf16(Bt[n][k], At[m][k], acc[ai][bj][m][n], 0, 0, 0); } } \
        __builtin_amdgcn_s_setprio(0); } while (0)
#define PG8_WAIT_V(n) asm volatile("s_waitcnt vmcnt(" #n ")" ::: "memory")
#define PG8_WAIT_L(n) asm volatile("s_waitcnt lgkmcnt(" #n ")" ::: "memory")
#define PG8_BAR __builtin_amdgcn_s_barrier()
#define PG8_SCHED __builtin_amdgcn_sched_barrier(0)
    Unit cur, nxt; int ui = 0;
    if (!S.next(0, cur)) return;
    f32x4 acc[2][2][4][2];
#pragma unroll
    for (int a = 0; a < 2; ++a)
#pragma unroll
        for (int b = 0; b < 2; ++b)
#pragma unroll
            for (int m = 0; m < 4; ++m)
#pragma unroll
                for (int n = 0; n < 2; ++n) acc[a][b][m][n] = (f32x4){0.f, 0.f, 0.f, 0.f};
    bf16x8 At[4][2], B0[2][2], B1[2][2]; v8i_t At8[4], B08[2], B18[2]; const int sc1 = 0x7f7f7f7f;
    const char* cA = (const char*)g.A + (size_t)cur.pm * tstepA; const char* cB = (const char*)g.Bt + (size_t)cur.pn * tstepB + (size_t)(cur.pm / g.pmg) * g.bgs;
    S.a_ready(cur);
    if constexpr (SP2) {
        PG8_STAGE(PG8_SB(0, 0), cB, voffB); PG8_STAGE(PG8_SB(0, 1), cB + hstepB, voffB); PG8_STAGE(PG8_SA(0, 0), cA, voffA); PG8_STAGE(PG8_SA(0, 1), cA + hstepA, voffA);
        if (wr == 1) PG8_BAR;
        PG8_WAIT_V(2); PG8_BAR;
        PG8_STAGE(PG8_SB(1, 0), cB + kstep, voffB); PG8_STAGE(PG8_SA(1, 0), cA + kstep, voffA); PG8_STAGE(PG8_SB(1, 1), cB + hstepB + kstep, voffB);
        PG8_WAIT_V(6); PG8_BAR;
    } else {
        PG8_STAGE(PG8_SB(0, 0), cB, voffB); PG8_STAGE(PG8_SA(0, 0), cA, voffA); PG8_STAGE(PG8_SB(0, 1), cB + hstepB, voffB); PG8_STAGE(PG8_SA(0, 1), cA + hstepA, voffA);
        if (wr == 1) PG8_BAR;
        PG8_WAIT_V(4); PG8_BAR;
        PG8_STAGE(PG8_SB(1, 0), cB + kstep, voffB); PG8_STAGE(PG8_SA(1, 0), cA + kstep, voffA); PG8_STAGE(PG8_SB(1, 1), cB + hstepB + kstep, voffB);
        PG8_WAIT_V(6); PG8_BAR;
    }
    for (;;) {
        const bool has_next = S.next(ui + 1, nxt);
        const char* nA = has_next ? (const char*)g.A + (size_t)nxt.pm * tstepA : cA;
        const char* nB = has_next ? (const char*)g.Bt + (size_t)nxt.pn * tstepB + (size_t)(nxt.pm / g.pmg) * g.bgs : cB;
        for (int t = 0; t < nt; t += 2) {
            const bool last = (t == nt - 2);
            const char* a1 = cA + (size_t)(t + 1) * kstep;
            const char* a2 = last ? nA : cA + (size_t)(t + 2) * kstep; const char* b2 = last ? nB : cB + (size_t)(t + 2) * kstep;
            const char* a3 = a2 + kstep; const char* b3 = b2 + kstep;
            if (last && has_next) S.a_ready(nxt);
            if constexpr (SP2) {
            PG8_LDB(B0, 0, 0); PG8_LDB(B1, 0, 1); PG8_SCHED; PG8_LDA(At, 0, 0); PG8_STAGE(PG8_SA(1, 1), a1 + hstepA, voffA);
            PG8_WAIT_V(8); PG8_WAIT_L(0); PG8_BAR; PG8_MMA(0, 0, At, B0); PG8_MMA(0, 1, At, B1); PG8_BAR; PG8_SCHED;
            PG8_LDA(At, 0, 1); PG8_STAGE(PG8_SB(0, 0), b2, voffB); PG8_STAGE(PG8_SB(0, 1), b2 + hstepB, voffB); PG8_STAGE(PG8_SA(0, 0), a2, voffA);
            PG8_WAIT_V(8); PG8_WAIT_L(0); PG8_BAR; PG8_MMA(1, 0, At, B0); PG8_MMA(1, 1, At, B1); PG8_BAR; PG8_SCHED;
            PG8_LDB(B0, 1, 0); PG8_LDB(B1, 1, 1); PG8_SCHED; PG8_LDA(At, 1, 0); PG8_STAGE(PG8_SA(0, 1), a2 + hstepA, voffA);
            PG8_WAIT_V(8); PG8_WAIT_L(0); PG8_BAR; PG8_MMA(0, 0, At, B0); PG8_MMA(0, 1, At, B1); PG8_BAR; PG8_SCHED;
            PG8_LDA(At, 1, 1); PG8_STAGE(PG8_SB(1, 0), b3, voffB); PG8_STAGE(PG8_SB(1, 1), b3 + hstepB, voffB); PG8_STAGE(PG8_SA(1, 0), a3, voffA);
            PG8_WAIT_V(8); PG8_WAIT_L(0); PG8_BAR; PG8_MMA(1, 0, At, B0); PG8_MMA(1, 1, At, B1); PG8_BAR; PG8_SCHED;
            } else {
            PG8_LDB(B0, 0, 0); PG8_SCHED; PG8_LDA(At, 0, 0); PG8_STAGE(PG8_SA(1, 1), a1 + hstepA, voffA);
            PG8_WAIT_L(8); PG8_BAR; PG8_WAIT_L(0); PG8_MMA(0, 0, At, B0); PG8_BAR; PG8_SCHED;
            PG8_LDB(B1, 0, 1); PG8_STAGE(PG8_SB(0, 0), b2, voffB);
            PG8_BAR; PG8_WAIT_L(0); PG8_MMA(0, 1, At, B1); PG8_BAR;
            PG8_LDA(At, 0, 1); PG8_STAGE(PG8_SA(0, 0), a2, voffA);
            PG8_BAR; PG8_WAIT_L(0); PG8_MMA(1, 0, At, B0); PG8_BAR; PG8_SCHED;
            PG8_STAGE(PG8_SB(0, 1), b2 + hstepB, voffB);
            PG8_WAIT_V(6); PG8_BAR; PG8_MMA(1, 1, At, B1); PG8_BAR;
            PG8_LDB(B0, 1, 0); PG8_SCHED; PG8_LDA(At, 1, 0); PG8_STAGE(PG8_SA(0, 1), a2 + hstepA, voffA);
            PG8_WAIT_L(8); PG8_BAR; PG8_WAIT_L(0); PG8_MMA(0, 0, At, B0); PG8_BAR; PG8_SCHED;
            PG8_LDB(B1, 1, 1); PG8_STAGE(PG8_SB(1, 0), b3, voffB);
            PG8_BAR; PG8_WAIT_L(0); PG8_MMA(0, 1, At, B1); PG8_BAR;
            PG8_LDA(At, 1, 1); PG8_STAGE(PG8_SA(1, 0), a3, voffA);
            PG8_BAR; PG8_WAIT_L(0); PG8_MMA(1, 0, At, B0); PG8_BAR; PG8_SCHED;
            PG8_STAGE(PG8_SB(1, 1), b3 + hstepB, voffB);
            PG8_WAIT_V(6); PG8_BAR; PG8_MMA(1, 1, At, B1); PG8_BAR;
            }
        }
        if constexpr (ALIGN_EPI) { if (wr == 0) PG8_BAR; }
        if constexpr (FP8) asm volatile("s_nop 15\n\ts_nop 15" ::: "memory");
        E(acc, cur, wr, wc, fr, fq); S.done(cur);
        if (!has_next) break;
#pragma unroll
        for (int a = 0; a < 2; ++a)
#pragma unroll
            for (int b = 0; b < 2; ++b)
#pragma unroll
                for (int m = 0; m < 4; ++m)
#pragma unroll
                    for (int n = 0; n < 2; ++n) acc[a][b][m][n] = (f32x4){0.f, 0.f, 0.f, 0.f};
        cur = nxt; cA = nA; cB = nB; ++ui;
        if constexpr (FP8) asm volatile("s_nop 7" ::: "memory");
        if constexpr (ALIGN_EPI) { if (wr == 1) PG8_BAR; }
    }
    PG8_WAIT_V(0);
    if constexpr (!ALIGN_EPI) { if (wr == 0) PG8_BAR; }
    PG8_BAR;
#undef PG8_SA
#undef PG8_SB
#undef PG8_STAGE
#undef PG8_LDA
#undef PG8_LDB
#undef PG8_MMA
#undef PG8_WAIT_V
#undef PG8_WAIT_L
#undef PG8_BAR
#undef PG8_SCHED
}
}

constexpr int NWAVES = 8, NTHR = 512;
constexpr int NB = 4, T = 8192, D = 1024, LC = 256, GW = 64, GH = 128;
constexpr int MT = NB * T, MC = NB * LC, MA = MT + MC;
constexpr int PIN = 5504, PINP = 5632;
constexpr int ZQ = 0, ZK = 512, ZV = 1024, ZRW = 1536, ZR = 1536, ZRK = 2048, ZRV = 2560, ZLORA = 3072, ZG = 3456, ZGNA = 3456, ZGRW = 4480;
constexpr int NE = 16, CAP = 1024, DE = 2816, NSLOT = NB * NE * CAP;
constexpr float ALPHA = 1.189207115f;
constexpr float LN_EPS = 1e-6f, GN_EPS = 64e-5f;
constexpr int LORAW = 2560;

constexpr size_t MiB = 1u << 20;
constexpr size_t WS_CTL = 0, CTL_ZERO_BYTES = 1 * MiB;
constexpr size_t WS_MOD = 1 * MiB;
constexpr size_t WS_WIN = 2 * MiB;
constexpr size_t WS_WPA = 13 * MiB, WS_WPR = 14 * MiB, WS_WO = 15 * MiB;
constexpr size_t WS_AFF = 17 * MiB;
constexpr size_t WS_IDX = 19 * MiB;
constexpr size_t WS_GATEV = 19 * MiB + 256 * 1024;
constexpr size_t WS_SLOT = 20 * MiB;
constexpr size_t WS_U = 22 * MiB;
constexpr size_t WS_Z = 88 * MiB;
constexpr size_t WS_LORA = 451 * MiB;
constexpr size_t WS_ROPE = 1 * MiB + 128 * 1024;
constexpr size_t WS_LW = 1 * MiB + 512 * 1024;
constexpr size_t WS_COEF = 17 * MiB;
constexpr size_t WS_YFB = 22 * MiB;
constexpr size_t WS_PQ = 451 * MiB;
constexpr size_t WS_G = 583 * MiB;
constexpr size_t WS_VT = 616 * MiB;
constexpr size_t WS_END1 = 616 * MiB;
constexpr size_t WS_U2 = 22 * MiB;
constexpr size_t WS_W13 = 54 * MiB;
constexpr size_t WS_W2 = 654 * MiB;
constexpr size_t WS_XS = 186 * MiB;
constexpr size_t WS_HDN = 250 * MiB;
constexpr size_t WS_YE = 426 * MiB;
constexpr float W13_SCALE = 64.f, W2_SCALE = 128.f, HDN_SCALE = 8.f;
constexpr size_t WS_END = 698 * MiB;
constexpr int W2_EARLY_TILES = 256 * 12;
static_assert(WS_VT + (size_t)34 * MiB <= WS_END, "ws map");
constexpr size_t VT_LAT_ELEMS = (size_t)NB * 8 * 64 * T, VT_CTX_ELEMS = (size_t)NB * 8 * 64 * LC;

constexpr int RING_BYTES = 131072, LDS_BYTES = 147456, LDSCTL_OFF = LDS_BYTES - 512, MISC_OFF = LDSCTL_OFF + 320;

#define GAS __attribute__((address_space(1)))
#define LAS __attribute__((address_space(3)))
typedef unsigned short bf16;
typedef unsigned v4u __attribute__((ext_vector_type(4)));
typedef unsigned v2u __attribute__((ext_vector_type(2)));
typedef float f32x4 __attribute__((ext_vector_type(4)));
typedef float f32x2 __attribute__((ext_vector_type(2)));
typedef short bf16x8 __attribute__((ext_vector_type(8)));
typedef short bf16x4 __attribute__((ext_vector_type(4)));
typedef GAS unsigned gu32;
#define RLX_AGENT __ATOMIC_RELAXED, __HIP_MEMORY_SCOPE_AGENT
#define LDS_WAIT() asm volatile("s_waitcnt lgkmcnt(0)" ::: "memory")
#define VM_WAIT() asm volatile("s_waitcnt vmcnt(0)" ::: "memory")
__device__ __forceinline__ unsigned f2bf(float f) { return pg8::cvt_pk_bf16(f, f) & 0xffffu; }
__device__ __forceinline__ unsigned pk2(float lo, float hi) { return pg8::cvt_pk_bf16(lo, hi); }
__device__ __forceinline__ float bf2f(bf16 b) { return __uint_as_float(((unsigned)b) << 16); }
__device__ __forceinline__ float bflo(unsigned w) { return __uint_as_float(w << 16); }
__device__ __forceinline__ float bfhi(unsigned w) { return __uint_as_float(w & 0xffff0000u); }
__device__ __forceinline__ float sigm(float x) { return __builtin_amdgcn_rcpf(1.0f + __expf(-x)); }

#define XB_TMO      128
#define XB_XCNT(j)  (256  + 64 * (j))
#define XB_XSUB(j)  (1280 + 64 * (j))
#define XB_XGEN(j)  (2304 + 64 * (j))
#define XB_TOP      3328
#define XB_TOPGEN   3392
#define XCD_BAR_WORDS 3456
#define XB_SPIN_CAP (1u << 18)
__device__ __forceinline__ unsigned xb_ld(unsigned* p)              { return __hip_atomic_load(p, __ATOMIC_RELAXED, __HIP_MEMORY_SCOPE_AGENT); }
__device__ __forceinline__ unsigned xb_add(unsigned* p, unsigned v) { return __hip_atomic_fetch_add(p, v, __ATOMIC_RELAXED, __HIP_MEMORY_SCOPE_AGENT); }
__device__ __forceinline__ unsigned xb_xcc_id() { return (unsigned)__builtin_amdgcn_s_getreg((3 << 11) | 20) & 0xFu; }
#define XB_SPIN(cond, bar) do { unsigned _sp = 0; while (cond) { __builtin_amdgcn_s_sleep(1); \
    if ((++_sp & 255u) == 0u) { if (xb_ld(&(bar)[XB_TMO])) break; if (_sp > XB_SPIN_CAP) { atomicAdd(&(bar)[XB_TMO], 1u); break; } } } } while (0)
struct XcdBarrier { unsigned* bar; unsigned x; volatile LAS unsigned* st; };
__device__ __forceinline__ XcdBarrier xcd_barrier_post(unsigned* bar, volatile LAS unsigned* st) {
    XcdBarrier b; b.bar = bar; b.x = xb_xcc_id(); b.st = st;
    if (threadIdx.x == 0) (void)xb_add(&bar[XB_XCNT(b.x)], 1u);
    return b;
}
__device__ __forceinline__ void xcd_barrier_complete(unsigned* bar, unsigned x, unsigned& nloc, unsigned& nx) {
    const unsigned G = gridDim.x * gridDim.y * gridDim.z;
    unsigned sum, cnt, mine, sp = 0u;
    for (;;) {
        sum = 0u; cnt = 0u; mine = 0u;
#pragma unroll
        for (unsigned j = 0; j < 16; ++j) { const unsigned c = xb_ld(&bar[XB_XCNT(j)]); sum += c; cnt += (c > 0u) ? 1u : 0u; mine = (j == x) ? c : mine; }
        if (sum == G) break;
        __builtin_amdgcn_s_sleep(1);
        if ((++sp & 255u) == 0u) { if (xb_ld(&bar[XB_TMO])) break; if (sp > XB_SPIN_CAP) { atomicAdd(&bar[XB_TMO], 1u); break; } }
    }
    nloc = mine > 0u ? mine : 1u; nx = cnt > 0u ? cnt : 1u;
}
__device__ __forceinline__ void xcd_barrier(const XcdBarrier& b) {
    asm volatile("s_waitcnt vmcnt(0)" ::: "memory");
    __syncthreads();
    if (threadIdx.x == 0) {
        unsigned* bar = b.bar;
        __builtin_amdgcn_s_waitcnt(0);
        unsigned nloc = b.st[0], nx = b.st[1];
        if (nloc == 0u) { xcd_barrier_complete(bar, b.x, nloc, nx); b.st[0] = nloc; b.st[1] = nx; }
        const unsigned old = xb_add(&bar[XB_XSUB(b.x)], 1u);
        const unsigned gen = old / nloc;
        if (old + 1u == (gen + 1u) * nloc) {
            __builtin_amdgcn_fence(__ATOMIC_RELEASE, "agent");
            asm volatile("s_waitcnt vmcnt(0)" ::: "memory");
#pragma unroll
            for (unsigned j = 0; j < 16; ++j) (void)xb_add(&bar[XB_XGEN(j)], 1u);
        }
        const unsigned target = (gen + 1u) * nx;
        XB_SPIN(xb_ld(&bar[XB_XGEN(b.x)]) < target, bar);
        __builtin_amdgcn_fence(__ATOMIC_ACQUIRE, "agent");
        asm volatile("s_waitcnt vmcnt(0)" ::: "memory");
    }
    __syncthreads();
}
constexpr int CW_BAR = 4096;

template <int CTRL> __device__ __forceinline__ float dppf(float v) { return __builtin_bit_cast(float, __builtin_amdgcn_update_dpp(0, __builtin_bit_cast(int, v), CTRL, 0xF, 0xF, true)); }
__device__ __forceinline__ float row16_sum(float v) {
    v += dppf<0xB1>(v);
    v += dppf<0x4E>(v);
    v += dppf<0x141>(v);
    v += dppf<0x140>(v);
    return v;
}

__device__ __forceinline__ float wave_sum(float v) { v = row16_sum(v); v += __shfl_xor(v, 16); v += __shfl_xor(v, 32); return v; }

__device__ __forceinline__ void unpack8(v4u w, float (&o)[8]) { o[0] = bflo(w.x); o[1] = bfhi(w.x); o[2] = bflo(w.y); o[3] = bfhi(w.y); o[4] = bflo(w.z); o[5] = bfhi(w.z); o[6] = bflo(w.w); o[7] = bfhi(w.w); }
__device__ __forceinline__ v4u pack8(const float (&v)[8]) { v4u o; o.x = pg8::cvt_pk_bf16(v[0], v[1]); o.y = pg8::cvt_pk_bf16(v[2], v[3]); o.z = pg8::cvt_pk_bf16(v[4], v[5]); o.w = pg8::cvt_pk_bf16(v[6], v[7]); return o; }
struct Frame {
    LAS unsigned char* lds;
    int tid, lane, wave, G, bid;
    const float* in[31]; float* out; unsigned char* ws;
};

__device__ __forceinline__ void transpose_item(const float* W, int N, int k0, int n0, bf16* WT, size_t dst_row0, int dpitch, LAS float* scr, int lane) {
#pragma unroll 8
    for (int i = 0; i < 32; ++i) { const int kk = 2 * i + (lane >> 5); scr[kk * 33 + (lane & 31)] = W[(size_t)(k0 + kk) * N + n0 + (lane & 31)]; }
    LDS_WAIT(); asm volatile("" ::: "memory");
    const int c = lane & 7;
#pragma unroll
    for (int j = 0; j < 4; ++j) { const int n = (lane >> 3) + 8 * j; const LAS float* s = scr + (8 * c) * 33 + n;
        v4u o; o.x = pk2(s[0 * 33], s[1 * 33]); o.y = pk2(s[2 * 33], s[3 * 33]); o.z = pk2(s[4 * 33], s[5 * 33]); o.w = pk2(s[6 * 33], s[7 * 33]);
        *(GAS v4u*)(WT + (dst_row0 + n) * dpitch + k0 + 8 * c) = o; }
    LDS_WAIT(); asm volatile("" ::: "memory");
}

__device__ __forceinline__ void cvt_tile64(const float* W, int N, int k0, int n0, bf16* WT, size_t dst_row0, int dpitch, int lane) {
    const int c = lane & 15, kq = lane >> 4;
    const float* src = W + (size_t)(k0 + 16 * kq) * N + n0 + 4 * c;
    f32x4 x[16];
#pragma unroll
    for (int j = 0; j < 16; ++j) x[j] = __builtin_nontemporal_load((const GAS f32x4*)(src + (size_t)j * N));
#pragma unroll
    for (int e = 0; e < 4; ++e) { bf16* dst = WT + (dst_row0 + 4 * c + e) * dpitch + k0 + 16 * kq;
        v4u o0, o1;
        o0.x = pg8::cvt_pk_bf16(x[0][e], x[1][e]); o0.y = pg8::cvt_pk_bf16(x[2][e], x[3][e]); o0.z = pg8::cvt_pk_bf16(x[4][e], x[5][e]); o0.w = pg8::cvt_pk_bf16(x[6][e], x[7][e]);
        o1.x = pg8::cvt_pk_bf16(x[8][e], x[9][e]); o1.y = pg8::cvt_pk_bf16(x[10][e], x[11][e]); o1.z = pg8::cvt_pk_bf16(x[12][e], x[13][e]); o1.w = pg8::cvt_pk_bf16(x[14][e], x[15][e]);
        *(GAS v4u*)dst = o0; *(GAS v4u*)(dst + 8) = o1; }
}

__device__ __forceinline__ unsigned pk4_fp8(float a, float b, float c, float d) { int w = 0; w = __builtin_amdgcn_cvt_pk_fp8_f32(a, b, w, false); w = __builtin_amdgcn_cvt_pk_fp8_f32(c, d, w, true); return (unsigned)w; }
__device__ __forceinline__ float clamp448(float x) { return fminf(fmaxf(x, -448.f), 448.f); }
__device__ __forceinline__ void cvt_tile64_fp8(const float* W, int N, int k0, int n0, unsigned char* WT, size_t dst_row0, int dpitch, float scale, int lane) {
    const int c = lane & 15, kq = lane >> 4;
    const float* src = W + (size_t)(k0 + 16 * kq) * N + n0 + 4 * c;
    f32x4 x[16];
#pragma unroll
    for (int j = 0; j < 16; ++j) x[j] = __builtin_nontemporal_load((const GAS f32x4*)(src + (size_t)j * N)) * scale;
#pragma unroll
    for (int e = 0; e < 4; ++e) { unsigned char* dst = WT + (dst_row0 + 4 * c + e) * dpitch + k0 + 16 * kq;
        v4u o; o.x = pk4_fp8(x[0][e], x[1][e], x[2][e], x[3][e]); o.y = pk4_fp8(x[4][e], x[5][e], x[6][e], x[7][e]); o.z = pk4_fp8(x[8][e], x[9][e], x[10][e], x[11][e]); o.w = pk4_fp8(x[12][e], x[13][e], x[14][e], x[15][e]);
        *(GAS v4u*)dst = o; }
}

__device__ __forceinline__ void phase_prologue(Frame& F) {
    const float* c = F.in[1]; const float* cctx = F.in[3]; const float* w_mod = F.in[4]; const float* b_mod = F.in[5];
    float* MODV = (float*)(F.ws + WS_MOD);
    if (F.bid < 96) {
        LAS float* sil = (LAS float*)F.lds;
        LAS float* part = (LAS float*)(F.lds + 5 * 1024 * 4);
        for (int e = F.tid; e < 5 * 1024; e += NTHR) { const int r = e >> 10, k = e & 1023; const float v = (r < 4) ? c[r * 1024 + k] : cctx[k]; sil[e] = v * sigm(v); }
        __syncthreads();
        const int col = F.bid * 64 + F.lane;
        { const int kq = F.lane >> 4, c4 = (F.lane & 15) * 4; f32x4 a4[5];
#pragma unroll
          for (int r = 0; r < 5; ++r) a4[r] = (f32x4){0.f, 0.f, 0.f, 0.f};
#pragma unroll 8
          for (int it = 0; it < 32; ++it) { const int k = F.wave * 128 + it * 4 + kq; const f32x4 w = *(const GAS f32x4*)(w_mod + (size_t)k * 6144 + F.bid * 64 + c4);
#pragma unroll
              for (int r = 0; r < 5; ++r) a4[r] += w * sil[r * 1024 + k]; }
#pragma unroll
          for (int r = 0; r < 5; ++r) {
#pragma unroll
              for (int j = 0; j < 4; ++j) { float v = a4[r][j]; v += __shfl_xor(v, 16); v += __shfl_xor(v, 32); a4[r][j] = v; }
              if (kq == 0) *(LAS f32x4*)(part + (F.wave * 5 + r) * 64 + c4) = a4[r]; } }
        __syncthreads();
        if (F.wave < 5) { float s = b_mod[col];
#pragma unroll
            for (int w = 0; w < 8; ++w) s += part[(w * 5 + F.wave) * 64 + F.lane];
            MODV[F.wave * 6144 + col] = s; }
        __syncthreads();
    }
    const int gw = F.bid * NWAVES + F.wave, NGW = F.G * NWAVES;
    bf16* WinT = (bf16*)(F.ws + WS_WIN); bf16* WpaT = (bf16*)(F.ws + WS_WPA); bf16* WprT = (bf16*)(F.ws + WS_WPR); bf16* WoT = (bf16*)(F.ws + WS_WO);
    bf16* WupT = (bf16*)(F.ws + WS_LW); bf16* AupT = WupT + 2 * 512 * 64; bf16* GupT = AupT + 2 * 512 * 64;
    constexpr int I_IN = 16 * (PIN / 64), I_PA = 8 * 16, I_PR = 8 * 16, I_O = 16 * 16, I_LW = 16 + 16 + 16, I_ALL = I_IN + I_PA + I_PR + I_O + I_LW;
    for (int it = gw; it < I_ALL; it += NGW) {
        int r = it;
        if (r < I_IN) { const int nb = PIN / 64; cvt_tile64(F.in[6], PIN, 64 * (r / nb), 64 * (r % nb), WinT, (size_t)64 * (r % nb), 1024, F.lane); continue; } r -= I_IN;
        if (r < I_PA) { cvt_tile64(F.in[20], 1024, 64 * (r / 16), 64 * (r % 16), WpaT, (size_t)64 * (r % 16), 512, F.lane); continue; } r -= I_PA;
        if (r < I_PR) { cvt_tile64(F.in[21], 1024, 64 * (r / 16), 64 * (r % 16), WprT, (size_t)64 * (r % 16), 512, F.lane); continue; } r -= I_PR;
        if (r < I_O) { cvt_tile64(F.in[22], 1024, 64 * (r / 16), 64 * (r % 16), WoT, (size_t)64 * (r % 16), 1024, F.lane); continue; } r -= I_O;
        if (r < 16) { cvt_tile64(F.in[11] + (size_t)(r >> 3) * 64 * 512, 512, 0, 64 * (r & 7), WupT + (size_t)(r >> 3) * 512 * 64, (size_t)64 * (r & 7), 64, F.lane); continue; } r -= 16;
        if (r < 16) { cvt_tile64(F.in[13] + (size_t)(r >> 3) * 64 * 512, 512, 0, 64 * (r & 7), AupT + (size_t)(r >> 3) * 512 * 64, (size_t)64 * (r & 7), 64, F.lane); continue; } r -= 16;
        cvt_tile64(F.in[14], 512, 64 * (r >> 3), 64 * (r & 7), GupT, (size_t)64 * (r & 7), 128, F.lane);
    }
    { float* tab = (float*)(F.ws + WS_ROPE); const int i = F.bid * NTHR + F.tid;
      if (i < 128 * 16) { const float ang = (float)(i >> 4) * powf(10000.0f, -(float)(i & 15) / 16.0f); float sn, cs; sincosf(ang, &sn, &cs); tab[2 * i] = cs; tab[2 * i + 1] = sn; } }
    { GAS v4u* z = (GAS v4u*)(WinT + (size_t)PIN * 1024); const int n16 = (PINP - PIN) * 1024 * 2 / 16;
      for (int i = F.bid * NTHR + F.tid; i < n16; i += F.G * NTHR) z[i] = (v4u){0u, 0u, 0u, 0u}; }
}

__device__ __forceinline__ void phase_ln_mod(Frame& F) {
    const float* MODV = (const float*)(F.ws + WS_MOD);
    bf16* U = (bf16*)(F.ws + WS_U);
    const int gw = F.bid * NWAVES + F.wave, NGW = F.G * NWAVES;
    f32x4 nx[4];
    if (gw < MA) { const GAS f32x4* xr = (const GAS f32x4*)((gw < MT) ? F.in[0] + (size_t)gw * D : F.in[2] + (size_t)(gw - MT) * D) + F.lane;
#pragma unroll
        for (int j = 0; j < 4; ++j) nx[j] = xr[64 * j]; }
    for (int m = gw; m < MA; m += NGW) {
        const int mr = (m < MT) ? (m / T) : 4;
        const float* sh = MODV + mr * 6144; const float* sc = sh + 1024;
        f32x4 v[4]; float s = 0.f;
#pragma unroll
        for (int j = 0; j < 4; ++j) { v[j] = nx[j]; s += (v[j].x + v[j].y) + (v[j].z + v[j].w); }
        { const int mn = m + NGW; if (mn < MA) { const GAS f32x4* xr = (const GAS f32x4*)((mn < MT) ? F.in[0] + (size_t)mn * D : F.in[2] + (size_t)(mn - MT) * D) + F.lane;
#pragma unroll
            for (int j = 0; j < 4; ++j) nx[j] = xr[64 * j]; } }
        const float mean = wave_sum(s) * (1.f / D); float s2 = 0.f;
#pragma unroll
        for (int j = 0; j < 4; ++j) { v[j] = v[j] - mean; s2 += (v[j].x * v[j].x + v[j].y * v[j].y) + (v[j].z * v[j].z + v[j].w * v[j].w); }
        const float rstd = 1.f / sqrtf(wave_sum(s2) * (1.f / D) + LN_EPS);
        GAS unsigned long long* o8 = (GAS unsigned long long*)(U + (size_t)m * D) + F.lane;
#pragma unroll
        for (int j = 0; j < 4; ++j) { const f32x4 a = *((const f32x4*)sc + F.lane + 64 * j), b = *((const f32x4*)sh + F.lane + 64 * j);
            const f32x4 o = v[j] * rstd * (a + 1.0f) + b;
            o8[64 * j] = (unsigned long long)pk2(o.x, o.y) | ((unsigned long long)pk2(o.z, o.w) << 32); }
    }
}

__device__ __forceinline__ void phase_rope_vt(Frame& F) {
    bf16* Z = (bf16*)(F.ws + WS_Z);
    const int gw = F.bid * NWAVES + F.wave, NGW = F.G * NWAVES;
    {
        const int fh = F.lane & 1, a = (F.lane >> 1) & 1, h = (F.lane >> 2) & 7, w = F.lane >> 5;
        const float* tab = (const float*)(F.ws + WS_ROPE);
        for (int m = gw; m < MT; m += NGW) {
            const int t = m % T; const int pos = a ? (t % GW) : (t / GW);
            bf16* p1 = Z + (size_t)m * PINP + w * 512 + h * 64 + a * 32 + fh * 8;
            float x1[8], x2[8], o1[8], o2[8];
            unpack8(*(const GAS v4u*)p1, x1); unpack8(*(const GAS v4u*)(p1 + 16), x2);
            const f32x4* tp = (const f32x4*)(tab + (size_t)(pos * 16 + fh * 8) * 2);
#pragma unroll
            for (int j2 = 0; j2 < 4; ++j2) { const f32x4 cs2 = tp[j2];
                o1[2 * j2] = x1[2 * j2] * cs2.x - x2[2 * j2] * cs2.y; o2[2 * j2] = x2[2 * j2] * cs2.x + x1[2 * j2] * cs2.y;
                o1[2 * j2 + 1] = x1[2 * j2 + 1] * cs2.z - x2[2 * j2 + 1] * cs2.w; o2[2 * j2 + 1] = x2[2 * j2 + 1] * cs2.z + x1[2 * j2 + 1] * cs2.w; }
            *(GAS v4u*)p1 = pack8(o1); *(GAS v4u*)(p1 + 16) = pack8(o2);
        }
    }
    {
        bf16* VT = (bf16*)(F.ws + WS_VT); bf16* VTC = VT + VT_LAT_ELEMS;
        LAS bf16* scr = (LAS bf16*)(F.lds + F.wave * 16384);
        constexpr int NI_LAT = (MT / 64) * 8, NI = NI_LAT + (MC / 64) * 8;
        for (int it = gw; it < NI; it += NGW) {
            const bool lat = it < NI_LAT; const int r = lat ? it : it - NI_LAT;
            const int h = r & 7, tb = r >> 3;
            const int row0 = (lat ? 0 : MT) + tb * 64;
            const int b = lat ? (tb * 64) / T : (tb * 64) / LC, t0 = lat ? (tb * 64) % T : (tb * 64) % LC;
#pragma unroll 8
            for (int i = 0; i < 32; ++i) { const int tok = 2 * i + (F.lane >> 5); const unsigned w = *(const GAS unsigned*)(Z + (size_t)(row0 + tok) * PINP + ZV + h * 64 + 2 * (F.lane & 31));
                scr[tok * 66 + 2 * (F.lane & 31)] = (bf16)(w & 0xffff); scr[tok * 66 + 2 * (F.lane & 31) + 1] = (bf16)(w >> 16); }
            LDS_WAIT(); asm volatile("" ::: "memory");
            if (lat) {
                bf16* dst = VT + ((size_t)(b * 8 + h) * (T / 4) + (t0 >> 2)) * 256;
#pragma unroll
                for (int j = 0; j < 8; ++j) { const int g = 2 * j + (F.lane >> 5), dh = 2 * (F.lane & 31); const LAS bf16* s0 = scr + (4 * g) * 66 + dh;
                    v4u o; o.x = (unsigned)s0[0] | ((unsigned)s0[66] << 16); o.y = (unsigned)s0[2 * 66] | ((unsigned)s0[3 * 66] << 16);
                    o.z = (unsigned)s0[1] | ((unsigned)s0[66 + 1] << 16); o.w = (unsigned)s0[2 * 66 + 1] | ((unsigned)s0[3 * 66 + 1] << 16);
                    *(GAS v4u*)(dst + (size_t)(j * 64 + F.lane) * 8) = o; }
            } else {
                bf16* dst = VTC + ((size_t)(b * 8 + h) * 64) * LC + t0;
                const int c = F.lane & 7;
#pragma unroll
                for (int j = 0; j < 8; ++j) { const int dh = (F.lane >> 3) + 8 * j; const LAS bf16* s = scr + (8 * c) * 66 + dh;
                    v4u o; o.x = (unsigned)s[0] | ((unsigned)s[66] << 16); o.y = (unsigned)s[2 * 66] | ((unsigned)s[3 * 66] << 16); o.z = (unsigned)s[4 * 66] | ((unsigned)s[5 * 66] << 16); o.w = (unsigned)s[6 * 66] | ((unsigned)s[7 * 66] << 16);
                    *(GAS v4u*)(dst + (size_t)dh * LC + 8 * c) = o; }
            }
            LDS_WAIT(); asm volatile("" ::: "memory");
        }
    }
}

constexpr int NA_KP = 72, NA_VP = 264;
__device__ __forceinline__ void na_wave_task(Frame& F, int task, LAS float* rpbs, const LAS bf16* ck, const LAS bf16* cvt, int ocol = ZQ) {
    bf16* Z = (bf16*)(F.ws + WS_Z);
    const bf16* VT = (const bf16*)(F.ws + WS_VT);
    const int jq = task & 3, h = (task >> 2) & 7, i = (task >> 5) & 127, b = task >> 12;
    const int rs = min(max(i - 4, 0), GH - 8);
    const int cb = (jq == 0) ? 0 : (jq == 1) ? 8 : (jq == 2) ? 24 : 32;
    const int qi = F.lane & 15, qd = F.lane >> 4;
    const int j = jq * 16 + qi, cs = min(max(j - 8, 0), GW - 16);
    const size_t qrow = (size_t)b * T + i * GW + j;
    const bf16x8 q0 = *(const GAS bf16x8*)(Z + qrow * PINP + ZQ + h * 64 + qd * 8);
    const bf16x8 q1 = *(const GAS bf16x8*)(Z + qrow * PINP + ZQ + h * 64 + 32 + qd * 8);
    f32x4 s[32];
    int bidx[2][4];
#pragma unroll
    for (int half = 0; half < 2; ++half)
#pragma unroll
        for (int jj = 0; jj < 4; ++jj) { const int c = cb + half * 16 + qd * 4 + jj; const bool ok = (c >= cs) && (c < cs + 16); bidx[half][jj] = ok ? h * 465 + (rs - i + 7) * 31 + (c - j + 15) : 8 * 465; }
    LAS bf16* kb = (LAS bf16*)(F.lds + 87040 + F.wave * 4608);
    v4u kraw[4];
#pragma unroll
    for (int ii = 0; ii < 4; ++ii) kraw[ii] = *(const GAS v4u*)(Z + ((size_t)b * T + rs * GW + cb + 8 * ii + (F.lane >> 3)) * PINP + ZK + h * 64 + (F.lane & 7) * 8);
#pragma unroll
    for (int r = 0; r < 8; ++r) {
#pragma unroll
        for (int ii = 0; ii < 4; ++ii) *(LAS v4u*)(kb + (8 * ii + (F.lane >> 3)) * NA_KP + (F.lane & 7) * 8) = kraw[ii];
        if (r < 7) {
#pragma unroll
            for (int ii = 0; ii < 4; ++ii) kraw[ii] = *(const GAS v4u*)(Z + ((size_t)b * T + (rs + r + 1) * GW + cb + 8 * ii + (F.lane >> 3)) * PINP + ZK + h * 64 + (F.lane & 7) * 8); }
#pragma unroll
        for (int half = 0; half < 2; ++half) {
            const bf16x8 k0 = *(const LAS bf16x8*)(kb + (half * 16 + qi) * NA_KP + qd * 8), k1 = *(const LAS bf16x8*)(kb + (half * 16 + qi) * NA_KP + 32 + qd * 8);
            f32x4 a = (f32x4){0.f, 0.f, 0.f, 0.f};
            a = __builtin_amdgcn_mfma_f32_16x16x32_bf16(k0, q0, a, 0, 0, 0);
            a = __builtin_amdgcn_mfma_f32_16x16x32_bf16(k1, q1, a, 0, 0, 0);
#pragma unroll
            for (int jj = 0; jj < 4; ++jj) a[jj] += rpbs[bidx[half][jj] + r * 31];
            s[2 * r + half] = a; }
        __builtin_amdgcn_sched_barrier(0);
    }
#pragma unroll
    for (int tc = 0; tc < 16; ++tc) {
        const bf16x8 k0 = *(const LAS bf16x8*)(ck + (tc * 16 + qi) * NA_KP + qd * 8);
        const bf16x8 k1 = *(const LAS bf16x8*)(ck + (tc * 16 + qi) * NA_KP + 32 + qd * 8);
        f32x4 a = (f32x4){0.f, 0.f, 0.f, 0.f};
        a = __builtin_amdgcn_mfma_f32_16x16x32_bf16(k0, q0, a, 0, 0, 0);
        a = __builtin_amdgcn_mfma_f32_16x16x32_bf16(k1, q1, a, 0, 0, 0);
        s[16 + tc] = a;
        if ((tc & 1) == 1) __builtin_amdgcn_sched_barrier(0);
    }
    float mx = -1e30f;
#pragma unroll
    for (int tl = 0; tl < 32; ++tl) mx = fmaxf(fmaxf(fmaxf(s[tl][0], s[tl][1]), fmaxf(s[tl][2], s[tl][3])), mx);
    mx = fmaxf(mx, __shfl_xor(mx, 16)); mx = fmaxf(mx, __shfl_xor(mx, 32));
    float sum = 0.f; const float esc = 0.125f * 1.44269504f, mxs = mx * esc;
#pragma unroll
    for (int tl = 0; tl < 32; ++tl) {
#pragma unroll
        for (int jj = 0; jj < 4; ++jj) { const float e = __builtin_amdgcn_exp2f(__builtin_fmaf(s[tl][jj], esc, -mxs)); s[tl][jj] = e; sum += e; } }
    sum += __shfl_xor(sum, 16); sum += __shfl_xor(sum, 32);
    const float inv = 1.0f / sum;
    f32x4 o[4];
#pragma unroll
    for (int dt = 0; dt < 4; ++dt) o[dt] = (f32x4){0.f, 0.f, 0.f, 0.f};
#pragma unroll
    for (int ks = 0; ks < 16; ++ks) {
        const f32x4 p0 = s[2 * ks], p1 = s[2 * ks + 1];
        v4u pw; pw.x = pk2(p0[0], p0[1]); pw.y = pk2(p0[2], p0[3]); pw.z = pk2(p1[0], p1[1]); pw.w = pk2(p1[2], p1[3]);
        const bf16x8 pa = __builtin_bit_cast(bf16x8, pw);
        if (ks < 8) { const bf16* vb = VT + ((size_t)(b * 8 + h) * (T / 4) + (((rs + ks) * GW + cb) >> 2) + qd) * 256;
#pragma unroll
            for (int dt = 0; dt < 4; ++dt) {
                const bf16* vp = vb + (dt * 16 + qi) * 4;
                const v2u lo = *(const GAS v2u*)vp, hi = *(const GAS v2u*)(vp + 4 * 256);
                v4u vw; vw.x = lo.x; vw.y = lo.y; vw.z = hi.x; vw.w = hi.y;
                o[dt] = __builtin_amdgcn_mfma_f32_16x16x32_bf16(pa, __builtin_bit_cast(bf16x8, vw), o[dt], 0, 0, 0); } }
        else { const LAS bf16* vb = cvt + (ks - 8) * 32 + qd * 4;
#pragma unroll
            for (int dt = 0; dt < 4; ++dt) {
                const LAS bf16* vp = vb + (dt * 16 + qi) * NA_VP;
                const v2u lo = *(const LAS v2u*)vp, hi = *(const LAS v2u*)(vp + 16);
                v4u vw; vw.x = lo.x; vw.y = lo.y; vw.z = hi.x; vw.w = hi.y;
                o[dt] = __builtin_amdgcn_mfma_f32_16x16x32_bf16(pa, __builtin_bit_cast(bf16x8, vw), o[dt], 0, 0, 0); } }
        __builtin_amdgcn_sched_barrier(0);
    }
    float invq[4];
#pragma unroll
    for (int jj = 0; jj < 4; ++jj) invq[jj] = __shfl(inv, qd * 4 + jj);
#pragma unroll
    for (int dt = 0; dt < 4; ++dt)
#pragma unroll
        for (int jj = 0; jj < 4; ++jj) Z[((size_t)b * T + i * GW + jq * 16 + qd * 4 + jj) * PINP + ocol + h * 64 + dt * 16 + qi] = (bf16)f2bf(o[dt][jj] * invq[jj]);
}

constexpr int CP = 72;
constexpr int CBUF = 9216;
__device__ __forceinline__ int swz(int row, int col) { return row * 64 + (((((col >> 3) ^ (row >> 1) ^ ((row & 1) << 2)) & 7) << 3) | (col & 7)); }
constexpr int NCHK = (LC + T) / 64;
constexpr size_t PQ_UNIT = 16384, RY_UNIT = 16384;
constexpr int LDS_TOT = 15 * CBUF, LDS_CLE = LDS_TOT + 2048, LDS_MU = LDS_CLE + 256 + 2048;
#define CB(i) ((LAS bf16*)(F.lds + (i) * CBUF))
__device__ __forceinline__ bf16x8 ldsfrag(const LAS bf16* base, int row, int col) { return *(const LAS bf16x8*)(base + swz(row, col)); }
template <int MODE = 0> __device__ __forceinline__ void mm2(const LAS bf16* X, const LAS bf16* Y, int mt0, int nt, int r, int q, f32x4 (&acc)[2]) {
    if (MODE == 1) return;
    const bf16x8 y0 = ldsfrag(Y, 16 * nt + r, 8 * q), y1 = ldsfrag(Y, 16 * nt + r, 32 + 8 * q);
#pragma unroll
    for (int t = 0; t < 2; ++t) { const bf16x8 x0 = ldsfrag(X, 16 * (mt0 + t) + r, 8 * q), x1 = ldsfrag(X, 16 * (mt0 + t) + r, 32 + 8 * q);
        acc[t] = __builtin_amdgcn_mfma_f32_16x16x32_bf16(x0, y0, acc[t], 0, 0, 0); acc[t] = __builtin_amdgcn_mfma_f32_16x16x32_bf16(x1, y1, acc[t], 0, 0, 0); }
}
struct FragX { bf16x8 a[2][2]; };
struct FragY { bf16x8 b[2]; };
template <int MODE = 0> __device__ __forceinline__ FragX ldX(const LAS bf16* X, int mt0, int r, int q) { FragX f;
#pragma unroll
    for (int t = 0; t < 2; ++t) { if (MODE == 1) { f.a[t][0] = f.a[t][1] = (bf16x8){0, 0, 0, 0, 0, 0, 0, 0}; } else { f.a[t][0] = ldsfrag(X, 16 * (mt0 + t) + r, 8 * q); f.a[t][1] = ldsfrag(X, 16 * (mt0 + t) + r, 32 + 8 * q); } }
    return f; }
template <int MODE = 0> __device__ __forceinline__ FragY ldY(const LAS bf16* Y, int nt, int r, int q) { FragY f;
    if (MODE == 1) { f.b[0] = f.b[1] = (bf16x8){0, 0, 0, 0, 0, 0, 0, 0}; } else { f.b[0] = ldsfrag(Y, 16 * nt + r, 8 * q); f.b[1] = ldsfrag(Y, 16 * nt + r, 32 + 8 * q); }
    return f; }
template <int MODE = 0> __device__ __forceinline__ void mmf(const FragX& x, const FragY& y, f32x4 (&acc)[2]) {
    if (MODE == 1) return;
#pragma unroll
    for (int k = 0; k < 2; ++k)
#pragma unroll
        for (int t = 0; t < 2; ++t) acc[t] = __builtin_amdgcn_mfma_f32_16x16x32_bf16(x.a[t][k], y.b[k], acc[t], 0, 0, 0);
}
__device__ __forceinline__ v2u pack4(f32x4 v) { v2u o; o.x = pg8::cvt_pk_bf16(v[0], v[1]); o.y = pg8::cvt_pk_bf16(v[2], v[3]); return o; }
__device__ __forceinline__ f32x4 unpack4(v2u w) { return (f32x4){bflo(w.x), bfhi(w.x), bflo(w.y), bfhi(w.y)}; }
__device__ __forceinline__ void stT(LAS bf16* O, int mt, int nt, int r, int q, f32x4 v) { *(LAS v2u*)(O + swz(16 * nt + r, 16 * mt + 4 * q)) = pack4(v); }
__device__ __forceinline__ void stR(LAS bf16* O, int mt, int nt, int r, int q, f32x4 v) {
#pragma unroll
    for (int jj = 0; jj < 4; ++jj) O[swz(16 * mt + 4 * q + jj, 16 * nt + r)] = (bf16)f2bf(v[jj]); }
__device__ __forceinline__ f32x4 ldT(const LAS bf16* O, int mt, int nt, int r, int q) { return unpack4(*(const LAS v2u*)(O + swz(16 * nt + r, 16 * mt + 4 * q))); }
#define Z2 {(f32x4){0.f, 0.f, 0.f, 0.f}, (f32x4){0.f, 0.f, 0.f, 0.f}}
__device__ __forceinline__ float tanh_fast(float x) { return 1.0f - 2.0f * __builtin_amdgcn_rcpf(1.0f + __expf(2.0f * x)); }
__device__ __forceinline__ bf16 f2bf_hw(float x) { return (bf16)(pg8::cvt_pk_bf16(x, x) & 0xffffu); }
__device__ __forceinline__ void shift8(const bf16* zp, bool hasp, bool hasn, const float* mup, const float* mun, float (&o)[8]) {
    float z[8], a[8], b[8];
    unpack8(*(const GAS v4u*)zp, z);
    unpack8(hasp ? *(const GAS v4u*)(zp - PINP) : (v4u){0u, 0u, 0u, 0u}, a);
    unpack8(hasn ? *(const GAS v4u*)(zp + PINP) : (v4u){0u, 0u, 0u, 0u}, b);
    const f32x4 p0 = *(const f32x4*)mup, p1 = *(const f32x4*)(mup + 4), n0 = *(const f32x4*)mun, n1 = *(const f32x4*)(mun + 4);
#pragma unroll
    for (int e = 0; e < 8; ++e) { const float mp = e < 4 ? p0[e & 3] : p1[e & 3], mn = e < 4 ? n0[e & 3] : n1[e & 3]; o[e] = z[e] + mp * (a[e] - z[e]) + mn * (b[e] - z[e]); }
}
__device__ __forceinline__ void shift8u(const char* zu, unsigned zo, bool hasp, bool hasn, const char* mup, const char* mun, unsigned mo, float (&o)[8]) {
    float z[8], a[8], b[8];
    unpack8(*(const GAS v4u*)(zu + zo), z);
    unpack8(hasp ? *(const GAS v4u*)(zu - PINP * 2 + zo) : (v4u){0u, 0u, 0u, 0u}, a);
    unpack8(hasn ? *(const GAS v4u*)(zu + PINP * 2 + zo) : (v4u){0u, 0u, 0u, 0u}, b);
    const f32x4 p0 = *(const GAS f32x4*)(mup + mo), p1 = *(const GAS f32x4*)(mup + 16 + mo), n0 = *(const GAS f32x4*)(mun + mo), n1 = *(const GAS f32x4*)(mun + 16 + mo);
#pragma unroll
    for (int e = 0; e < 8; ++e) { const float mp = e < 4 ? p0[e & 3] : p1[e & 3], mn = e < 4 ? n0[e & 3] : n1[e & 3]; o[e] = z[e] + mp * (a[e] - z[e]) + mn * (b[e] - z[e]); }
}
__device__ __forceinline__ void shift8l(const char* zu, unsigned zo, bool hasp, bool hasn, const LAS float* mup, const LAS float* mun, float (&o)[8]) {
    float z[8], a[8], b[8];
    unpack8(*(const GAS v4u*)(zu + zo), z);
    unpack8(hasp ? *(const GAS v4u*)(zu - PINP * 2 + zo) : (v4u){0u, 0u, 0u, 0u}, a);
    unpack8(hasn ? *(const GAS v4u*)(zu + PINP * 2 + zo) : (v4u){0u, 0u, 0u, 0u}, b);
    const f32x4 p0 = *(const LAS f32x4*)mup, p1 = *(const LAS f32x4*)(mup + 4), n0 = *(const LAS f32x4*)mun, n1 = *(const LAS f32x4*)(mun + 4);
#pragma unroll
    for (int e = 0; e < 8; ++e) { const float mp = e < 4 ? p0[e & 3] : p1[e & 3], mn = e < 4 ? n0[e & 3] : n1[e & 3]; o[e] = z[e] + mp * (a[e] - z[e]) + mn * (b[e] - z[e]); }
}
struct Raw3 { v4u z, a, b; };
__device__ __forceinline__ void dma_tile(const char* gbase, unsigned zo, unsigned lds_tile, int wave, int lane) {
    const unsigned m0a = lds_tile + (unsigned)wave * 1024u;
    asm volatile("s_mov_b32 m0, %0\n\ts_nop 0\n\tglobal_load_lds_dwordx4 %1, %2" :: "s"(m0a), "v"(zo), "s"(gbase) : "memory", "m0");
    if (wave == 0) { if (lane < 16) { const char* g2 = gbase + (size_t)64 * PINP * 2; const unsigned m0b = lds_tile + 8192u;
        asm volatile("s_mov_b32 m0, %0\n\ts_nop 0\n\tglobal_load_lds_dwordx4 %1, %2" :: "s"(m0b), "v"(zo), "s"(g2) : "memory", "m0"); } }
}
__device__ __forceinline__ Raw3 rd3(const LAS unsigned char* tile, int t1, int k8) { Raw3 w; const LAS unsigned char* p = tile + t1 * 128 + k8 * 2;
    w.a = *(const LAS v4u*)p; w.z = *(const LAS v4u*)(p + 128); w.b = *(const LAS v4u*)(p + 256); return w; }
__device__ __forceinline__ Raw3 ld3(const char* zu, unsigned zo) { Raw3 w; w.z = *(const GAS v4u*)(zu + zo); w.a = *(const GAS v4u*)(zu - PINP * 2 + zo); w.b = *(const GAS v4u*)(zu + PINP * 2 + zo); return w; }
__device__ __forceinline__ void mix8(const Raw3& w, bool hasp, bool hasn, const LAS float* mup, const LAS float* mun, float (&o)[8]) {
    float z[8], a[8], b[8];
    unpack8(w.z, z); unpack8(hasp ? w.a : (v4u){0u, 0u, 0u, 0u}, a); unpack8(hasn ? w.b : (v4u){0u, 0u, 0u, 0u}, b);
    const f32x4 p0 = *(const LAS f32x4*)mup, p1 = *(const LAS f32x4*)(mup + 4), n0 = *(const LAS f32x4*)mun, n1 = *(const LAS f32x4*)(mun + 4);
#pragma unroll
    for (int e = 0; e < 8; ++e) { const float mp = e < 4 ? p0[e & 3] : p1[e & 3], mn = e < 4 ? n0[e & 3] : n1[e & 3]; o[e] = z[e] + mp * (a[e] - z[e]) + mn * (b[e] - z[e]); }
}
#define VMW(n) asm volatile("s_waitcnt vmcnt(" #n ")" ::: "memory")
__device__ __forceinline__ float sum8(float v) { v += dppf<0xB1>(v); v += dppf<0x4E>(v); v += dppf<0x141>(v); return v; }

__device__ __forceinline__ int afrag_off(int row, int col) { return ((((row >> 4) * 2 + (col >> 5)) * 64 + ((col >> 2) & 3) * 16 + (row & 15)) << 3) + ((col >> 4) & 1) * 4 + (col & 3); }
__device__ __forceinline__ int cfrag_off(int n, int m) { return ((((n >> 4) * 4 + (m >> 4)) * 64 + ((m >> 2) & 3) * 16 + (n & 15)) << 2) + (m & 3); }
template <int MODE> __device__ __forceinline__ void rwkvA_unit(Frame& F, int u, int& hl, int pre, int un) {
    int lane_ = F.lane, tid_ = F.tid; asm volatile("" : "+v"(lane_), "+v"(tid_));
    const bf16* Z = (const bf16*)(F.ws + WS_Z);
    const bf16* WupT = (const bf16*)(F.ws + WS_LW); const bf16* AupT = WupT + 2 * 512 * 64; const bf16* GupT = AupT + 2 * 512 * 64;
    const int h = u & 7, bt = u >> 3, b = bt / NCHK, blk = bt % NCHK; const bool isctx = blk < 4;
    const int seqlen = isctx ? LC : T, s0 = (isctx ? blk : blk - 4) * 64;
    const size_t row0 = (isctx ? (size_t)MT + b * LC : (size_t)b * T) + s0;
    const int ti = lane_, c8 = F.wave * 8;
    const int r = lane_ & 15, q = lane_ >> 4, nt = F.wave & 3, mt0 = 2 * (F.wave >> 2);
    const int sp = s0 + ti; const bool hasp = sp > 0, hasn = sp < seqlen - 1;
    const bf16* zrow = Z + (row0 + ti) * PINP;
    const int t1 = tid_ >> 3, k8 = (tid_ & 7) * 8; const int sp1 = s0 + t1; const bool hasp1 = sp1 > 0, hasn1 = sp1 < seqlen - 1;
    const char* Zu = (const char*)(Z + row0 * PINP); const unsigned zo = (unsigned)((t1 * PINP + k8) * 2), mo = (unsigned)(k8 * 4);
    LAS float* RSs = (LAS float*)(F.lds + 4 * CBUF); LAS float* KSs = RSs + 64 * 68; LAS bf16* VSs = (LAS bf16*)(F.lds + 4 * CBUF + 2 * 64 * 68 * 4);
    LAS float* ssp = (LAS float*)(F.lds + LDS_CLE + 256);
    const LAS float* mpL = (const LAS float*)(F.lds + LDS_MU); const LAS float* mnL = mpL + 384;
    LAS float* mpR = (LAS float*)(F.lds + 0 * CBUF + 8192); LAS float* mnR = (LAS float*)(F.lds + 1 * CBUF + 8192);
    if (h != hl) { hl = h; if (tid_ < 192) { const int gi = (tid_ >> 6) * 512 + h * 64 + (tid_ & 63); mpR[tid_] = F.in[8][gi]; mnR[tid_] = F.in[9][gi]; } __syncthreads(); }
    const unsigned ldsb = (unsigned)(size_t)F.lds;
    const char* Zm = Zu - PINP * 2;
    if (pre < 0) { dma_tile(Zm + (ZR + h * 64) * 2, zo, ldsb + 10 * CBUF, F.wave, lane_); dma_tile(Zm + (ZRK + h * 64) * 2, zo, ldsb + 11 * CBUF, F.wave, lane_); dma_tile(Zm + (ZRV + h * 64) * 2, zo, ldsb + 14 * CBUF, F.wave, lane_); VMW(0); }
    else if (pre == 4) VMW(4); else VMW(8);
    __syncthreads();
    dma_tile(Zm + ZLORA * 2, zo, ldsb + 9 * CBUF, F.wave, lane_); dma_tile(Zm + (ZLORA + 128) * 2, zo, ldsb + 12 * CBUF, F.wave, lane_); dma_tile(Zm + (ZLORA + 256) * 2, zo, ldsb + 13 * CBUF, F.wave, lane_);
    { float x[8], y[8];
      mix8(rd3(F.lds + 10 * CBUF, t1, k8), hasp1, hasn1, mpR + k8, mnR + k8, x);
      *(LAS f32x4*)(RSs + t1 * 68 + k8) = (f32x4){x[0], x[1], x[2], x[3]}; *(LAS f32x4*)(RSs + t1 * 68 + k8 + 4) = (f32x4){x[4], x[5], x[6], x[7]};
      mix8(rd3(F.lds + 11 * CBUF, t1, k8), hasp1, hasn1, mpR + 64 + k8, mnR + 64 + k8, y);
      *(LAS f32x4*)(KSs + t1 * 68 + k8) = (f32x4){y[0], y[1], y[2], y[3]}; *(LAS f32x4*)(KSs + t1 * 68 + k8 + 4) = (f32x4){y[4], y[5], y[6], y[7]};
      float ss = 0.f;
#pragma unroll
      for (int e = 0; e < 8; ++e) { const float kv = y[e] * F.in[15][h * 64 + k8 + e]; ss += kv * kv; }
      ss = sum8(ss); if ((tid_ & 7) == 0) ssp[t1] = 1.0f / sqrtf(ss + 1e-12f);
      mix8(rd3(F.lds + 14 * CBUF, t1, k8), hasp1, hasn1, mpR + 128 + k8, mnR + 128 + k8, x);
      *(LAS v4u*)(VSs + t1 * CP + k8) = pack8(x); }
    VMW(0); __syncthreads();
    float rs[8], ks[8], rn = 0.f; v4u vsp = {0u, 0u, 0u, 0u};
    LAS float* lwT = (LAS float*)(F.lds + 10 * CBUF);
    LAS float* aT = (LAS float*)(F.lds + 10 * CBUF + 64 * 68 * 4);
    LAS float* tot = (LAS float*)(F.lds + LDS_TOT); LAS float* cle = (LAS float*)(F.lds + LDS_CLE);
#pragma unroll 1
    for (int d = 0; d < 2; ++d) {
        const int ip = d ? 63 - ti : ti;
        const int chunk_p = isctx ? (d ? 3 - blk : blk) : (d ? 4 + (131 - blk) : blk);
        const bf16* wy = WupT + ((size_t)(d * 512 + h * 64 + 16 * nt + r)) * 64 + 8 * q; const bf16* ay = AupT + ((size_t)(d * 512 + h * 64 + 16 * nt + r)) * 64 + 8 * q;
        const bf16x8 wy0 = *(const GAS bf16x8*)wy, wy1 = *(const GAS bf16x8*)(wy + 32), ay0 = *(const GAS bf16x8*)ay, ay1 = *(const GAS bf16x8*)(ay + 32);
        const float w0v = F.in[10][d * 512 + h * 64 + 16 * nt + r], a0v = F.in[12][d * 512 + h * 64 + 16 * nt + r];
        { float x[8]; const int ip1 = d ? 63 - t1 : t1;
          Raw3 gB; if (d == 0) gB = ld3(Zu + (ZLORA + 256 + 64) * 2, zo);
          mix8(rd3(F.lds + (d ? 10 : 9) * CBUF, t1, k8), hasp1, hasn1, mpL + d * 64 + k8, mnL + d * 64 + k8, x);
#pragma unroll
          for (int e = 0; e < 8; ++e) x[e] = tanh_fast(x[e]);
          *(LAS v4u*)(CB(0) + swz(ip1, k8)) = pack8(x);
          mix8(rd3(F.lds + (d ? 11 : 12) * CBUF, t1, k8), hasp1, hasn1, mpL + 128 + d * 64 + k8, mnL + 128 + d * 64 + k8, x);
          *(LAS v4u*)(CB(1) + swz(ip1, k8)) = pack8(x);
          if (d == 0) {
              mix8(rd3(F.lds + 13 * CBUF, t1, k8), hasp1, hasn1, mpL + 256 + k8, mnL + 256 + k8, x);
#pragma unroll
              for (int e = 0; e < 8; ++e) x[e] = sigm(x[e]);
              *(LAS v4u*)(CB(2) + t1 * 144 + k8) = pack8(x);
              mix8(gB, hasp1, hasn1, mpL + 256 + 64 + k8, mnL + 256 + 64 + k8, x);
#pragma unroll
              for (int e = 0; e < 8; ++e) x[e] = sigm(x[e]);
              *(LAS v4u*)(CB(2) + t1 * 144 + 64 + k8) = pack8(x); } }
        __syncthreads();
        if (MODE == 5) { __syncthreads(); continue; }
        { f32x4 aw[2] = Z2, aa[2] = Z2;
          { const FragX xw = ldX<0>(CB(0), mt0, r, q), xa = ldX<0>(CB(1), mt0, r, q); FragY yw, ya; yw.b[0] = wy0; yw.b[1] = wy1; ya.b[0] = ay0; ya.b[1] = ay1;
            __builtin_amdgcn_sched_barrier(0);
            mmf<0>(xw, yw, aw); mmf<0>(xa, ya, aa); }
          const int c = 16 * nt + r;
#pragma unroll
          for (int t = 0; t < 2; ++t) { f32x4 lw, av;
#pragma unroll
              for (int jj = 0; jj < 4; ++jj) { lw[jj] = -0.60653066f * sigm(aw[t][jj] + w0v); av[jj] = sigm(aa[t][jj] + a0v); }
              *(LAS f32x4*)(lwT + c * 68 + 16 * (mt0 + t) + 4 * q) = lw; *(LAS f32x4*)(aT + c * 68 + 16 * (mt0 + t) + 4 * q) = av; }
          if (d == 0) { bf16x8 gyv[4]; { const bf16* gy = GupT + ((size_t)(h * 64 + 16 * nt + r)) * 128 + 8 * q;
#pragma unroll
              for (int k4 = 0; k4 < 4; ++k4) gyv[k4] = *(const GAS bf16x8*)(gy + 32 * k4); }
              f32x4 ag[2] = Z2;
#pragma unroll
              for (int kp = 0; kp < 2; ++kp) { bf16x8 xg[2][2];
#pragma unroll
                  for (int t = 0; t < 2; ++t)
#pragma unroll
                      for (int k2 = 0; k2 < 2; ++k2) xg[t][k2] = *(const LAS bf16x8*)(CB(2) + (16 * (mt0 + t) + r) * 144 + 32 * (2 * kp + k2) + 8 * q);
                  __builtin_amdgcn_sched_barrier(0);
#pragma unroll
                  for (int k2 = 0; k2 < 2; ++k2)
#pragma unroll
                      for (int t = 0; t < 2; ++t) ag[t] = __builtin_amdgcn_mfma_f32_16x16x32_bf16(gyv[2 * kp + k2], xg[t][k2], ag[t], 0, 0, 0); }
              if (!isctx) { bf16* G = (bf16*)(F.ws + WS_G);
#pragma unroll
                  for (int t = 0; t < 2; ++t) *(GAS v2u*)(G + (row0 + 16 * (mt0 + t) + r) * 512 + h * 64 + 16 * nt + 4 * q) = pack4(ag[t]); } } }
        __syncthreads();
        if (MODE == 4) { __syncthreads(); continue; }
        { const int c = tid_ & 63, g = tid_ >> 6; LAS float* p = lwT + c * 68 + 8 * g;
          f32x4 v0 = *(LAS f32x4*)p, v1 = *(LAS f32x4*)(p + 4);
          v0[1] += v0[0]; v0[2] += v0[1]; v0[3] += v0[2]; v1[0] += v0[3]; v1[1] += v1[0]; v1[2] += v1[1]; v1[3] += v1[2];
          tot[g * 64 + c] = v1[3];
          __syncthreads();
          float base = 0.f;
#pragma unroll
          for (int g2 = 0; g2 < 7; ++g2) base += (g2 < g) ? tot[g2 * 64 + c] : 0.f;
          v0 += base; v1 += base; *(LAS f32x4*)p = v0; *(LAS f32x4*)(p + 4) = v1;
          if (g == 7) cle[c] = v1[3]; }
        __syncthreads();
        { float at[8], btv[8], kt[8], rt[8]; float cf = 0.f;
          if (d == 0) { const f32x4 r0 = *(const LAS f32x4*)(RSs + ti * 68 + c8), r1 = *(const LAS f32x4*)(RSs + ti * 68 + c8 + 4), k0 = *(const LAS f32x4*)(KSs + ti * 68 + c8), k1 = *(const LAS f32x4*)(KSs + ti * 68 + c8 + 4);
              vsp = *(const LAS v4u*)(VSs + ti * CP + c8); rn = ssp[ti];
#pragma unroll
              for (int e = 0; e < 8; ++e) { rs[e] = e < 4 ? r0[e & 3] : r1[e & 3]; ks[e] = e < 4 ? k0[e & 3] : k1[e & 3]; }
              __syncthreads(); }
          float vs[8]; unpack8(vsp, vs);
#pragma unroll
          for (int e = 0; e < 8; ++e) { const int c = c8 + e; const float cl = lwT[c * 68 + ip], clp = ip > 0 ? lwT[c * 68 + ip - 1] : 0.f, a = aT[c * 68 + ip], ce = cle[c];
              const float G = __expf(cl), iG = __expf(-cl), Gex = __expf(clp), GeG = __expf(ce - cl);
              const float kke = ks[e] * F.in[15][h * 64 + c] * rn;
              const float km = ks[e] * (1.0f + (a - 1.0f) * F.in[16][h * 64 + c]), kb = kke * a;
              at[e] = -kke * Gex; btv[e] = kb * iG; kt[e] = km * iG; rt[e] = rs[e] * G;
              { const int so = swz(c, ip); CB(4)[so] = f2bf_hw(at[e]); CB(5)[so] = f2bf_hw(kb * GeG); CB(6)[so] = f2bf_hw(km * GeG); CB(7)[so] = f2bf_hw(vs[e]); }
              cf += rs[e] * km * F.in[17][h * 64 + c]; }
          { const int so = swz(ip, c8); *(LAS v4u*)(CB(0) + so) = pack8(at); *(LAS v4u*)(CB(1) + so) = pack8(btv); *(LAS v4u*)(CB(2) + so) = pack8(kt); *(LAS v4u*)(CB(3) + so) = pack8(rt); }
          ssp[F.wave * 64 + ti] = cf; }
        __syncthreads();
        if (!isctx && F.wave == 0) { float cf = 0.f;
#pragma unroll
            for (int w = 0; w < 8; ++w) cf += ssp[w * 64 + ti];
            ((float*)(F.ws + WS_COEF))[(row0 + ti) * 16 + h * 2 + d] = cf; }
        if (MODE == 3) { __syncthreads(); continue; }
        { f32x4 pN[2] = Z2, pLak[2] = Z2, pMrb[2] = Z2, pMrk[2] = Z2;
          { const FragX x1 = ldX<MODE>(CB(1), mt0, r, q), x2 = ldX<MODE>(CB(2), mt0, r, q); const FragY y0 = ldY<MODE>(CB(0), nt, r, q), y3 = ldY<MODE>(CB(3), nt, r, q);
            __builtin_amdgcn_sched_barrier(0);
            mmf<MODE>(x1, y0, pN); mmf<MODE>(x2, y0, pLak); mmf<MODE>(x1, y3, pMrb); mmf<MODE>(x2, y3, pMrk); }
          __builtin_amdgcn_sched_barrier(0);
          const int n = 16 * nt + r;
#pragma unroll
          for (int t = 0; t < 2; ++t) { f32x4 t0;
#pragma unroll
              for (int jj = 0; jj < 4; ++jj) { const int m = 16 * (mt0 + t) + 4 * q + jj;
                  pN[t][jj] = (m < n) ? pN[t][jj] : 0.f; t0[jj] = pN[t][jj] + ((m == n) ? 1.0f : 0.f);
                  pLak[t][jj] = (m < n) ? pLak[t][jj] : 0.f; pMrb[t][jj] = (m <= n) ? pMrb[t][jj] : 0.f; pMrk[t][jj] = (m <= n) ? pMrk[t][jj] : 0.f; }
              stT(CB(8), mt0 + t, nt, r, q, pN[t]); stT(CB(10), mt0 + t, nt, r, q, t0); stR(CB(9), mt0 + t, nt, r, q, pN[t]);
              stT(CB(11), mt0 + t, nt, r, q, pLak[t]); stT(CB(12), mt0 + t, nt, r, q, pMrb[t]); stT(CB(13), mt0 + t, nt, r, q, pMrk[t]); } }
        __syncthreads();
#define SQ_ST(a1, ONT_, ON_) do { _Pragma("unroll") for (int t = 0; t < 2; ++t) { stT(CB(ONT_), mt0 + t, nt, r, q, a1[t]); if ((ON_) >= 0) stR(CB((ON_) < 0 ? 0 : (ON_)), mt0 + t, nt, r, q, a1[t]); } } while (0)
#define TSQ_STAGE(NTB_, TOLD_, TNEW_, NB_, NTB2_, ONT_, ON_) do { f32x4 a3[2], a1[2] = Z2; \
            const FragX xt = ldX<MODE>(CB(NTB_), mt0, r, q); const FragY yt = ldY<MODE>(CB(TOLD_), nt, r, q); a3[0] = ldT(CB(TOLD_), mt0, nt, r, q); a3[1] = ldT(CB(TOLD_), mt0 + 1, nt, r, q); \
            const FragX xs = ldX<MODE>(CB(NB_), mt0, r, q); const FragY ys = ldY<MODE>(CB(NTB2_), nt, r, q); \
            __builtin_amdgcn_sched_barrier(0); \
            mmf<MODE>(xt, yt, a3); mmf<MODE>(xs, ys, a1); \
            __builtin_amdgcn_sched_barrier(0); \
            _Pragma("unroll") for (int t = 0; t < 2; ++t) stT(CB(TNEW_), mt0 + t, nt, r, q, a3[t]); \
            SQ_ST(a1, ONT_, ON_); } while (0)
        { f32x4 w1[2] = Z2, a1[2] = Z2;
          { const FragX xw = ldX<MODE>(CB(11), mt0, r, q), xs = ldX<MODE>(CB(8), mt0, r, q); const FragY yw = ldY<MODE>(CB(7), nt, r, q), ys = ldY<MODE>(CB(9), nt, r, q);
            __builtin_amdgcn_sched_barrier(0);
            mmf<MODE>(xw, yw, w1); mmf<MODE>(xs, ys, a1); }
          __builtin_amdgcn_sched_barrier(0);
          stT(CB(14), mt0, nt, r, q, w1[0]); stT(CB(14), mt0 + 1, nt, r, q, w1[1]); SQ_ST(a1, 0, 1); }
        __syncthreads();
        TSQ_STAGE(0, 10, 2, 1, 0, 8, 9);   __syncthreads();
        TSQ_STAGE(8, 2, 10, 9, 8, 0, 1);   __syncthreads();
        TSQ_STAGE(0, 10, 2, 1, 0, 8, 9);   __syncthreads();
        TSQ_STAGE(8, 2, 10, 9, 8, 0, -1);  __syncthreads();
        { f32x4 a3[2]; const FragX xt = ldX<MODE>(CB(0), mt0, r, q); const FragY yt = ldY<MODE>(CB(10), nt, r, q); a3[0] = ldT(CB(10), mt0, nt, r, q); a3[1] = ldT(CB(10), mt0 + 1, nt, r, q);
          __builtin_amdgcn_sched_barrier(0);
          mmf<MODE>(xt, yt, a3); stT(CB(2), mt0, nt, r, q, a3[0]); stT(CB(2), mt0 + 1, nt, r, q, a3[1]); }
        __syncthreads();
        if (d == 0) { dma_tile(Zm + (ZLORA + 64) * 2, zo, ldsb + 10 * CBUF, F.wave, lane_); dma_tile(Zm + (ZLORA + 128 + 64) * 2, zo, ldsb + 11 * CBUF, F.wave, lane_); }
        { f32x4 w2[2] = Z2, ah[2] = Z2;
          { const FragX xT = ldX<MODE>(CB(2), mt0, r, q); const FragY y14 = ldY<MODE>(CB(14), nt, r, q), y4 = ldY<MODE>(CB(4), nt, r, q);
            __builtin_amdgcn_sched_barrier(0);
            mmf<MODE>(xT, y14, w2); mmf<MODE>(xT, y4, ah); }
#pragma unroll
          for (int t = 0; t < 2; ++t) { stT(CB(8), mt0 + t, nt, r, q, w2[t]); stT(CB(9), mt0 + t, nt, r, q, ah[t]); } }
        __syncthreads();
        if (d == 1 && un >= 0) { const int hn = un & 7, btn = un >> 3, bn = btn / NCHK, blkn = btn % NCHK;
            const size_t rown = (blkn < 4 ? (size_t)MT + bn * LC + blkn * 64 : (size_t)bn * T + (blkn - 4) * 64);
            const char* zn = (const char*)(Z + (rown - 1) * PINP);
            dma_tile(zn + (ZR + hn * 64) * 2, zo, ldsb + 10 * CBUF, F.wave, lane_); dma_tile(zn + (ZRK + hn * 64) * 2, zo, ldsb + 11 * CBUF, F.wave, lane_); dma_tile(zn + (ZRV + hn * 64) * 2, zo, ldsb + 14 * CBUF, F.wave, lane_); }
        { const size_t ud = ((size_t)((b * 8 + h) * 2 + d)) * NCHK + chunk_p;
          bf16* Pg = (bf16*)(F.ws + WS_PQ + ud * PQ_UNIT); bf16* Qg = Pg + 4096;
          f32x4 pP[2] = Z2, pQ[2] = Z2;
          { const FragX x9 = ldX<MODE>(CB(9), mt0, r, q), x5 = ldX<MODE>(CB(5), mt0, r, q), x6 = ldX<MODE>(CB(6), mt0, r, q); const FragY y5 = ldY<MODE>(CB(5), nt, r, q), y8 = ldY<MODE>(CB(8), nt, r, q), y7 = ldY<MODE>(CB(7), nt, r, q);
            __builtin_amdgcn_sched_barrier(0);
            mmf<MODE>(x9, y5, pP); mmf<MODE>(x5, y8, pQ); mmf<MODE>(x6, y7, pQ); }
          __builtin_amdgcn_sched_barrier(0);
          const int n = 16 * nt + r; const float ge = __expf(cle[n]);
#pragma unroll
          for (int t = 0; t < 2; ++t) {
#pragma unroll
              for (int jj = 0; jj < 4; ++jj) { const int m = 16 * (mt0 + t) + 4 * q + jj; pP[t][jj] += (m == n) ? ge : 0.f; }
              *(GAS v2u*)(Pg + afrag_off(n, 16 * (mt0 + t) + 4 * q)) = pack4(pP[t]); *(GAS v2u*)(Qg + cfrag_off(n, 16 * (mt0 + t) + 4 * q)) = pack4(pQ[t]); }
          if (!isctx) { const size_t ul = ((size_t)((b * 8 + h) * 2 + d)) * 128 + (chunk_p - 4);
              bf16* Rg = (bf16*)((unsigned char*)F.out + ul * RY_UNIT); bf16* Yg = Rg + 4096;
              f32x4 pR[2], pY[2] = Z2; pR[0] = ldT(CB(3), mt0, nt, r, q); pR[1] = ldT(CB(3), mt0 + 1, nt, r, q);
              { const FragX x9 = ldX<MODE>(CB(9), mt0, r, q), x12 = ldX<MODE>(CB(12), mt0, r, q), x13 = ldX<MODE>(CB(13), mt0, r, q); const FragY y12 = ldY<MODE>(CB(12), nt, r, q), y8 = ldY<MODE>(CB(8), nt, r, q), y7 = ldY<MODE>(CB(7), nt, r, q);
                __builtin_amdgcn_sched_barrier(0);
                mmf<MODE>(x9, y12, pR); mmf<MODE>(x12, y8, pY); mmf<MODE>(x13, y7, pY); }
              __builtin_amdgcn_sched_barrier(0);
#pragma unroll
              for (int t = 0; t < 2; ++t) {
                  *(GAS v2u*)(Rg + afrag_off(d ? 63 - n : n, 16 * (mt0 + t) + 4 * q)) = pack4(pR[t]);
                  if (d) { const f32x4 rv = {pY[t][3], pY[t][2], pY[t][1], pY[t][0]}; *(GAS v2u*)(Yg + cfrag_off(n, 60 - 16 * (mt0 + t) - 4 * q)) = pack4(rv); }
                  else *(GAS v2u*)(Yg + cfrag_off(n, 16 * (mt0 + t) + 4 * q)) = pack4(pY[t]); } } }
        if (d == 0) { if (isctx) VMW(4); else VMW(8); }
        __syncthreads();
    }
#undef SQ_ST
#undef TSQ_STAGE
}

struct BSetPQ { v4u p[8]; v2u qv[4]; };
constexpr size_t XC_UNIT = 2048;
__device__ __forceinline__ void rwkvB_task(Frame& F, int task) {
    const int vsl = task & 3, chain = task >> 2;
    const int r = F.lane & 15, q = F.lane >> 4;
    const unsigned char* PQ = F.ws + WS_PQ + (size_t)chain * NCHK * PQ_UNIT;
    unsigned char* XC = F.ws + WS_YFB + ((size_t)chain * 128 * 4 + vsl) * XC_UNIT;
    f32x4 X[4];
#pragma unroll
    for (int i = 0; i < 4; ++i) X[i] = (f32x4){0.f, 0.f, 0.f, 0.f};
#define B_LOADPQ(S, c_) do { const int _c = (c_) < NCHK ? (c_) : NCHK - 1; const bf16* _P = (const bf16*)(PQ + (size_t)_c * PQ_UNIT); const bf16* _Q = _P + 4096; \
        _Pragma("unroll") for (int mt = 0; mt < 4; ++mt) { S.qv[mt] = *(const GAS v2u*)(_Q + (((vsl * 4 + mt) * 64 + F.lane) << 2)); \
            _Pragma("unroll") for (int ks = 0; ks < 2; ++ks) S.p[mt * 2 + ks] = *(const GAS v4u*)(_P + (((mt * 2 + ks) * 64 + F.lane) << 3)); } } while (0)
#define B_STEP(S, c_) do { const int _c = (c_); bf16x8 xb[2]; \
        _Pragma("unroll") for (int ks = 0; ks < 2; ++ks) { const v2u lo = pack4(X[2 * ks]), hi = pack4(X[2 * ks + 1]); const v4u xw = {lo.x, lo.y, hi.x, hi.y}; xb[ks] = __builtin_bit_cast(bf16x8, xw); \
            if (_c >= 4) *(GAS v4u*)(XC + (size_t)(_c - 4) * 4 * XC_UNIT + ks * 1024 + F.lane * 16) = xw; } \
        _Pragma("unroll") for (int mt = 0; mt < 4; ++mt) { f32x4 xn = unpack4(S.qv[mt]); \
            _Pragma("unroll") for (int ks = 0; ks < 2; ++ks) xn = __builtin_amdgcn_mfma_f32_16x16x32_bf16(__builtin_bit_cast(bf16x8, S.p[mt * 2 + ks]), xb[ks], xn, 0, 0, 0); \
            X[mt] = xn; } } while (0)
    BSetPQ SA, SB, SC;
    B_LOADPQ(SA, 0); B_LOADPQ(SB, 1);
#pragma unroll 1
    for (int c = 0; c < NCHK; c += 3) {
        B_LOADPQ(SC, c + 2); B_STEP(SA, c);
        B_LOADPQ(SA, c + 3); B_STEP(SB, c + 1);
        B_LOADPQ(SB, c + 4); B_STEP(SC, c + 2);
    }
#undef B_LOADPQ
#undef B_STEP
}

constexpr int YSP = 520;
__device__ __forceinline__ void phase_readout(Frame& F) {
    bf16* Z = (bf16*)(F.ws + WS_Z); const bf16* G = (const bf16*)(F.ws + WS_G); const float* COEF = (const float*)(F.ws + WS_COEF);
    LAS bf16* YS = (LAS bf16*)F.lds;
    const int r = F.lane & 15, q = F.lane >> 4, h = F.wave;
    const int hh = F.lane >> 3, c0 = F.lane * 8;
    float gnw[8], gnb[8];
#pragma unroll
    for (int e = 0; e < 8; ++e) { gnw[e] = F.in[18][c0 + e]; gnb[e] = F.in[19][c0 + e]; }
    for (int u = F.bid; u < NB * 128; u += F.G) {
        const int b = u >> 7, blk = u & 127;
        f32x4 y[4][4];
#pragma unroll
        for (int it = 0; it < 4; ++it)
#pragma unroll
            for (int vs = 0; vs < 4; ++vs) y[it][vs] = (f32x4){0.f, 0.f, 0.f, 0.f};
#pragma unroll
        for (int d = 0; d < 2; ++d) {
            const int chain = (b * 8 + h) * 2 + d, lc = d ? 127 - blk : blk;
            const bf16* Rg = (const bf16*)((const unsigned char*)F.out + ((size_t)chain * 128 + lc) * RY_UNIT); const bf16* Yg = Rg + 4096;
            const unsigned char* XC = F.ws + WS_YFB + ((size_t)chain * 128 + lc) * 4 * XC_UNIT;
            v4u xw[4][2], rr[4][2]; v2u yl[4][4];
#pragma unroll
            for (int vs = 0; vs < 4; ++vs) { xw[vs][0] = *(const GAS v4u*)(XC + vs * XC_UNIT + F.lane * 16); xw[vs][1] = *(const GAS v4u*)(XC + vs * XC_UNIT + 1024 + F.lane * 16); }
#pragma unroll
            for (int it = 0; it < 4; ++it) {
#pragma unroll
                for (int ks = 0; ks < 2; ++ks) rr[it][ks] = *(const GAS v4u*)(Rg + (((it * 2 + ks) * 64 + F.lane) << 3));
#pragma unroll
                for (int vs = 0; vs < 4; ++vs) yl[it][vs] = *(const GAS v2u*)(Yg + (((vs * 4 + it) * 64 + F.lane) << 2)); }
#pragma unroll
            for (int it = 0; it < 4; ++it)
#pragma unroll
                for (int vs = 0; vs < 4; ++vs) { f32x4 a = y[it][vs] + unpack4(yl[it][vs]);
#pragma unroll
                    for (int ks = 0; ks < 2; ++ks) a = __builtin_amdgcn_mfma_f32_16x16x32_bf16(__builtin_bit_cast(bf16x8, rr[it][ks]), __builtin_bit_cast(bf16x8, xw[vs][ks]), a, 0, 0, 0);
                    y[it][vs] = a; }
        }
#pragma unroll
        for (int it = 0; it < 4; ++it)
#pragma unroll
            for (int vs = 0; vs < 4; ++vs)
#pragma unroll
                for (int jj = 0; jj < 4; ++jj) YS[(16 * it + 4 * q + jj) * YSP + h * 64 + 16 * vs + r] = f2bf_hw(y[it][vs][jj]);
        __syncthreads();
#pragma unroll 2
        for (int tk = 0; tk < 8; ++tk) {
            const int tok = 8 * F.wave + tk, t = blk * 64 + tok; const size_t m = (size_t)b * T + t;
            float vsh[8], yf[8], gg[8];
            shift8(Z + m * PINP + ZRV + c0, t > 0, t < T - 1, F.in[8] + 1024 + c0, F.in[9] + 1024 + c0, vsh);
            unpack8(*(const LAS v4u*)(YS + tok * YSP + c0), yf); unpack8(*(const GAS v4u*)(G + m * 512 + c0), gg);
            const f32x2 cf2 = *(const GAS f32x2*)(COEF + m * 16 + hh * 2); const float coef = cf2.x + cf2.y;
            float sm = 0.f;
#pragma unroll
            for (int e = 0; e < 8; ++e) sm += yf[e];
            const float mean = sum8(sm) * (1.0f / 64.0f); float q2 = 0.f;
#pragma unroll
            for (int e = 0; e < 8; ++e) { yf[e] -= mean; q2 += yf[e] * yf[e]; }
            const float rstd = 1.0f / sqrtf(sum8(q2) * (1.0f / 64.0f) + GN_EPS);
            float o[8];
#pragma unroll
            for (int e = 0; e < 8; ++e) o[e] = (yf[e] * rstd * gnw[e] + gnb[e] + coef * vsh[e]) * gg[e];
            *(GAS v4u*)(Z + m * PINP + ZK + c0) = pack8(o);
        }
        __syncthreads();
    }
}

__device__ __forceinline__ void phase_ln1_router(Frame& F, float* hdst = nullptr) {
    const float* MODV = (const float*)(F.ws + WS_MOD);
    unsigned char* U2 = F.ws + WS_U2; float* AFF = (float*)(F.ws + WS_AFF);
    LAS float* wr = (LAS float*)F.lds;
    for (int e = F.tid; e < 1024 * 16; e += NTHR) { const int d = e >> 4, ex = e & 15, j = d >> 8, ln = (d & 255) >> 2, q = d & 3; wr[((j * 4 + q) * 64 + ln) * 20 + ex] = F.in[25][e]; }
    LAS float* tr = (LAS float*)(F.lds + 81920 + F.wave * 4352);
    __syncthreads();
    const int gw = F.bid * NWAVES + F.wave, NGW = F.G * NWAVES;
    f32x4 nx[4];
    if (gw < MT) {
#pragma unroll
        for (int j = 0; j < 4; ++j) nx[j] = ((const GAS f32x4*)(F.out + (size_t)gw * D) + F.lane)[64 * j]; }
    for (int m = gw; m < MT; m += NGW) {
        const int b = m / T;
        const float* sh2 = MODV + b * 6144 + 3072; const float* sc2 = sh2 + 1024;
        GAS f32x4* hr = (GAS f32x4*)(F.out + (size_t)m * D) + F.lane;
        f32x4 v[4]; float s = 0.f;
#pragma unroll
        for (int j = 0; j < 4; ++j) { v[j] = nx[j]; s += (v[j].x + v[j].y) + (v[j].z + v[j].w); }
        if (m + NGW < MT) {
#pragma unroll
            for (int j = 0; j < 4; ++j) nx[j] = ((const GAS f32x4*)(F.out + (size_t)(m + NGW) * D) + F.lane)[64 * j]; }
        float mean = wave_sum(s) * (1.f / D); float s2 = 0.f;
#pragma unroll
        for (int j = 0; j < 4; ++j) { v[j] = v[j] - mean; s2 += (v[j].x * v[j].x + v[j].y * v[j].y) + (v[j].z * v[j].z + v[j].w * v[j].w); }
        float rstd = 1.f / sqrtf(wave_sum(s2) * (1.f / D) + LN_EPS);
        s = 0.f;
#pragma unroll
        for (int j = 0; j < 4; ++j) { const f32x4 g = *((const f32x4*)F.in[23] + F.lane + 64 * j), bb = *((const f32x4*)F.in[24] + F.lane + 64 * j);
            v[j] = v[j] * rstd * g + bb; if (hdst) ((GAS f32x4*)(hdst + (size_t)m * D) + F.lane)[64 * j] = v[j]; else hr[64 * j] = v[j]; s += (v[j].x + v[j].y) + (v[j].z + v[j].w); }
        mean = wave_sum(s) * (1.f / D); s2 = 0.f;
#pragma unroll
        for (int j = 0; j < 4; ++j) { v[j] = v[j] - mean; s2 += (v[j].x * v[j].x + v[j].y * v[j].y) + (v[j].z * v[j].z + v[j].w * v[j].w); }
        rstd = 1.f / sqrtf(wave_sum(s2) * (1.f / D) + LN_EPS);
        GAS unsigned* o4 = (GAS unsigned*)(U2 + (size_t)m * D) + F.lane;
        float lg[16];
#pragma unroll
        for (int e = 0; e < 16; ++e) lg[e] = 0.f;
#pragma unroll
        for (int j = 0; j < 4; ++j) { const f32x4 a = *((const f32x4*)sc2 + F.lane + 64 * j), bb = *((const f32x4*)sh2 + F.lane + 64 * j);
            const f32x4 o = v[j] * rstd * (a + 1.0f) + bb; v[j] = o;
            o4[64 * j] = pk4_fp8(o.x, o.y, o.z, o.w); }
#pragma unroll
        for (int j = 0; j < 4; ++j) {
#pragma unroll
            for (int q = 0; q < 4; ++q) { const LAS f32x4* wp = (const LAS f32x4*)(wr + (size_t)(((j * 4 + q) * 64 + F.lane) * 20)); const float oq = v[j][q];
#pragma unroll
                for (int e4 = 0; e4 < 4; ++e4) { const f32x4 w = wp[e4]; lg[e4 * 4 + 0] += oq * w.x; lg[e4 * 4 + 1] += oq * w.y; lg[e4 * 4 + 2] += oq * w.z; lg[e4 * 4 + 3] += oq * w.w; } }
            __builtin_amdgcn_sched_barrier(0); }
#pragma unroll
        for (int e = 0; e < 16; ++e) tr[F.lane * 17 + e] = lg[e];
        LDS_WAIT(); asm volatile("" ::: "memory");
        float lgt = 0.f;
#pragma unroll
        for (int i = 0; i < 16; ++i) lgt += tr[((F.lane >> 4) * 16 + i) * 17 + (F.lane & 15)];
        LDS_WAIT(); asm volatile("" ::: "memory");
        lgt += __shfl_xor(lgt, 16); lgt += __shfl_xor(lgt, 32);
        float mx = lgt;
        mx = fmaxf(mx, dppf<0xB1>(mx)); mx = fmaxf(mx, dppf<0x4E>(mx)); mx = fmaxf(mx, dppf<0x141>(mx)); mx = fmaxf(mx, dppf<0x140>(mx));
        const float ex = expf(lgt - mx); const float mine = ex / row16_sum(ex);
        if (F.lane < 16) AFF[(size_t)m * 16 + F.lane] = mine;
    }
}

__device__ __forceinline__ unsigned block_excl_scan(Frame& F, unsigned v, LAS unsigned* sc, unsigned& total) {
    unsigned inc = v;
#pragma unroll
    for (int o = 1; o < 64; o <<= 1) { const unsigned t = __shfl_up(inc, o); if (F.lane >= o) inc += t; }
    __syncthreads();
    if (F.lane == 63) sc[F.wave] = inc;
    __syncthreads();
    unsigned base = 0, tot = 0;
#pragma unroll
    for (int w = 0; w < 8; ++w) { const unsigned x = sc[w]; if (w < F.wave) base += x; tot += x; }
    total = tot;
    return base + inc - v;
}
__device__ __forceinline__ void topk_unit(Frame& F, int unit) {
    const int b = unit & 3, e = unit >> 2;
    const float* AFF = (const float*)(F.ws + WS_AFF);
    int* IDX = (int*)(F.ws + WS_IDX); float* GATEV = (float*)(F.ws + WS_GATEV); int* SLOT = (int*)(F.ws + WS_SLOT);
    LAS unsigned* hist = (LAS unsigned*)F.lds;
    LAS unsigned* sc = hist + 256;
    LAS unsigned* sel = sc + 16;
    LAS int* idl = (LAS int*)(sel + 16);
    unsigned key[16];
#pragma unroll
    for (int i = 0; i < 16; ++i) key[i] = __float_as_uint(AFF[((size_t)b * T + F.tid * 16 + i) * 16 + e]);
    unsigned prefix = 0, need = CAP;
#pragma unroll 1
    for (int rd = 0; rd < 4; ++rd) {
        const int shift = 24 - 8 * rd; const unsigned hmask = (rd == 0) ? 0u : (0xffffffffu << (shift + 8));
        if (F.tid < 256) hist[F.tid] = 0u;
        __syncthreads();
#pragma unroll
        for (int i = 0; i < 16; ++i) if ((key[i] & hmask) == prefix) __hip_atomic_fetch_add(&hist[(key[i] >> shift) & 255u], 1u, __ATOMIC_RELAXED, __HIP_MEMORY_SCOPE_WORKGROUP);
        __syncthreads();
        if (F.wave == 0) {
            const unsigned c0 = hist[4 * F.lane], c1 = hist[4 * F.lane + 1], c2 = hist[4 * F.lane + 2], c3 = hist[4 * F.lane + 3];
            const unsigned tot4 = (c0 + c1) + (c2 + c3); unsigned x = tot4;
#pragma unroll
            for (int o = 1; o < 64; o <<= 1) { const unsigned t = __shfl_down(x, o); if (F.lane + o < 64) x += t; }
            const unsigned excl = x - tot4;
            if (excl < need && need <= x) { unsigned cum = excl; int bin;
                if (cum + c3 >= need) bin = 4 * F.lane + 3; else { cum += c3; if (cum + c2 >= need) bin = 4 * F.lane + 2; else { cum += c2; if (cum + c1 >= need) bin = 4 * F.lane + 1; else { cum += c1; bin = 4 * F.lane; } } }
                sel[0] = (unsigned)bin; sel[1] = need - cum; } }
        __syncthreads();
        prefix |= sel[0] << shift; need = sel[1];
        __syncthreads();
    }
    unsigned neq = 0, ngt = 0;
#pragma unroll
    for (int i = 0; i < 16; ++i) { neq += (key[i] == prefix); ngt += (key[i] > prefix); }
    unsigned tot; const unsigned eqbase = block_excl_scan(F, neq, sc, tot);
    unsigned cnt = 0, eqr = eqbase; unsigned selm = 0;
#pragma unroll
    for (int i = 0; i < 16; ++i) { bool s = key[i] > prefix; if (key[i] == prefix) { s = eqr < need; ++eqr; } if (s) { selm |= 1u << i; ++cnt; } }
    const unsigned pos0 = block_excl_scan(F, cnt, sc, tot);
    unsigned pos = pos0;
#pragma unroll
    for (int i = 0; i < 16; ++i) { const int t = F.tid * 16 + i; int sl = -1;
        if (selm & (1u << i)) { sl = (int)pos; ++pos; const int slot = (e * NB + b) * CAP + sl; IDX[slot] = b * T + t; GATEV[slot] = __uint_as_float(key[i]); idl[sl] = b * T + t; }
        SLOT[((size_t)b * T + t) * 16 + e] = sl; }
    __syncthreads();
    { const unsigned char* U2 = F.ws + WS_U2; unsigned char* XS = F.ws + WS_XS + (size_t)((e * NB + b) * CAP) * D;
#pragma unroll 1
      for (int s0 = F.wave * 16; s0 < CAP; s0 += NWAVES * 16) { v4u rw[16];
#pragma unroll
          for (int k = 0; k < 16; ++k) rw[k] = *((const GAS v4u*)(U2 + (size_t)idl[s0 + k] * D) + F.lane);
#pragma unroll
          for (int k = 0; k < 16; ++k) *((GAS v4u*)(XS + (size_t)(s0 + k) * D) + F.lane) = rw[k]; } }
    __syncthreads();
}
constexpr int CV_I13 = 16 * (DE / 64), CV_I2 = (DE / 64) * 16, CV_N13 = NE * 2 * CV_I13;
constexpr int Z_EARLY_PER_WAVE = 6;
__device__ __forceinline__ int z_tail_first(int G) { return ((MA / 256) * (PINP / 256)) % G; }
__device__ __forceinline__ int z_early_tiles(int G) { const int t = z_tail_first(G); const int n = t > 0 ? (G - t) * NWAVES * Z_EARLY_PER_WAVE : 0; return n <= NE * CV_I2 - W2_EARLY_TILES ? n : 0; }
__device__ __forceinline__ void cvt_w2_tile(Frame& F, int w2t) { const int e = w2t / CV_I2, r = w2t % CV_I2, k0 = 64 * (r / 16), n0 = 64 * (r % 16);
    cvt_tile64_fp8(F.in[28] + (size_t)e * DE * 1024, 1024, k0, n0, F.ws + WS_W2 + (size_t)e * 1024 * DE, (size_t)n0, DE, W2_SCALE, F.lane); }
__device__ __forceinline__ void cvt_w13_tile(Frame& F, int it0) { const int e = it0 / (2 * CV_I13); int r = it0 % (2 * CV_I13);
    const int which = r / CV_I13; r %= CV_I13; const int nb = DE / 64, k0 = 64 * (r / nb), n0 = 64 * (r % nb);
    cvt_tile64_fp8(F.in[which ? 27 : 26] + (size_t)e * 1024 * DE, DE, k0, n0, F.ws + WS_W13 + (size_t)e * PINP * 1024, (size_t)(256 * (n0 / 128) + 128 * which + (n0 % 128)), 1024, W13_SCALE, F.lane); }
__device__ __forceinline__ void phase_topk_convert(Frame& F) {
    if (F.bid < NB * NE) topk_unit(F, F.bid);
    const int NTK = NB * NE * NWAVES, NVW = F.G * NWAVES - NTK;
    const int gwl = F.bid * NWAVES + F.wave; const int vw0 = gwl < NTK ? 0 : (gwl - NTK), nvw = gwl < NTK ? 0 : 1;
    const int w2done = z_early_tiles(F.G) + W2_EARLY_TILES, nlate = CV_N13 + NE * CV_I2 - w2done;
    for (int itb = vw0; itb < nlate; itb += NVW) for (int v = 0; v < nvw; ++v) { const int it0 = itb + v; if (it0 >= nlate) break;
        if (it0 < CV_N13) cvt_w13_tile(F, it0); else cvt_w2_tile(F, it0 - CV_N13 + w2done); }
}

__device__ __forceinline__ void phase_gather(Frame& F) {
    const int* IDX = (const int*)(F.ws + WS_IDX); const unsigned char* U2 = F.ws + WS_U2; unsigned char* XS = F.ws + WS_XS;
    const int gw = F.bid * NWAVES + F.wave, NGW = F.G * NWAVES;
    for (int s = gw; s < NSLOT; s += NGW) {
        const int src = IDX[s];
        *((GAS v4u*)(XS + (size_t)s * D) + F.lane) = *((const GAS v4u*)(U2 + (size_t)src * D) + F.lane);
    }
}

__device__ __forceinline__ void phase_final(Frame& F, float* odst = nullptr) {
    const float* MODV = (const float*)(F.ws + WS_MOD); const int* SLOT = (const int*)(F.ws + WS_SLOT); const bf16* YE = (const bf16*)(F.ws + WS_YE);
    const int gw = F.bid * NWAVES + F.wave, NGW = F.G * NWAVES;
    int nslot = -1; f32x4 nhv[4];
    if (gw < MT) { nslot = (F.lane < 16) ? SLOT[(size_t)gw * 16 + F.lane] : -1;
#pragma unroll
        for (int j = 0; j < 4; ++j) nhv[j] = ((const GAS f32x4*)(F.out + (size_t)gw * D) + F.lane)[64 * j]; }
    for (int m = gw; m < MT; m += NGW) {
        const int b = m / T;
        const float* gt2 = MODV + b * 6144 + 5120;
        GAS f32x4* hr = (GAS f32x4*)(F.out + (size_t)m * D) + F.lane;
        f32x4 acc[4];
#pragma unroll
        for (int j = 0; j < 4; ++j) acc[j] = (f32x4){0.f, 0.f, 0.f, 0.f};
        const int myslot = nslot;
        f32x4 hv[4];
#pragma unroll
        for (int j = 0; j < 4; ++j) hv[j] = nhv[j];
        if (m + NGW < MT) { nslot = (F.lane < 16) ? SLOT[(size_t)(m + NGW) * 16 + F.lane] : -1;
#pragma unroll
            for (int j = 0; j < 4; ++j) nhv[j] = ((const GAS f32x4*)(F.out + (size_t)(m + NGW) * D) + F.lane)[64 * j]; }
        unsigned mask = (unsigned)(__ballot(myslot >= 0) & 0xFFFFull);
        while (mask) {
            const int e0 = __builtin_ctz(mask); mask &= mask - 1; const bool two = mask != 0; const int e1 = two ? __builtin_ctz(mask) : e0; if (two) mask &= mask - 1;
            const int s0 = __shfl(myslot, e0), s1 = __shfl(myslot, e1);
            const GAS v2u* y0 = (const GAS v2u*)(YE + (size_t)((e0 * NB + b) * CAP + s0) * D) + F.lane; const GAS v2u* y1 = (const GAS v2u*)(YE + (size_t)((e1 * NB + b) * CAP + s1) * D) + F.lane;
            v2u w0[4], w1[4];
#pragma unroll
            for (int j = 0; j < 4; ++j) { w0[j] = y0[64 * j]; w1[j] = y1[64 * j]; }
            const float f1 = two ? 1.f : 0.f;
#pragma unroll
            for (int j = 0; j < 4; ++j) { acc[j].x += bflo(w0[j].x) + f1 * bflo(w1[j].x); acc[j].y += bfhi(w0[j].x) + f1 * bfhi(w1[j].x); acc[j].z += bflo(w0[j].y) + f1 * bflo(w1[j].y); acc[j].w += bfhi(w0[j].y) + f1 * bfhi(w1[j].y); } }
        f32x4 v[4]; float s = 0.f;
#pragma unroll
        for (int j = 0; j < 4; ++j) { const f32x4 g = *((const f32x4*)gt2 + F.lane + 64 * j); v[j] = hv[j] * ALPHA + g * acc[j]; s += (v[j].x + v[j].y) + (v[j].z + v[j].w); }
        const float mean = wave_sum(s) * (1.f / D); float s2 = 0.f;
#pragma unroll
        for (int j = 0; j < 4; ++j) { v[j] = v[j] - mean; s2 += (v[j].x * v[j].x + v[j].y * v[j].y) + (v[j].z * v[j].z + v[j].w * v[j].w); }
        const float rstd = 1.f / sqrtf(wave_sum(s2) * (1.f / D) + LN_EPS);
#pragma unroll
        for (int j = 0; j < 4; ++j) { const f32x4 g = *((const f32x4*)F.in[29] + F.lane + 64 * j), bb = *((const f32x4*)F.in[30] + F.lane + 64 * j); { const f32x4 ov = v[j] * rstd * g + bb; if (odst) ((GAS f32x4*)(odst + (size_t)m * D) + F.lane)[64 * j] = ov; else hr[64 * j] = ov; } }
    }
}

constexpr int N_PHASES = 16;
struct Args { const float* in[31]; float* out; unsigned char* ws; int ph_lo, ph_hi; };
__global__ void __launch_bounds__(NTHR, 2) fwd(Args args) {
    extern __shared__ __attribute__((aligned(16))) unsigned char lds[];
    Frame F;
    F.lds = (LAS unsigned char*)lds;
    F.tid = threadIdx.x; F.lane = F.tid & 63; F.wave = __builtin_amdgcn_readfirstlane(F.tid >> 6);
    F.G = gridDim.x; F.bid = blockIdx.x;
#pragma unroll
    for (int i = 0; i < 31; ++i) F.in[i] = args.in[i];
    F.out = args.out; F.ws = args.ws;
    volatile LAS unsigned* MISC = (volatile LAS unsigned*)(F.lds + MISC_OFF);
    for (int u = F.tid; u < (LDS_BYTES - LDSCTL_OFF) / 4; u += NTHR) ((LAS unsigned*)(F.lds + LDSCTL_OFF))[u] = 0u;
    __syncthreads();
    XcdBarrier bar; bar.bar = (unsigned*)(F.ws + WS_CTL) + CW_BAR; bar.x = 0; bar.st = nullptr;
    const int lo = args.ph_lo, hi = args.ph_hi;
    const bool multi = (hi - lo) > 1;
    if (multi) bar = xcd_barrier_post((unsigned*)(F.ws + WS_CTL) + CW_BAR, MISC + 8);
#ifndef PH_MASK
#define PH_MASK 0xFFFF
#endif
#define IN(k) (((PH_MASK >> (k)) & 1) && lo <= (k) && (k) < hi)
#define SEAM(k) do { if (IN(k) && IN((k) + 1)) xcd_barrier(bar); } while (0)
    LAS unsigned char* ring = F.lds;
    bf16* Z = (bf16*)(F.ws + WS_Z);

    if (IN(0)) { for (int rp = 0; rp < REPS(0); ++rp) { phase_prologue(F); if (rp + 1 < REPS(0)) xcd_barrier(bar); } SEAM(0); }
    if (IN(1)) { for (int rp = 0; rp < REPS(1); ++rp) { phase_ln_mod(F); if (rp + 1 < REPS(1)) xcd_barrier(bar); } SEAM(1); }
    if (IN(2)) {
        pg8::Gemm g{(const bf16*)(F.ws + WS_U), (const bf16*)(F.ws + WS_WIN), MA, PINP, D, D, 1 << 30, 0};
        pg8::StaticOrder S; S.init(MA, PINP, F.G, F.bid);
        pg8::EpiBf16 E{Z, PINP};
        pg8::gemm_phase<pg8::EpiBf16, pg8::StaticOrder, true, true>(ring, g, S, E);
        if (DUP(2)) { xcd_barrier(bar); pg8::gemm_phase<pg8::EpiBf16, pg8::StaticOrder, true, true>(ring, g, S, E); }
        { const int t0 = z_tail_first(F.G);
          if (z_early_tiles(F.G) > 0 && F.bid >= t0) { const int nw = (F.G - t0) * NWAVES, w0 = (F.bid - t0) * NWAVES + F.wave;
              for (int k = 0; k < Z_EARLY_PER_WAVE; ++k) cvt_w2_tile(F, w0 + k * nw); } }
        SEAM(2);
    }
    if (IN(3)) {
        phase_rope_vt(F);
        __syncthreads();
        { LAS float* mu = (LAS float*)(F.lds + LDS_MU); for (int e = F.tid; e < 768; e += NTHR) mu[e] = F.in[e < 384 ? 8 : 9][1536 + (e < 384 ? e : e - 384)]; }
        __syncthreads();
#ifdef PROBE_AMODE
        { int hl0 = -1; for (int u = F.bid; u < NB * NCHK * 8; u += F.G) rwkvA_unit<PROBE_AMODE>(F, u, hl0, -1, -1); }
        xcd_barrier(bar);
#endif
        for (int rp = 0; rp < REPS(3); ++rp) { int hl = -1, pre = -1; for (int u = F.bid; u < NB * NCHK * 8; u += F.G) { const int un = u + F.G < NB * NCHK * 8 ? u + F.G : -1; rwkvA_unit<0>(F, u, hl, pre, un); pre = (((u >> 3) % NCHK) < 4) ? 4 : 8; } if (rp + 1 < REPS(3)) xcd_barrier(bar); }
        SEAM(3);
    }
    if (IN(4)) {
        LAS float* rpbs = (LAS float*)F.lds;
        LAS bf16* ck = (LAS bf16*)(F.lds + 16384);
        LAS bf16* cvt = (LAS bf16*)(F.lds + 16384 + 36864);
        for (int e = F.tid; e < 8 * 465 + 224; e += NTHR) rpbs[e] = e < 8 * 465 ? 8.0f * F.in[7][e] : -1e30f;
        {
            const int vb = F.bid, bh = (vb >> 3) & 31, b4 = bh >> 3, h4 = bh & 7, sub = vb & 7;
            { const bf16* Zc = Z + ((size_t)MT + b4 * LC) * PINP + ZK + h4 * 64; const bf16* VTCg = (const bf16*)(F.ws + WS_VT) + VT_LAT_ELEMS + (size_t)bh * 64 * LC;
              for (int e = F.tid; e < 256 * 8; e += NTHR) { const int row = e >> 3, c8 = (e & 7) * 8; *(LAS v4u*)(ck + row * NA_KP + c8) = *(const GAS v4u*)(Zc + (size_t)row * PINP + c8); }
              for (int e = F.tid; e < 64 * 32; e += NTHR) { const int row = e >> 5, c8 = (e & 31) * 8; *(LAS v4u*)(cvt + row * NA_VP + c8) = *(const GAS v4u*)(VTCg + (size_t)row * LC + c8); } }
            __syncthreads();
            if (vb < 256) {
                if (DUP(4)) { if (F.wave > 0) for (int tk = F.wave - 1; tk < 64; tk += 7) na_wave_task(F, (b4 << 12) | ((16 * sub + (tk >> 2)) << 5) | (h4 << 2) | (tk & 3), rpbs, ck, cvt, ZV); }
                if (F.wave == 0) { rwkvB_task(F, vb);
                    { const int ze = z_early_tiles(F.G); for (int w2t = ze + vb; w2t < ze + W2_EARLY_TILES; w2t += 256) cvt_w2_tile(F, w2t); } }
                else { for (int tk = F.wave - 1; tk < 64; tk += 7) na_wave_task(F, (b4 << 12) | ((16 * sub + (tk >> 2)) << 5) | (h4 << 2) | (tk & 3), rpbs, ck, cvt); }
            }
        }
        if (REPS(4) > 1) { xcd_barrier(bar); if (F.wave == 0 && F.bid < 256) rwkvB_task(F, F.bid); }
        SEAM(4);
    }
    if (IN(5)) { for (int rp = 0; rp < REPS(5); ++rp) { phase_readout(F); if (rp + 1 < REPS(5)) xcd_barrier(bar); } SEAM(5); }
    if (IN(6)) {
        pg8::StaticOrder S; S.init(MT, D, F.G, F.bid);
        { pg8::Gemm g{Z + ZQ, (const bf16*)(F.ws + WS_WPA), MT, D, 512, PINP, 1 << 30, 0};
          pg8::EpiGate<0> E{(bf16*)(F.ws + WS_LORA), D, Z + ZGNA, PINP};
          pg8::gemm_phase<pg8::EpiGate<0>, pg8::StaticOrder, true, true>(ring, g, S, E); }
        VM_WAIT(); __syncthreads();
        { pg8::Gemm g{Z + ZK, (const bf16*)(F.ws + WS_WPR), MT, D, 512, PINP, 1 << 30, 0};
          pg8::EpiGate<1> E{(bf16*)(F.ws + WS_LORA), D, Z + ZGRW, PINP};
          pg8::gemm_phase<pg8::EpiGate<1>, pg8::StaticOrder, true, true>(ring, g, S, E); }
        if (DUP(6)) { xcd_barrier(bar);

        { pg8::Gemm g{Z + ZQ, (const bf16*)(F.ws + WS_WPA), MT, D, 512, PINP, 1 << 30, 0};
          pg8::EpiGate<0> E{(bf16*)(F.ws + WS_LORA), D, Z + ZGNA, PINP};
          pg8::gemm_phase<pg8::EpiGate<0>, pg8::StaticOrder, true, true>(ring, g, S, E); }
        VM_WAIT(); __syncthreads();
        { pg8::Gemm g{Z + ZK, (const bf16*)(F.ws + WS_WPR), MT, D, 512, PINP, 1 << 30, 0};
          pg8::EpiGate<1> E{(bf16*)(F.ws + WS_LORA), D, Z + ZGRW, PINP};
          pg8::gemm_phase<pg8::EpiGate<1>, pg8::StaticOrder, true, true>(ring, g, S, E); }
        }
        SEAM(6);
    }
    if (IN(7)) {
        pg8::Gemm g{(const bf16*)(F.ws + WS_LORA), (const bf16*)(F.ws + WS_WO), MT, D, D, D, 1 << 30, 0};
        pg8::StaticOrder S; S.init(MT, D, F.G, F.bid);
        pg8::EpiResid E{F.out, F.in[0], (const float*)(F.ws + WS_MOD) + 2048, 6144, T, ALPHA};
        pg8::gemm_phase<pg8::EpiResid, pg8::StaticOrder, true, true>(ring, g, S, E);
        if (DUP(7)) { xcd_barrier(bar); pg8::gemm_phase<pg8::EpiResid, pg8::StaticOrder, true, true>(ring, g, S, E); }
        SEAM(7);
    }
    if (IN(8)) { if (DUP(8)) { phase_ln1_router(F, (float*)(F.ws + WS_YE)); xcd_barrier(bar); } phase_ln1_router(F); SEAM(8); }
    if (IN(9)) { for (int rp = 0; rp < REPS(9); ++rp) { phase_topk_convert(F); if (rp + 1 < REPS(9)) xcd_barrier(bar); } SEAM(9); }
    if (IN(11)) {
        pg8::Gemm g{(const bf16*)(F.ws + WS_XS), (const bf16*)(F.ws + WS_W13), NSLOT, PINP, D / 2, D / 2, 16, (size_t)PINP * 1024};
        pg8::StaticOrder S; S.init(NSLOT, PINP, F.G, F.bid);
        pg8::EpiSwiglu E{F.ws + WS_HDN, DE, 1.0f / W13_SCALE, HDN_SCALE};
        pg8::gemm_phase<pg8::EpiSwiglu, pg8::StaticOrder, true, true, true>(ring, g, S, E);
        if (DUP(11)) { xcd_barrier(bar); pg8::gemm_phase<pg8::EpiSwiglu, pg8::StaticOrder, true, true, true>(ring, g, S, E); }
        SEAM(11);
    }
    if (IN(12)) {
        pg8::Gemm g{(const bf16*)(F.ws + WS_HDN), (const bf16*)(F.ws + WS_W2), NSLOT, D, DE / 2, DE / 2, 16, (size_t)1024 * DE};
        pg8::StaticOrder S; S.init(NSLOT, D, F.G, F.bid);
        pg8::EpiScaleRow E{(bf16*)(F.ws + WS_YE), D, (const float*)(F.ws + WS_GATEV), 1.0f / (W2_SCALE * HDN_SCALE)};
        pg8::gemm_phase<pg8::EpiScaleRow, pg8::StaticOrder, true, true, true>(ring, g, S, E);
        if (DUP(12)) { xcd_barrier(bar); pg8::gemm_phase<pg8::EpiScaleRow, pg8::StaticOrder, true, true, true>(ring, g, S, E); }
        if (IN(12) && IN(15)) xcd_barrier(bar);
    }
    if (IN(15)) { if (DUP(15)) { phase_final(F, (float*)(F.ws + WS_HDN)); xcd_barrier(bar); } phase_final(F); }
#undef IN
#undef SEAM
}

extern "C" void kernel_launch(void* const* d_in, const int* in_sizes, int n_in, void* d_out, int out_size, void* d_ws, size_t ws_size, hipStream_t stream) {
    static int grid = 0;
    if (grid == 0) {
        if (n_in != 31 || out_size != MT * D || ws_size < WS_END) { fprintf(stderr, "kernel_launch: unexpected shapes (n_in %d, out %d, ws %zu); nothing launched\n", n_in, out_size, ws_size); grid = -1; return; }
        int dev = 0, cus = 0, per_cu = 0;
        if (hipGetDevice(&dev) != hipSuccess || hipDeviceGetAttribute(&cus, hipDeviceAttributeMultiprocessorCount, dev) != hipSuccess) { grid = -1; return; }
        if (hipFuncSetAttribute((const void*)fwd, hipFuncAttributeMaxDynamicSharedMemorySize, LDS_BYTES) != hipSuccess) { fprintf(stderr, "kernel_launch: hipFuncSetAttribute failed\n"); grid = -1; return; }
        if (hipOccupancyMaxActiveBlocksPerMultiprocessor(&per_cu, (const void*)fwd, NTHR, LDS_BYTES) != hipSuccess || per_cu < 1) fprintf(stderr, "kernel_launch: occupancy query reports %d\n", per_cu);
        (void)hipGetLastError();
        grid = cus;
        if (grid < 256) { fprintf(stderr, "kernel_launch: this kernel needs >= 256 CUs (got %d); nothing launched\n", cus); grid = -1; return; }
    }
    if (grid < 0) return;
    (void)hipMemsetAsync((char*)d_ws + WS_CTL, 0, CTL_ZERO_BYTES, stream);
    Args a{};
    for (int i = 0; i < 31; ++i) a.in[i] = (const float*)d_in[i];
    a.out = (float*)d_out; a.ws = (unsigned char*)d_ws;
#if MK_ONE_LAUNCH
    a.ph_lo = 0; a.ph_hi = 16;
    hipLaunchKernelGGL(fwd, dim3(grid), dim3(NTHR), LDS_BYTES, stream, a);
#else
    for (int p = 0; p < 16; ++p) { a.ph_lo = p; a.ph_hi = p + 1; hipLaunchKernelGGL(fwd, dim3(grid), dim3(NTHR), LDS_BYTES, stream, a); }
#endif
}
```

```cpp
#include <hip/hip_runtime.h>
#include <cstdio>
#include <cstdint>

#ifndef PROBE_REP
#define PROBE_REP 0
#endif
#define REPS(k) (((PROBE_REP >> (k)) & 1) ? 2 : 1)
#ifndef PROBE_DUP
#define PROBE_DUP 0
#endif
#define DUP(k) ((PROBE_DUP >> (k)) & 1)
#ifndef MK_ONE_LAUNCH
#define MK_ONE_LAUNCH 1
#endif

namespace pg8 {
#define PG8_LAS __attribute__((address_space(3)))
typedef unsigned short bf16_t;
typedef short bf16x8 __attribute__((ext_vector_type(8)));
typedef float f32x4 __attribute__((ext_vector_type(4)));
typedef unsigned u32x4 __attribute__((ext_vector_type(4)));
typedef unsigned u32x2 __attribute__((ext_vector_type(2)));
constexpr int BM = 256, BK = 64, HALF = 128, HTB = HALF * BK * 2, STAGE_BYTES = 8 * HTB, NXCD = 8, WGM = 8;

__host__ __device__ __forceinline__ int lds_byte(int r, int c) { const int st = (r >> 4) * 2 + (c >> 5), rr = r & 15, cc = c & 31, ob = rr * 64 + cc * 2; return st * 1024 + (ob ^ (((ob >> 9) & 1) << 5)); }
__host__ __device__ __forceinline__ void stage_rc(int b, int& R, int& C) { const int st = b / 1024, sb = b % 1024, swz = sb ^ (((sb >> 9) & 1) << 5); R = (st >> 1) * 16 + swz / 64; C = (st & 1) * 32 + (swz % 64) / 2; }
__host__ __device__ __forceinline__ int perm32(int rho) { const int n = rho >> 4, i = rho & 15; return 8 * (i >> 2) + 4 * n + (i & 3); }

struct Unit { int pm, pn; };
struct Gemm { const bf16_t* A; const bf16_t* Bt; int M, N, K, lda; int pmg; size_t bgs; };

struct StaticOrder {
    int nM, nN, nwg, G, c;
    __host__ __device__ void init(int M, int N, int G_, int c_) { nM = M / BM; nN = N / BM; nwg = nM * nN; G = G_; c = c_; }
    __host__ __device__ bool next(int i, Unit& u) const {
        const long L = (long)i * G + c; if (L >= nwg) return false;
        int wgid = (int)L; { const int q = nwg / NXCD, r = nwg % NXCD, xcd = wgid % NXCD, off = wgid / NXCD; wgid = (xcd < r ? xcd * (q + 1) : r * (q + 1) + (xcd - r) * q) + off; }
        const int nig = WGM * nN, gid = wgid / nig, fm = gid * WGM, gsz = (nM - fm) < WGM ? (nM - fm) : WGM;
        u.pm = fm + ((wgid % nig) % gsz); u.pn = (wgid % nig) / gsz; return true;
    }
    __device__ __forceinline__ void a_ready(const Unit&) const {}
    __device__ __forceinline__ void done(const Unit&) const {}
};

typedef __bf16 bf16x2_t __attribute__((ext_vector_type(2)));
typedef float f32x2_t __attribute__((ext_vector_type(2)));
__device__ __forceinline__ unsigned cvt_pk_bf16(float lo, float hi) { const f32x2_t v = {lo, hi}; const bf16x2_t b = __builtin_convertvector(v, bf16x2_t); return __builtin_bit_cast(unsigned, b); }
__device__ __forceinline__ float bf_lo(unsigned w) { return __uint_as_float(w << 16); }
__device__ __forceinline__ float bf_hi(unsigned w) { return __uint_as_float(w & 0xffff0000u); }
__device__ __forceinline__ float sigmoidf_(float x) { return __builtin_amdgcn_rcpf(1.0f + __expf(-x)); }

struct EpiBf16 {
    static constexpr bool PERM = true;
    bf16_t* O; int ldc;
    __device__ __forceinline__ void operator()(const f32x4 (&acc)[2][2][4][2], const Unit& u, int wr, int wc, int fr, int fq) const {
        const int row0 = u.pm * BM + wr * 64 + fr, col0 = u.pn * BM + wc * 32 + 8 * fq;
#pragma unroll
        for (int ai = 0; ai < 2; ++ai)
#pragma unroll
            for (int m = 0; m < 4; ++m) { bf16_t* rowp = O + (size_t)(row0 + ai * HALF + m * 16) * ldc + col0;
#pragma unroll
                for (int bj = 0; bj < 2; ++bj) { const f32x4 v0 = acc[ai][bj][m][0], v1 = acc[ai][bj][m][1];
                    u32x4 w; w.x = cvt_pk_bf16(v0[0], v0[1]); w.y = cvt_pk_bf16(v0[2], v0[3]); w.z = cvt_pk_bf16(v1[0], v1[1]); w.w = cvt_pk_bf16(v1[2], v1[3]);
                    *(u32x4*)(rowp + bj * HALF) = w; } }
    }
};
template <int MODE> struct EpiGate {
    static constexpr bool PERM = true;
    bf16_t* O; int ldc; const bf16_t* G; int ldg;
    __device__ __forceinline__ void operator()(const f32x4 (&acc)[2][2][4][2], const Unit& u, int wr, int wc, int fr, int fq) const {
        const int row0 = u.pm * BM + wr * 64 + fr, col0 = u.pn * BM + wc * 32 + 8 * fq;
#pragma unroll
        for (int ai = 0; ai < 2; ++ai)
#pragma unroll
            for (int m = 0; m < 4; ++m) { const size_t row = (size_t)(row0 + ai * HALF + m * 16);
#pragma unroll
                for (int bj = 0; bj < 2; ++bj) { const f32x4 v0 = acc[ai][bj][m][0], v1 = acc[ai][bj][m][1];
                    const u32x4 gz = *(const u32x4*)(G + row * ldg + col0 + bj * HALF);
                    float o[8];
                    o[0] = sigmoidf_(bf_lo(gz.x)) * v0[0]; o[1] = sigmoidf_(bf_hi(gz.x)) * v0[1]; o[2] = sigmoidf_(bf_lo(gz.y)) * v0[2]; o[3] = sigmoidf_(bf_hi(gz.y)) * v0[3];
                    o[4] = sigmoidf_(bf_lo(gz.z)) * v1[0]; o[5] = sigmoidf_(bf_hi(gz.z)) * v1[1]; o[6] = sigmoidf_(bf_lo(gz.w)) * v1[2]; o[7] = sigmoidf_(bf_hi(gz.w)) * v1[3];
                    bf16_t* op = O + row * ldc + col0 + bj * HALF;
                    if (MODE == 1) { const u32x4 pz = *(const u32x4*)op;
                        o[0] += bf_lo(pz.x); o[1] += bf_hi(pz.x); o[2] += bf_lo(pz.y); o[3] += bf_hi(pz.y); o[4] += bf_lo(pz.z); o[5] += bf_hi(pz.z); o[6] += bf_lo(pz.w); o[7] += bf_hi(pz.w); }
                    u32x4 w; w.x = cvt_pk_bf16(o[0], o[1]); w.y = cvt_pk_bf16(o[2], o[3]); w.z = cvt_pk_bf16(o[4], o[5]); w.w = cvt_pk_bf16(o[6], o[7]);
                    *(u32x4*)op = w; } }
    }
};
struct EpiResid {
    static constexpr bool PERM = false;
    float* O; const float* X; const float* gt; int gt_pitch; int rows_per_b; float alpha;
    __device__ __forceinline__ void operator()(const f32x4 (&acc)[2][2][4][2], const Unit& u, int wr, int wc, int fr, int fq) const {
        const int row0 = u.pm * BM + wr * 64 + fr, col0 = u.pn * BM + wc * 32 + 4 * fq;
        const float* gtb = gt + (size_t)((u.pm * BM) / rows_per_b) * gt_pitch + col0;
        f32x4 gv[2][2];
#pragma unroll
        for (int bj = 0; bj < 2; ++bj)
#pragma unroll
            for (int n = 0; n < 2; ++n) gv[bj][n] = *(const f32x4*)(gtb + bj * HALF + n * 16);
#pragma unroll
        for (int ai = 0; ai < 2; ++ai)
#pragma unroll
            for (int m = 0; m < 4; ++m) { const size_t off = (size_t)(row0 + ai * HALF + m * 16) * 1024 + col0;
#pragma unroll
                for (int bj = 0; bj < 2; ++bj)
#pragma unroll
                    for (int n = 0; n < 2; ++n) { const f32x4 xv = *(const f32x4*)(X + off + bj * HALF + n * 16);
                        *(f32x4*)(O + off + bj * HALF + n * 16) = xv * alpha + gv[bj][n] * acc[ai][bj][m][n]; } }
    }
};
struct EpiSwiglu {
    static constexpr bool PERM = true;
    unsigned char* H; int ldh; float as, hs;
    __device__ __forceinline__ void operator()(const f32x4 (&acc)[2][2][4][2], const Unit& u, int wr, int wc, int fr, int fq) const {
        const int row0 = u.pm * BM + wr * 64 + fr, col0 = u.pn * HALF + wc * 32 + 8 * fq;
#pragma unroll
        for (int ai = 0; ai < 2; ++ai)
#pragma unroll
            for (int m = 0; m < 4; ++m) { unsigned char* rowp = H + (size_t)(row0 + ai * HALF + m * 16) * ldh + col0;
                float o[8];
#pragma unroll
                for (int n = 0; n < 2; ++n)
#pragma unroll
                    for (int j = 0; j < 4; ++j) { const float a = acc[ai][0][m][n][j] * as, b = acc[ai][1][m][n][j] * as; o[n * 4 + j] = fminf(fmaxf(a * sigmoidf_(a) * b * hs, -448.f), 448.f); }
                u32x2 w; w.x = (unsigned)__builtin_amdgcn_cvt_pk_fp8_f32(o[2], o[3], __builtin_amdgcn_cvt_pk_fp8_f32(o[0], o[1], 0, false), true);
                w.y = (unsigned)__builtin_amdgcn_cvt_pk_fp8_f32(o[6], o[7], __builtin_amdgcn_cvt_pk_fp8_f32(o[4], o[5], 0, false), true);
                *(u32x2*)rowp = w; }
    }
};
struct EpiScaleRow {
    static constexpr bool PERM = true;
    bf16_t* O; int ldc; const float* gate; float sc;
    __device__ __forceinline__ void operator()(const f32x4 (&acc)[2][2][4][2], const Unit& u, int wr, int wc, int fr, int fq) const {
        const int row0 = u.pm * BM + wr * 64 + fr, col0 = u.pn * BM + wc * 32 + 8 * fq;
#pragma unroll
        for (int ai = 0; ai < 2; ++ai)
#pragma unroll
            for (int m = 0; m < 4; ++m) { const int row = row0 + ai * HALF + m * 16; const float gsc = gate[row] * sc; bf16_t* rowp = O + (size_t)row * ldc + col0;
#pragma unroll
                for (int bj = 0; bj < 2; ++bj) { const f32x4 v0 = acc[ai][bj][m][0] * gsc, v1 = acc[ai][bj][m][1] * gsc;
                    u32x4 w; w.x = cvt_pk_bf16(v0[0], v0[1]); w.y = cvt_pk_bf16(v0[2], v0[3]); w.z = cvt_pk_bf16(v1[0], v1[1]); w.w = cvt_pk_bf16(v1[2], v1[3]);
                    *(u32x4*)(rowp + bj * HALF) = w; } }
    }
};

typedef int v8i_t __attribute__((ext_vector_type(8)));
typedef int v4i_t __attribute__((ext_vector_type(4)));
template <class Epi, class Sched, bool ALIGN_EPI = false, bool SP2 = false, bool FP8 = false>
__device__ __forceinline__ void gemm_phase(PG8_LAS unsigned char* lds, const Gemm g, const Sched& S, const Epi& E) {
    const int tid = threadIdx.x, wid = __builtin_amdgcn_readfirstlane(tid >> 6), lane = tid & 63, wr = wid >> 2, wc = wid & 3, fr = lane & 15, fq = lane >> 4;
    const int K = g.K, nt = K / BK;
    unsigned voffA[2], voffB[2];
#pragma unroll
    for (int i = 0; i < 2; ++i) { int R, C; stage_rc(tid * 16 + i * 8192, R, C); const int Rb = Epi::PERM ? ((R & ~31) + perm32(R & 31)) : R;
        voffA[i] = (unsigned)(R * g.lda + C) * 2u; voffB[i] = (unsigned)(Rb * K + C) * 2u; }
    const size_t kstep = (size_t)(BK * 2);
    const size_t hstepA = (size_t)HALF * g.lda * 2, tstepA = 2 * hstepA;
    const size_t hstepB = (size_t)HALF * K * 2, tstepB = 2 * hstepB;
    const unsigned ldsw = (unsigned)wid * 1024u;
    const int aoff = lds_byte(wr * 64 + fr, fq * 8), boff = lds_byte(wc * 32 + fr, fq * 8);
#define PG8_SA(b, h) (((b) * 2 + (h)) * HTB)
#define PG8_SB(b, h) ((4 + (b) * 2 + (h)) * HTB)
#define PG8_STAGE(bufoff, gbase, voff) do { _Pragma("unroll") for (int _i = 0; _i < 2; ++_i) \
        __builtin_amdgcn_global_load_lds((const unsigned*)((const char*)(gbase) + (voff)[_i]), (PG8_LAS unsigned*)(lds + (bufoff) + ldsw + _i * 8192), 16, 0, 0); } while (0)
#define PG8_LDA(dst, b, h) do { if constexpr (FP8) { _Pragma("unroll") for (int m = 0; m < 4; ++m) dst##8[m] = __builtin_shufflevector(*(const PG8_LAS v4i_t*)(lds + PG8_SA(b, h) + aoff + m * 2048), *(const PG8_LAS v4i_t*)(lds + PG8_SA(b, h) + aoff + m * 2048 + 1024), 0, 1, 2, 3, 4, 5, 6, 7); } \
    else { _Pragma("unroll") for (int m = 0; m < 4; ++m) _Pragma("unroll") for (int k = 0; k < 2; ++k) dst[m][k] = *(const PG8_LAS bf16x8*)(lds + PG8_SA(b, h) + aoff + m * 2048 + k * 1024); } } while (0)
#define PG8_LDB(dst, b, h) do { if constexpr (FP8) { _Pragma("unroll") for (int n = 0; n < 2; ++n) dst##8[n] = __builtin_shufflevector(*(const PG8_LAS v4i_t*)(lds + PG8_SB(b, h) + boff + n * 2048), *(const PG8_LAS v4i_t*)(lds + PG8_SB(b, h) + boff + n * 2048 + 1024), 0, 1, 2, 3, 4, 5, 6, 7); } \
    else { _Pragma("unroll") for (int n = 0; n < 2; ++n) _Pragma("unroll") for (int k = 0; k < 2; ++k) dst[n][k] = *(const PG8_LAS bf16x8*)(lds + PG8_SB(b, h) + boff + n * 2048 + k * 1024); } } while (0)
#define PG8_MMA(ai, bj, At, Bt) do { __builtin_amdgcn_s_setprio(1); _Pragma("unroll") for (int m = 0; m < 4; ++m) _Pragma("unroll") for (int n = 0; n < 2; ++n) { \
        if constexpr (FP8) { asm volatile("v_mfma_scale_f32_16x16x128_f8f6f4 %0, %1, %2, %0, %3, %3 op_sel_hi:[0,0,0]" : "+v"(acc[ai][bj][m][n]) : "v"(Bt##8[n]), "v"(At##8[m]), "v"(sc1)); } \
        else { _Pragma("unroll") for (int k = 0; k < 2; ++k) acc[ai][bj][m][n] = __builtin_amdgcn_mfma_f32_16x16x32_bf16(Bt[n][k], At[m][k], acc[ai][bj][m][n], 0, 0, 0); } } \
        __builtin_amdgcn_s_setprio(0); } while (0)
#define PG8_WAIT_V(n) asm volatile("s_waitcnt vmcnt(" #n ")" ::: "memory")
#define PG8_WAIT_L(n) asm volatile("s_waitcnt lgkmcnt(" #n ")" ::: "memory")
#define PG8_BAR __builtin_amdgcn_s_barrier()
#define PG8_SCHED __builtin_amdgcn_sched_barrier(0)
    Unit cur, nxt; int ui = 0;
    if (!S.next(0, cur)) return;
    f32x4 acc[2][2][4][2];
#pragma unroll
    for (int a = 0; a < 2; ++a)
#pragma unroll
        for (int b = 0; b < 2; ++b)
#pragma unroll
            for (int m = 0; m < 4; ++m)
#pragma unroll
                for (int n = 0; n < 2; ++n) acc[a][b][m][n] = (f32x4){0.f, 0.f, 0.f, 0.f};
    bf16x8 At[4][2], B0[2][2], B1[2][2]; v8i_t At8[4], B08[2], B18[2]; const int sc1 = 0x7f7f7f7f;
    const char* cA = (const char*)g.A + (size_t)cur.pm * tstepA; const char* cB = (const char*)g.Bt + (size_t)cur.pn * tstepB + (size_t)(cur.pm / g.pmg) * g.bgs;
    S.a_ready(cur);
    if constexpr (SP2) {
        PG8_STAGE(PG8_SB(0, 0), cB, voffB); PG8_STAGE(PG8_SB(0, 1), cB + hstepB, voffB); PG8_STAGE(PG8_SA(0, 0), cA, voffA); PG8_STAGE(PG8_SA(0, 1), cA + hstepA, voffA);
        if (wr == 1) PG8_BAR;
        PG8_WAIT_V(2); PG8_BAR;
        PG8_STAGE(PG8_SB(1, 0), cB + kstep, voffB); PG8_STAGE(PG8_SA(1, 0), cA + kstep, voffA); PG8_STAGE(PG8_SB(1, 1), cB + hstepB + kstep, voffB);
        PG8_WAIT_V(6); PG8_BAR;
    } else {
        PG8_STAGE(PG8_SB(0, 0), cB, voffB); PG8_STAGE(PG8_SA(0, 0), cA, voffA); PG8_STAGE(PG8_SB(0, 1), cB + hstepB, voffB); PG8_STAGE(PG8_SA(0, 1), cA + hstepA, voffA);
        if (wr == 1) PG8_BAR;
        PG8_WAIT_V(4); PG8_BAR;
        PG8_STAGE(PG8_SB(1, 0), cB + kstep, voffB); PG8_STAGE(PG8_SA(1, 0), cA + kstep, voffA); PG8_STAGE(PG8_SB(1, 1), cB + hstepB + kstep, voffB);
        PG8_WAIT_V(6); PG8_BAR;
    }
    for (;;) {
        const bool has_next = S.next(ui + 1, nxt);
        const char* nA = has_next ? (const char*)g.A + (size_t)nxt.pm * tstepA : cA;
        const char* nB = has_next ? (const char*)g.Bt + (size_t)nxt.pn * tstepB + (size_t)(nxt.pm / g.pmg) * g.bgs : cB;
        for (int t = 0; t < nt; t += 2) {
            const bool last = (t == nt - 2);
            const char* a1 = cA + (size_t)(t + 1) * kstep;
            const char* a2 = last ? nA : cA + (size_t)(t + 2) * kstep; const char* b2 = last ? nB : cB + (size_t)(t + 2) * kstep;
            const char* a3 = a2 + kstep; const char* b3 = b2 + kstep;
            if (last && has_next) S.a_ready(nxt);
            if constexpr (SP2) {
            PG8_LDB(B0, 0, 0); PG8_LDB(B1, 0, 1); PG8_SCHED; PG8_LDA(At, 0, 0); PG8_STAGE(PG8_SA(1, 1), a1 + hstepA, voffA);
            PG8_WAIT_V(8); PG8_WAIT_L(0); PG8_BAR; PG8_MMA(0, 0, At, B0); PG8_MMA(0, 1, At, B1); PG8_BAR; PG8_SCHED;
            PG8_LDA(At, 0, 1); PG8_STAGE(PG8_SB(0, 0), b2, voffB); PG8_STAGE(PG8_SB(0, 1), b2 + hstepB, voffB); PG8_STAGE(PG8_SA(0, 0), a2, voffA);
            PG8_WAIT_V(8); PG8_WAIT_L(0); PG8_BAR; PG8_MMA(1, 0, At, B0); PG8_MMA(1, 1, At, B1); PG8_BAR; PG8_SCHED;
            PG8_LDB(B0, 1, 0); PG8_LDB(B1, 1, 1); PG8_SCHED; PG8_LDA(At, 1, 0); PG8_STAGE(PG8_SA(0, 1), a2 + hstepA, voffA);
            PG8_WAIT_V(8); PG8_WAIT_L(0); PG8_BAR; PG8_MMA(0, 0, At, B0); PG8_MMA(0, 1, At, B1); PG8_BAR; PG8_SCHED;
            PG8_LDA(At, 1, 1); PG8_STAGE(PG8_SB(1, 0), b3, voffB); PG8_STAGE(PG8_SB(1, 1), b3 + hstepB, voffB); PG8_STAGE(PG8_SA(1, 0), a3, voffA);
            PG8_WAIT_V(8); PG8_WAIT_L(0); PG8_BAR; PG8_MMA(1, 0, At, B0); PG8_MMA(1, 1, At, B1); PG8_BAR; PG8_SCHED;
            } else {
            PG8_LDB(B0, 0, 0); PG8_SCHED; PG8_LDA(At, 0, 0); PG8_STAGE(PG8_SA(1, 1), a1 + hstepA, voffA);
            PG8_WAIT_L(8); PG8_BAR; PG8_WAIT_L(0); PG8_MMA(0, 0, At, B0); PG8_BAR; PG8_SCHED;
            PG8_LDB(B1, 0, 1); PG8_STAGE(PG8_SB(0, 0), b2, voffB);
            PG8_BAR; PG8_WAIT_L(0); PG8_MMA(0, 1, At, B1); PG8_BAR;
            PG8_LDA(At, 0, 1); PG8_STAGE(PG8_SA(0, 0), a2, voffA);
            PG8_BAR; PG8_WAIT_L(0); PG8_MMA(1, 0, At, B0); PG8_BAR; PG8_SCHED;
            PG8_STAGE(PG8_SB(0, 1), b2 + hstepB, voffB);
            PG8_WAIT_V(6); PG8_BAR; PG8_MMA(1, 1, At, B1); PG8_BAR;
            PG8_LDB(B0, 1, 0); PG8_SCHED; PG8_LDA(At, 1, 0); PG8_STAGE(PG8_SA(0, 1), a2 + hstepA, voffA);
            PG8_WAIT_L(8); PG8_BAR; PG8_WAIT_L(0); PG8_MMA(0, 0, At, B0); PG8_BAR; PG8_SCHED;
            PG8_LDB(B1, 1, 1); PG8_STAGE(PG8_SB(1, 0), b3, voffB);
            PG8_BAR; PG8_WAIT_L(0); PG8_MMA(0, 1, At, B1); PG8_BAR;
            PG8_LDA(At, 1, 1); PG8_STAGE(PG8_SA(1, 0), a3, voffA);
            PG8_BAR; PG8_WAIT_L(0); PG8_MMA(1, 0, At, B0); PG8_BAR; PG8_SCHED;
            PG8_STAGE(PG8_SB(1, 1), b3 + hstepB, voffB);
            PG8_WAIT_V(6); PG8_BAR; PG8_MMA(1, 1, At, B1); PG8_BAR;
            }
        }
        if constexpr (ALIGN_EPI) { if (wr == 0) PG8_BAR; }
        if constexpr (FP8) asm volatile("s_nop 15\n\ts_nop 15" ::: "memory");
        E(acc, cur, wr, wc, fr, fq); S.done(cur);
        if (!has_next) break;
#pragma unroll
        for (int a = 0; a < 2; ++a)
#pragma unroll
            for (int b = 0; b < 2; ++b)
#pragma unroll
                for (int m = 0; m < 4; ++m)
#pragma unroll
                    for (int n = 0; n < 2; ++n) acc[a][b][m][n] = (f32x4){0.f, 0.f, 0.f, 0.f};
        cur = nxt; cA = nA; cB = nB; ++ui;
        if constexpr (FP8) asm volatile("s_nop 7" ::: "memory");
        if constexpr (ALIGN_EPI) { if (wr == 1) PG8_BAR; }
    }
    PG8_WAIT_V(0);
    if constexpr (!ALIGN_EPI) { if (wr == 0) PG8_BAR; }
    PG8_BAR;
#undef PG8_SA
#undef PG8_SB
#undef PG8_STAGE
#undef PG8_LDA
#undef PG8_LDB
#undef PG8_MMA
#undef PG8_WAIT_V
#undef PG8_WAIT_L
#undef PG8_BAR
#undef PG8_SCHED
}
}

constexpr int NWAVES = 8, NTHR = 512;
constexpr int NB = 4, T = 8192, D = 1024, LC = 256, GW = 64, GH = 128;
constexpr int MT = NB * T, MC = NB * LC, MA = MT + MC;
constexpr int PIN = 5504, PINP = 5632;
constexpr int ZQ = 0, ZK = 512, ZV = 1024, ZRW = 1536, ZR = 1536, ZRK = 2048, ZRV = 2560, ZLORA = 3072, ZG = 3456, ZGNA = 3456, ZGRW = 4480;
constexpr int NE = 16, CAP = 1024, DE = 2816, NSLOT = NB * NE * CAP;
constexpr float ALPHA = 1.189207115f;
constexpr float LN_EPS = 1e-6f, GN_EPS = 64e-5f;
constexpr int LORAW = 2560;

constexpr size_t MiB = 1u << 20;
constexpr size_t WS_CTL = 0, CTL_ZERO_BYTES = 1 * MiB;
constexpr size_t WS_MOD = 1 * MiB;
constexpr size_t WS_WIN = 2 * MiB;
constexpr size_t WS_WPA = 13 * MiB, WS_WPR = 14 * MiB, WS_WO = 15 * MiB;
constexpr size_t WS_AFF = 17 * MiB;
constexpr size_t WS_IDX = 19 * MiB;
constexpr size_t WS_GATEV = 19 * MiB + 256 * 1024;
constexpr size_t WS_SLOT = 20 * MiB;
constexpr size_t WS_U = 22 * MiB;
constexpr size_t WS_Z = 88 * MiB;
constexpr size_t WS_LORA = 451 * MiB;
constexpr size_t WS_ROPE = 1 * MiB + 128 * 1024;
constexpr size_t WS_LW = 1 * MiB + 512 * 1024;
constexpr size_t WS_COEF = 17 * MiB;
constexpr size_t WS_YFB = 22 * MiB;
constexpr size_t WS_PQ = 451 * MiB;
constexpr size_t WS_G = 583 * MiB;
constexpr size_t WS_VT = 616 * MiB;
constexpr size_t WS_END1 = 616 * MiB;
constexpr size_t WS_U2 = 22 * MiB;
constexpr size_t WS_W13 = 54 * MiB;
constexpr size_t WS_W2 = 654 * MiB;
constexpr size_t WS_XS = 186 * MiB;
constexpr size_t WS_HDN = 250 * MiB;
constexpr size_t WS_YE = 426 * MiB;
constexpr float W13_SCALE = 64.f, W2_SCALE = 128.f, HDN_SCALE = 8.f;
constexpr size_t WS_END = 698 * MiB;
constexpr int W2_EARLY_TILES = 256 * 12;
static_assert(WS_VT + (size_t)34 * MiB <= WS_END, "ws map");
constexpr size_t VT_LAT_ELEMS = (size_t)NB * 8 * 64 * T, VT_CTX_ELEMS = (size_t)NB * 8 * 64 * LC;

constexpr int RING_BYTES = 131072, LDS_BYTES = 147456, LDSCTL_OFF = LDS_BYTES - 512, MISC_OFF = LDSCTL_OFF + 320;

#define GAS __attribute__((address_space(1)))
#define LAS __attribute__((address_space(3)))
typedef unsigned short bf16;
typedef unsigned v4u __attribute__((ext_vector_type(4)));
typedef unsigned v2u __attribute__((ext_vector_type(2)));
typedef float f32x4 __attribute__((ext_vector_type(4)));
typedef float f32x2 __attribute__((ext_vector_type(2)));
typedef short bf16x8 __attribute__((ext_vector_type(8)));
typedef short bf16x4 __attribute__((ext_vector_type(4)));
typedef GAS unsigned gu32;
#define RLX_AGENT __ATOMIC_RELAXED, __HIP_MEMORY_SCOPE_AGENT
#define LDS_WAIT() asm volatile("s_waitcnt lgkmcnt(0)" ::: "memory")
#define VM_WAIT() asm volatile("s_waitcnt vmcnt(0)" ::: "memory")
__device__ __forceinline__ unsigned f2bf(float f) { return pg8::cvt_pk_bf16(f, f) & 0xffffu; }
__device__ __forceinline__ unsigned pk2(float lo, float hi) { return pg8::cvt_pk_bf16(lo, hi); }
__device__ __forceinline__ float bf2f(bf16 b) { return __uint_as_float(((unsigned)b) << 16); }
__device__ __forceinline__ float bflo(unsigned w) { return __uint_as_float(w << 16); }
__device__ __forceinline__ float bfhi(unsigned w) { return __uint_as_float(w & 0xffff0000u); }
__device__ __forceinline__ float sigm(float x) { return __builtin_amdgcn_rcpf(1.0f + __expf(-x)); }

#define XB_TMO      128
#define XB_XCNT(j)  (256  + 64 * (j))
#define XB_XSUB(j)  (1280 + 64 * (j))
#define XB_XGEN(j)  (2304 + 64 * (j))
#define XB_TOP      3328
#define XB_TOPGEN   3392
#define XCD_BAR_WORDS 3456
#define XB_SPIN_CAP (1u << 18)
__device__ __forceinline__ unsigned xb_ld(unsigned* p)              { return __hip_atomic_load(p, __ATOMIC_RELAXED, __HIP_MEMORY_SCOPE_AGENT); }
__device__ __forceinline__ unsigned xb_add(unsigned* p, unsigned v) { return __hip_atomic_fetch_add(p, v, __ATOMIC_RELAXED, __HIP_MEMORY_SCOPE_AGENT); }
__device__ __forceinline__ unsigned xb_xcc_id() { return (unsigned)__builtin_amdgcn_s_getreg((3 << 11) | 20) & 0xFu; }
#define XB_SPIN(cond, bar) do { unsigned _sp = 0; while (cond) { __builtin_amdgcn_s_sleep(1); \
    if ((++_sp & 255u) == 0u) { if (xb_ld(&(bar)[XB_TMO])) break; if (_sp > XB_SPIN_CAP) { atomicAdd(&(bar)[XB_TMO], 1u); break; } } } } while (0)
struct XcdBarrier { unsigned* bar; unsigned x; volatile LAS unsigned* st; };
__device__ __forceinline__ XcdBarrier xcd_barrier_post(unsigned* bar, volatile LAS unsigned* st) {
    XcdBarrier b; b.bar = bar; b.x = xb_xcc_id(); b.st = st;
    if (threadIdx.x == 0) (void)xb_add(&bar[XB_XCNT(b.x)], 1u);
    return b;
}
__device__ __forceinline__ void xcd_barrier_complete(unsigned* bar, unsigned x, unsigned& nloc, unsigned& nx) {
    const unsigned G = gridDim.x * gridDim.y * gridDim.z;
    unsigned sum, cnt, mine, sp = 0u;
    for (;;) {
        sum = 0u; cnt = 0u; mine = 0u;
#pragma unroll
        for (unsigned j = 0; j < 16; ++j) { const unsigned c = xb_ld(&bar[XB_XCNT(j)]); sum += c; cnt += (c > 0u) ? 1u : 0u; mine = (j == x) ? c : mine; }
        if (sum == G) break;
        __builtin_amdgcn_s_sleep(1);
        if ((++sp & 255u) == 0u) { if (xb_ld(&bar[XB_TMO])) break; if (sp > XB_SPIN_CAP) { atomicAdd(&bar[XB_TMO], 1u); break; } }
    }
    nloc = mine > 0u ? mine : 1u; nx = cnt > 0u ? cnt : 1u;
}
__device__ __forceinline__ void xcd_barrier(const XcdBarrier& b) {
    asm volatile("s_waitcnt vmcnt(0)" ::: "memory");
    __syncthreads();
    if (threadIdx.x == 0) {
        unsigned* bar = b.bar;
        __builtin_amdgcn_s_waitcnt(0);
        unsigned nloc = b.st[0], nx = b.st[1];
        if (nloc == 0u) { xcd_barrier_complete(bar, b.x, nloc, nx); b.st[0] = nloc; b.st[1] = nx; }
        const unsigned old = xb_add(&bar[XB_XSUB(b.x)], 1u);
        const unsigned gen = old / nloc;
        if (old + 1u == (gen + 1u) * nloc) {
            __builtin_amdgcn_fence(__ATOMIC_RELEASE, "agent");
            asm volatile("s_waitcnt vmcnt(0)" ::: "memory");
#pragma unroll
            for (unsigned j = 0; j < 16; ++j) (void)xb_add(&bar[XB_XGEN(j)], 1u);
        }
        const unsigned target = (gen + 1u) * nx;
        XB_SPIN(xb_ld(&bar[XB_XGEN(b.x)]) < target, bar);
        __builtin_amdgcn_fence(__ATOMIC_ACQUIRE, "agent");
        asm volatile("s_waitcnt vmcnt(0)" ::: "memory");
    }
    __syncthreads();
}
constexpr int CW_BAR = 4096;

template <int CTRL> __device__ __forceinline__ float dppf(float v) { return __builtin_bit_cast(float, __builtin_amdgcn_update_dpp(0, __builtin_bit_cast(int, v), CTRL, 0xF, 0xF, true)); }
__device__ __forceinline__ float row16_sum(float v) {
    v += dppf<0xB1>(v);
    v += dppf<0x4E>(v);
    v += dppf<0x141>(v);
    v += dppf<0x140>(v);
    return v;
}

__device__ __forceinline__ float wave_sum(float v) { v = row16_sum(v); v += __shfl_xor(v, 16); v += __shfl_xor(v, 32); return v; }

__device__ __forceinline__ void unpack8(v4u w, float (&o)[8]) { o[0] = bflo(w.x); o[1] = bfhi(w.x); o[2] = bflo(w.y); o[3] = bfhi(w.y); o[4] = bflo(w.z); o[5] = bfhi(w.z); o[6] = bflo(w.w); o[7] = bfhi(w.w); }
__device__ __forceinline__ v4u pack8(const float (&v)[8]) { v4u o; o.x = pg8::cvt_pk_bf16(v[0], v[1]); o.y = pg8::cvt_pk_bf16(v[2], v[3]); o.z = pg8::cvt_pk_bf16(v[4], v[5]); o.w = pg8::cvt_pk_bf16(v[6], v[7]); return o; }
struct Frame {
    LAS unsigned char* lds;
    int tid, lane, wave, G, bid;
    const float* in[31]; float* out; unsigned char* ws;
};

__device__ __forceinline__ void transpose_item(const float* W, int N, int k0, int n0, bf16* WT, size_t dst_row0, int dpitch, LAS float* scr, int lane) {
#pragma unroll 8
    for (int i = 0; i < 32; ++i) { const int kk = 2 * i + (lane >> 5); scr[kk * 33 + (lane & 31)] = W[(size_t)(k0 + kk) * N + n0 + (lane & 31)]; }
    LDS_WAIT(); asm volatile("" ::: "memory");
    const int c = lane & 7;
#pragma unroll
    for (int j = 0; j < 4; ++j) { const int n = (lane >> 3) + 8 * j; const LAS float* s = scr + (8 * c) * 33 + n;
        v4u o; o.x = pk2(s[0 * 33], s[1 * 33]); o.y = pk2(s[2 * 33], s[3 * 33]); o.z = pk2(s[4 * 33], s[5 * 33]); o.w = pk2(s[6 * 33], s[7 * 33]);
        *(GAS v4u*)(WT + (dst_row0 + n) * dpitch + k0 + 8 * c) = o; }
    LDS_WAIT(); asm volatile("" ::: "memory");
}

__device__ __forceinline__ void cvt_tile64(const float* W, int N, int k0, int n0, bf16* WT, size_t dst_row0, int dpitch, int lane) {
    const int c = lane & 15, kq = lane >> 4;
    const float* src = W + (size_t)(k0 + 16 * kq) * N + n0 + 4 * c;
    f32x4 x[16];
#pragma unroll
    for (int j = 0; j < 16; ++j) x[j] = __builtin_nontemporal_load((const GAS f32x4*)(src + (size_t)j * N));
#pragma unroll
    for (int e = 0; e < 4; ++e) { bf16* dst = WT + (dst_row0 + 4 * c + e) * dpitch + k0 + 16 * kq;
        v4u o0, o1;
        o0.x = pg8::cvt_pk_bf16(x[0][e], x[1][e]); o0.y = pg8::cvt_pk_bf16(x[2][e], x[3][e]); o0.z = pg8::cvt_pk_bf16(x[4][e], x[5][e]); o0.w = pg8::cvt_pk_bf16(x[6][e], x[7][e]);
        o1.x = pg8::cvt_pk_bf16(x[8][e], x[9][e]); o1.y = pg8::cvt_pk_bf16(x[10][e], x[11][e]); o1.z = pg8::cvt_pk_bf16(x[12][e], x[13][e]); o1.w = pg8::cvt_pk_bf16(x[14][e], x[15][e]);
        *(GAS v4u*)dst = o0; *(GAS v4u*)(dst + 8) = o1; }
}

__device__ __forceinline__ unsigned pk4_fp8(float a, float b, float c, float d) { int w = 0; w = __builtin_amdgcn_cvt_pk_fp8_f32(a, b, w, false); w = __builtin_amdgcn_cvt_pk_fp8_f32(c, d, w, true); return (unsigned)w; }
__device__ __forceinline__ float clamp448(float x) { return fminf(fmaxf(x, -448.f), 448.f); }
__device__ __forceinline__ void cvt_tile64_fp8(const float* W, int N, int k0, int n0, unsigned char* WT, size_t dst_row0, int dpitch, float scale, int lane) {
    const int c = lane & 15, kq = lane >> 4;
    const float* src = W + (size_t)(k0 + 16 * kq) * N + n0 + 4 * c;
    f32x4 x[16];
#pragma unroll
    for (int j = 0; j < 16; ++j) x[j] = __builtin_nontemporal_load((const GAS f32x4*)(src + (size_t)j * N)) * scale;
#pragma unroll
    for (int e = 0; e < 4; ++e) { unsigned char* dst = WT + (dst_row0 + 4 * c + e) * dpitch + k0 + 16 * kq;
        v4u o; o.x = pk4_fp8(x[0][e], x[1][e], x[2][e], x[3][e]); o.y = pk4_fp8(x[4][e], x[5][e], x[6][e], x[7][e]); o.z = pk4_fp8(x[8][e], x[9][e], x[10][e], x[11][e]); o.w = pk4_fp8(x[12][e], x[13][e], x[14][e], x[15][e]);
        *(GAS v4u*)dst = o; }
}

__device__ __forceinline__ void phase_prologue(Frame& F) {
    const float* c = F.in[1]; const float* cctx = F.in[3]; const float* w_mod = F.in[4]; const float* b_mod = F.in[5];
    float* MODV = (float*)(F.ws + WS_MOD);
    if (F.bid < 96) {
        LAS float* sil = (LAS float*)F.lds;
        LAS float* part = (LAS float*)(F.lds + 5 * 1024 * 4);
        for (int e = F.tid; e < 5 * 1024; e += NTHR) { const int r = e >> 10, k = e & 1023; const float v = (r < 4) ? c[r * 1024 + k] : cctx[k]; sil[e] = v * sigm(v); }
        __syncthreads();
        const int col = F.bid * 64 + F.lane;
        { const int kq = F.lane >> 4, c4 = (F.lane & 15) * 4; f32x4 a4[5];
#pragma unroll
          for (int r = 0; r < 5; ++r) a4[r] = (f32x4){0.f, 0.f, 0.f, 0.f};
#pragma unroll 8
          for (int it = 0; it < 32; ++it) { const int k = F.wave * 128 + it * 4 + kq; const f32x4 w = *(const GAS f32x4*)(w_mod + (size_t)k * 6144 + F.bid * 64 + c4);
#pragma unroll
              for (int r = 0; r < 5; ++r) a4[r] += w * sil[r * 1024 + k]; }
#pragma unroll
          for (int r = 0; r < 5; ++r) {
#pragma unroll
              for (int j = 0; j < 4; ++j) { float v = a4[r][j]; v += __shfl_xor(v, 16); v += __shfl_xor(v, 32); a4[r][j] = v; }
              if (kq == 0) *(LAS f32x4*)(part + (F.wave * 5 + r) * 64 + c4) = a4[r]; } }
        __syncthreads();
        if (F.wave < 5) { float s = b_mod[col];
#pragma unroll
            for (int w = 0; w < 8; ++w) s += part[(w * 5 + F.wave) * 64 + F.lane];
            MODV[F.wave * 6144 + col] = s; }
        __syncthreads();
    }
    const int gw = F.bid * NWAVES + F.wave, NGW = F.G * NWAVES;
    bf16* WinT = (bf16*)(F.ws + WS_WIN); bf16* WpaT = (bf16*)(F.ws + WS_WPA); bf16* WprT = (bf16*)(F.ws + WS_WPR); bf16* WoT = (bf16*)(F.ws + WS_WO);
    bf16* WupT = (bf16*)(F.ws + WS_LW); bf16* AupT = WupT + 2 * 512 * 64; bf16* GupT = AupT + 2 * 512 * 64;
    constexpr int I_IN = 16 * (PIN / 64), I_PA = 8 * 16, I_PR = 8 * 16, I_O = 16 * 16, I_LW = 16 + 16 + 16, I_ALL = I_IN + I_PA + I_PR + I_O + I_LW;
    for (int it = gw; it < I_ALL; it += NGW) {
        int r = it;
        if (r < I_IN) { const int nb = PIN / 64; cvt_tile64(F.in[6], PIN, 64 * (r / nb), 64 * (r % nb), WinT, (size_t)64 * (r % nb), 1024, F.lane); continue; } r -= I_IN;
        if (r < I_PA) { cvt_tile64(F.in[20], 1024, 64 * (r / 16), 64 * (r % 16), WpaT, (size_t)64 * (r % 16), 512, F.lane); continue; } r -= I_PA;
        if (r < I_PR) { cvt_tile64(F.in[21], 1024, 64 * (r / 16), 64 * (r % 16), WprT, (size_t)64 * (r % 16), 512, F.lane); continue; } r -= I_PR;
        if (r < I_O) { cvt_tile64(F.in[22], 1024, 64 * (r / 16), 64 * (r % 16), WoT, (size_t)64 * (r % 16), 1024, F.lane); continue; } r -= I_O;
        if (r < 16) { cvt_tile64(F.in[11] + (size_t)(r >> 3) * 64 * 512, 512, 0, 64 * (r & 7), WupT + (size_t)(r >> 3) * 512 * 64, (size_t)64 * (r & 7), 64, F.lane); continue; } r -= 16;
        if (r < 16) { cvt_tile64(F.in[13] + (size_t)(r >> 3) * 64 * 512, 512, 0, 64 * (r & 7), AupT + (size_t)(r >> 3) * 512 * 64, (size_t)64 * (r & 7), 64, F.lane); continue; } r -= 16;
        cvt_tile64(F.in[14], 512, 64 * (r >> 3), 64 * (r & 7), GupT, (size_t)64 * (r & 7), 128, F.lane);
    }
    { float* tab = (float*)(F.ws + WS_ROPE); const int i = F.bid * NTHR + F.tid;
      if (i < 128 * 16) { const float ang = (float)(i >> 4) * powf(10000.0f, -(float)(i & 15) / 16.0f); float sn, cs; sincosf(ang, &sn, &cs); tab[2 * i] = cs; tab[2 * i + 1] = sn; } }
    { GAS v4u* z = (GAS v4u*)(WinT + (size_t)PIN * 1024); const int n16 = (PINP - PIN) * 1024 * 2 / 16;
      for (int i = F.bid * NTHR + F.tid; i < n16; i += F.G * NTHR) z[i] = (v4u){0u, 0u, 0u, 0u}; }
}

__device__ __forceinline__ void phase_ln_mod(Frame& F) {
    const float* MODV = (const float*)(F.ws + WS_MOD);
    bf16* U = (bf16*)(F.ws + WS_U);
    const int gw = F.bid * NWAVES + F.wave, NGW = F.G * NWAVES;
    f32x4 nx[4];
    if (gw < MA) { const GAS f32x4* xr = (const GAS f32x4*)((gw < MT) ? F.in[0] + (size_t)gw * D : F.in[2] + (size_t)(gw - MT) * D) + F.lane;
#pragma unroll
        for (int j = 0; j < 4; ++j) nx[j] = xr[64 * j]; }
    for (int m = gw; m < MA; m += NGW) {
        const int mr = (m < MT) ? (m / T) : 4;
        const float* sh = MODV + mr * 6144; const float* sc = sh + 1024;
        f32x4 v[4]; float s = 0.f;
#pragma unroll
        for (int j = 0; j < 4; ++j) { v[j] = nx[j]; s += (v[j].x + v[j].y) + (v[j].z + v[j].w); }
        { const int mn = m + NGW; if (mn < MA) { const GAS f32x4* xr = (const GAS f32x4*)((mn < MT) ? F.in[0] + (size_t)mn * D : F.in[2] + (size_t)(mn - MT) * D) + F.lane;
#pragma unroll
            for (int j = 0; j < 4; ++j) nx[j] = xr[64 * j]; } }
        const float mean = wave_sum(s) * (1.f / D); float s2 = 0.f;
#pragma unroll
        for (int j = 0; j < 4; ++j) { v[j] = v[j] - mean; s2 += (v[j].x * v[j].x + v[j].y * v[j].y) + (v[j].z * v[j].z + v[j].w * v[j].w); }
        const float rstd = 1.f / sqrtf(wave_sum(s2) * (1.f / D) + LN_EPS);
        GAS unsigned long long* o8 = (GAS unsigned long long*)(U + (size_t)m * D) + F.lane;
#pragma unroll
        for (int j = 0; j < 4; ++j) { const f32x4 a = *((const f32x4*)sc + F.lane + 64 * j), b = *((const f32x4*)sh + F.lane + 64 * j);
            const f32x4 o = v[j] * rstd * (a + 1.0f) + b;
            o8[64 * j] = (unsigned long long)pk2(o.x, o.y) | ((unsigned long long)pk2(o.z, o.w) << 32); }
    }
}

__device__ __forceinline__ void phase_rope_vt(Frame& F) {
    bf16* Z = (bf16*)(F.ws + WS_Z);
    const int gw = F.bid * NWAVES + F.wave, NGW = F.G * NWAVES;
    {
        const int fh = F.lane & 1, a = (F.lane >> 1) & 1, h = (F.lane >> 2) & 7, w = F.lane >> 5;
        const float* tab = (const float*)(F.ws + WS_ROPE);
        for (int m = gw; m < MT; m += NGW) {
            const int t = m % T; const int pos = a ? (t % GW) : (t / GW);
            bf16* p1 = Z + (size_t)m * PINP + w * 512 + h * 64 + a * 32 + fh * 8;
            float x1[8], x2[8], o1[8], o2[8];
            unpack8(*(const GAS v4u*)p1, x1); unpack8(*(const GAS v4u*)(p1 + 16), x2);
            const f32x4* tp = (const f32x4*)(tab + (size_t)(pos * 16 + fh * 8) * 2);
#pragma unroll
            for (int j2 = 0; j2 < 4; ++j2) { const f32x4 cs2 = tp[j2];
                o1[2 * j2] = x1[2 * j2] * cs2.x - x2[2 * j2] * cs2.y; o2[2 * j2] = x2[2 * j2] * cs2.x + x1[2 * j2] * cs2.y;
                o1[2 * j2 + 1] = x1[2 * j2 + 1] * cs2.z - x2[2 * j2 + 1] * cs2.w; o2[2 * j2 + 1] = x2[2 * j2 + 1] * cs2.z + x1[2 * j2 + 1] * cs2.w; }
            *(GAS v4u*)p1 = pack8(o1); *(GAS v4u*)(p1 + 16) = pack8(o2);
        }
    }
    {
        bf16* VT = (bf16*)(F.ws + WS_VT); bf16* VTC = VT + VT_LAT_ELEMS;
        LAS bf16* scr = (LAS bf16*)(F.lds + F.wave * 16384);
        constexpr int NI_LAT = (MT / 64) * 8, NI = NI_LAT + (MC / 64) * 8;
        for (int it = gw; it < NI; it += NGW) {
            const bool lat = it < NI_LAT; const int r = lat ? it : it - NI_LAT;
            const int h = r & 7, tb = r >> 3;
            const int row0 = (lat ? 0 : MT) + tb * 64;
            const int b = lat ? (tb * 64) / T : (tb * 64) / LC, t0 = lat ? (tb * 64) % T : (tb * 64) % LC;
#pragma unroll 8
            for (int i = 0; i < 32; ++i) { const int tok = 2 * i + (F.lane >> 5); const unsigned w = *(const GAS unsigned*)(Z + (size_t)(row0 + tok) * PINP + ZV + h * 64 + 2 * (F.lane & 31));
                scr[tok * 66 + 2 * (F.lane & 31)] = (bf16)(w & 0xffff); scr[tok * 66 + 2 * (F.lane & 31) + 1] = (bf16)(w >> 16); }
            LDS_WAIT(); asm volatile("" ::: "memory");
            if (lat) {
                bf16* dst = VT + ((size_t)(b * 8 + h) * (T / 4) + (t0 >> 2)) * 256;
#pragma unroll
                for (int j = 0; j < 8; ++j) { const int g = 2 * j + (F.lane >> 5), dh = 2 * (F.lane & 31); const LAS bf16* s0 = scr + (4 * g) * 66 + dh;
                    v4u o; o.x = (unsigned)s0[0] | ((unsigned)s0[66] << 16); o.y = (unsigned)s0[2 * 66] | ((unsigned)s0[3 * 66] << 16);
                    o.z = (unsigned)s0[1] | ((unsigned)s0[66 + 1] << 16); o.w = (unsigned)s0[2 * 66 + 1] | ((unsigned)s0[3 * 66 + 1] << 16);
                    *(GAS v4u*)(dst + (size_t)(j * 64 + F.lane) * 8) = o; }
            } else {
                bf16* dst = VTC + ((size_t)(b * 8 + h) * 64) * LC + t0;
                const int c = F.lane & 7;
#pragma unroll
                for (int j = 0; j < 8; ++j) { const int dh = (F.lane >> 3) + 8 * j; const LAS bf16* s = scr + (8 * c) * 66 + dh;
                    v4u o; o.x = (unsigned)s[0] | ((unsigned)s[66] << 16); o.y = (unsigned)s[2 * 66] | ((unsigned)s[3 * 66] << 16); o.z = (unsigned)s[4 * 66] | ((unsigned)s[5 * 66] << 16); o.w = (unsigned)s[6 * 66] | ((unsigned)s[7 * 66] << 16);
                    *(GAS v4u*)(dst + (size_t)dh * LC + 8 * c) = o; }
            }
            LDS_WAIT(); asm volatile("" ::: "memory");
        }
    }
}

constexpr int NA_KP = 72, NA_VP = 264;
__device__ __forceinline__ void na_wave_task(Frame& F, int task, LAS float* rpbs, const LAS bf16* ck, const LAS bf16* cvt, int ocol = ZQ) {
    bf16* Z = (bf16*)(F.ws + WS_Z);
    const bf16* VT = (const bf16*)(F.ws + WS_VT);
    const int jq = task & 3, h = (task >> 2) & 7, i = (task >> 5) & 127, b = task >> 12;
    const int rs = min(max(i - 4, 0), GH - 8);
    const int cb = (jq == 0) ? 0 : (jq == 1) ? 8 : (jq == 2) ? 24 : 32;
    const int qi = F.lane & 15, qd = F.lane >> 4;
    const int j = jq * 16 + qi, cs = min(max(j - 8, 0), GW - 16);
    const size_t qrow = (size_t)b * T + i * GW + j;
    const bf16x8 q0 = *(const GAS bf16x8*)(Z + qrow * PINP + ZQ + h * 64 + qd * 8);
    const bf16x8 q1 = *(const GAS bf16x8*)(Z + qrow * PINP + ZQ + h * 64 + 32 + qd * 8);
    f32x4 s[32];
    int bidx[2][4];
#pragma unroll
    for (int half = 0; half < 2; ++half)
#pragma unroll
        for (int jj = 0; jj < 4; ++jj) { const int c = cb + half * 16 + qd * 4 + jj; const bool ok = (c >= cs) && (c < cs + 16); bidx[half][jj] = ok ? h * 465 + (rs - i + 7) * 31 + (c - j + 15) : 8 * 465; }
    LAS bf16* kb = (LAS bf16*)(F.lds + 87040 + F.wave * 4608);
    v4u kraw[4];
#pragma unroll
    for (int ii = 0; ii < 4; ++ii) kraw[ii] = *(const GAS v4u*)(Z + ((size_t)b * T + rs * GW + cb + 8 * ii + (F.lane >> 3)) * PINP + ZK + h * 64 + (F.lane & 7) * 8);
#pragma unroll
    for (int r = 0; r < 8; ++r) {
#pragma unroll
        for (int ii = 0; ii < 4; ++ii) *(LAS v4u*)(kb + (8 * ii + (F.lane >> 3)) * NA_KP + (F.lane & 7) * 8) = kraw[ii];
        if (r < 7) {
#pragma unroll
            for (int ii = 0; ii < 4; ++ii) kraw[ii] = *(const GAS v4u*)(Z + ((size_t)b * T + (rs + r + 1) * GW + cb + 8 * ii + (F.lane >> 3)) * PINP + ZK + h * 64 + (F.lane & 7) * 8); }
#pragma unroll
        for (int half = 0; half < 2; ++half) {
            const bf16x8 k0 = *(const LAS bf16x8*)(kb + (half * 16 + qi) * NA_KP + qd * 8), k1 = *(const LAS bf16x8*)(kb + (half * 16 + qi) * NA_KP + 32 + qd * 8);
            f32x4 a = (f32x4){0.f, 0.f, 0.f, 0.f};
            a = __builtin_amdgcn_mfma_f32_16x16x32_bf16(k0, q0, a, 0, 0, 0);
            a = __builtin_amdgcn_mfma_f32_16x16x32_bf16(k1, q1, a, 0, 0, 0);
#pragma unroll
            for (int jj = 0; jj < 4; ++jj) a[jj] += rpbs[bidx[half][jj] + r * 31];
            s[2 * r + half] = a; }
        __builtin_amdgcn_sched_barrier(0);
    }
#pragma unroll
    for (int tc = 0; tc < 16; ++tc) {
        const bf16x8 k0 = *(const LAS bf16x8*)(ck + (tc * 16 + qi) * NA_KP + qd * 8);
        const bf16x8 k1 = *(const LAS bf16x8*)(ck + (tc * 16 + qi) * NA_KP + 32 + qd * 8);
        f32x4 a = (f32x4){0.f, 0.f, 0.f, 0.f};
        a = __builtin_amdgcn_mfma_f32_16x16x32_bf16(k0, q0, a, 0, 0, 0);
        a = __builtin_amdgcn_mfma_f32_16x16x32_bf16(k1, q1, a, 0, 0, 0);
        s[16 + tc] = a;
        if ((tc & 1) == 1) __builtin_amdgcn_sched_barrier(0);
    }
    float mx = -1e30f;
#pragma unroll
    for (int tl = 0; tl < 32; ++tl) mx = fmaxf(fmaxf(fmaxf(s[tl][0], s[tl][1]), fmaxf(s[tl][2], s[tl][3])), mx);
    mx = fmaxf(mx, __shfl_xor(mx, 16)); mx = fmaxf(mx, __shfl_xor(mx, 32));
    float sum = 0.f; const float esc = 0.125f * 1.44269504f, mxs = mx * esc;
#pragma unroll
    for (int tl = 0; tl < 32; ++tl) {
#pragma unroll
        for (int jj = 0; jj < 4; ++jj) { const float e = __builtin_amdgcn_exp2f(__builtin_fmaf(s[tl][jj], esc, -mxs)); s[tl][jj] = e; sum += e; } }
    sum += __shfl_xor(sum, 16); sum += __shfl_xor(sum, 32);
    const float inv = 1.0f / sum;
    f32x4 o[4];
#pragma unroll
    for (int dt = 0; dt < 4; ++dt) o[dt] = (f32x4){0.f, 0.f, 0.f, 0.f};
#pragma unroll
    for (int ks = 0; ks < 16; ++ks) {
        const f32x4 p0 = s[2 * ks], p1 = s[2 * ks + 1];
        v4u pw; pw.x = pk2(p0[0], p0[1]); pw.y = pk2(p0[2], p0[3]); pw.z = pk2(p1[0], p1[1]); pw.w = pk2(p1[2], p1[3]);
        const bf16x8 pa = __builtin_bit_cast(bf16x8, pw);
        if (ks < 8) { const bf16* vb = VT + ((size_t)(b * 8 + h) * (T / 4) + (((rs + ks) * GW + cb) >> 2) + qd) * 256;
#pragma unroll
            for (int dt = 0; dt < 4; ++dt) {
                const bf16* vp = vb + (dt * 16 + qi) * 4;
                const v2u lo = *(const GAS v2u*)vp, hi = *(const GAS v2u*)(vp + 4 * 256);
                v4u vw; vw.x = lo.x; vw.y = lo.y; vw.z = hi.x; vw.w = hi.y;
                o[dt] = __builtin_amdgcn_mfma_f32_16x16x32_bf16(pa, __builtin_bit_cast(bf16x8, vw), o[dt], 0, 0, 0); } }
        else { const LAS bf16* vb = cvt + (ks - 8) * 32 + qd * 4;
#pragma unroll
            for (int dt = 0; dt < 4; ++dt) {
                const LAS bf16* vp = vb + (dt * 16 + qi) * NA_VP;
                const v2u lo = *(const LAS v2u*)vp, hi = *(const LAS v2u*)(vp + 16);
                v4u vw; vw.x = lo.x; vw.y = lo.y; vw.z = hi.x; vw.w = hi.y;
                o[dt] = __builtin_amdgcn_mfma_f32_16x16x32_bf16(pa, __builtin_bit_cast(bf16x8, vw), o[dt], 0, 0, 0); } }
        __builtin_amdgcn_sched_barrier(0);
    }
    float invq[4];
#pragma unroll
    for (int jj = 0; jj < 4; ++jj) invq[jj] = __shfl(inv, qd * 4 + jj);
#pragma unroll
    for (int dt = 0; dt < 4; ++dt)
#pragma unroll
        for (int jj = 0; jj < 4; ++jj) Z[((size_t)b * T + i * GW + jq * 16 + qd * 4 + jj) * PINP + ocol + h * 64 + dt * 16 + qi] = (bf16)f2bf(o[dt][jj] * invq[jj]);
}

constexpr int CP = 72;
constexpr int CBUF = 9216;
__device__ __forceinline__ int swz(int row, int col) { return row * 64 + (((((col >> 3) ^ (row >> 1) ^ ((row & 1) << 2)) & 7) << 3) | (col & 7)); }
constexpr int NCHK = (LC + T) / 64;
constexpr size_t PQ_UNIT = 16384, RY_UNIT = 16384;
constexpr int LDS_TOT = 15 * CBUF, LDS_CLE = LDS_TOT + 2048, LDS_MU = LDS_CLE + 256 + 2048;
#define CB(i) ((LAS bf16*)(F.lds + (i) * CBUF))
__device__ __forceinline__ bf16x8 ldsfrag(const LAS bf16* base, int row, int col) { return *(const LAS bf16x8*)(base + swz(row, col)); }
template <int MODE = 0> __device__ __forceinline__ void mm2(const LAS bf16* X, const LAS bf16* Y, int mt0, int nt, int r, int q, f32x4 (&acc)[2]) {
    if (MODE == 1) return;
    const bf16x8 y0 = ldsfrag(Y, 16 * nt + r, 8 * q), y1 = ldsfrag(Y, 16 * nt + r, 32 + 8 * q);
#pragma unroll
    for (int t = 0; t < 2; ++t) { const bf16x8 x0 = ldsfrag(X, 16 * (mt0 + t) + r, 8 * q), x1 = ldsfrag(X, 16 * (mt0 + t) + r, 32 + 8 * q);
        acc[t] = __builtin_amdgcn_mfma_f32_16x16x32_bf16(x0, y0, acc[t], 0, 0, 0); acc[t] = __builtin_amdgcn_mfma_f32_16x16x32_bf16(x1, y1, acc[t], 0, 0, 0); }
}
struct FragX { bf16x8 a[2][2]; };
struct FragY { bf16x8 b[2]; };
template <int MODE = 0> __device__ __forceinline__ FragX ldX(const LAS bf16* X, int mt0, int r, int q) { FragX f;
#pragma unroll
    for (int t = 0; t < 2; ++t) { if (MODE == 1) { f.a[t][0] = f.a[t][1] = (bf16x8){0, 0, 0, 0, 0, 0, 0, 0}; } else { f.a[t][0] = ldsfrag(X, 16 * (mt0 + t) + r, 8 * q); f.a[t][1] = ldsfrag(X, 16 * (mt0 + t) + r, 32 + 8 * q); } }
    return f; }
template <int MODE = 0> __device__ __forceinline__ FragY ldY(const LAS bf16* Y, int nt, int r, int q) { FragY f;
    if (MODE == 1) { f.b[0] = f.b[1] = (bf16x8){0, 0, 0, 0, 0, 0, 0, 0}; } else { f.b[0] = ldsfrag(Y, 16 * nt + r, 8 * q); f.b[1] = ldsfrag(Y, 16 * nt + r, 32 + 8 * q); }
    return f; }
template <int MODE = 0> __device__ __forceinline__ void mmf(const FragX& x, const FragY& y, f32x4 (&acc)[2]) {
    if (MODE == 1) return;
#pragma unroll
    for (int k = 0; k < 2; ++k)
#pragma unroll
        for (int t = 0; t < 2; ++t) acc[t] = __builtin_amdgcn_mfma_f32_16x16x32_bf16(x.a[t][k], y.b[k], acc[t], 0, 0, 0);
}
__device__ __forceinline__ v2u pack4(f32x4 v) { v2u o; o.x = pg8::cvt_pk_bf16(v[0], v[1]); o.y = pg8::cvt_pk_bf16(v[2], v[3]); return o; }
__device__ __forceinline__ f32x4 unpack4(v2u w) { return (f32x4){bflo(w.x), bfhi(w.x), bflo(w.y), bfhi(w.y)}; }
__device__ __forceinline__ void stT(LAS bf16* O, int mt, int nt, int r, int q, f32x4 v) { *(LAS v2u*)(O + swz(16 * nt + r, 16 * mt + 4 * q)) = pack4(v); }
__device__ __forceinline__ void stR(LAS bf16* O, int mt, int nt, int r, int q, f32x4 v) {
#pragma unroll
    for (int jj = 0; jj < 4; ++jj) O[swz(16 * mt + 4 * q + jj, 16 * nt + r)] = (bf16)f2bf(v[jj]); }
__device__ __forceinline__ f32x4 ldT(const LAS bf16* O, int mt, int nt, int r, int q) { return unpack4(*(const LAS v2u*)(O + swz(16 * nt + r, 16 * mt + 4 * q))); }
#define Z2 {(f32x4){0.f, 0.f, 0.f, 0.f}, (f32x4){0.f, 0.f, 0.f, 0.f}}
__device__ __forceinline__ float tanh_fast(float x) { return 1.0f - 2.0f * __builtin_amdgcn_rcpf(1.0f + __expf(2.0f * x)); }
__device__ __forceinline__ bf16 f2bf_hw(float x) { return (bf16)(pg8::cvt_pk_bf16(x, x) & 0xffffu); }
__device__ __forceinline__ void shift8(const bf16* zp, bool hasp, bool hasn, const float* mup, const float* mun, float (&o)[8]) {
    float z[8], a[8], b[8];
    unpack8(*(const GAS v4u*)zp, z);
    unpack8(hasp ? *(const GAS v4u*)(zp - PINP) : (v4u){0u, 0u, 0u, 0u}, a);
    unpack8(hasn ? *(const GAS v4u*)(zp + PINP) : (v4u){0u, 0u, 0u, 0u}, b);
    const f32x4 p0 = *(const f32x4*)mup, p1 = *(const f32x4*)(mup + 4), n0 = *(const f32x4*)mun, n1 = *(const f32x4*)(mun + 4);
#pragma unroll
    for (int e = 0; e < 8; ++e) { const float mp = e < 4 ? p0[e & 3] : p1[e & 3], mn = e < 4 ? n0[e & 3] : n1[e & 3]; o[e] = z[e] + mp * (a[e] - z[e]) + mn * (b[e] - z[e]); }
}
__device__ __forceinline__ void shift8u(const char* zu, unsigned zo, bool hasp, bool hasn, const char* mup, const char* mun, unsigned mo, float (&o)[8]) {
    float z[8], a[8], b[8];
    unpack8(*(const GAS v4u*)(zu + zo), z);
    unpack8(hasp ? *(const GAS v4u*)(zu - PINP * 2 + zo) : (v4u){0u, 0u, 0u, 0u}, a);
    unpack8(hasn ? *(const GAS v4u*)(zu + PINP * 2 + zo) : (v4u){0u, 0u, 0u, 0u}, b);
    const f32x4 p0 = *(const GAS f32x4*)(mup + mo), p1 = *(const GAS f32x4*)(mup + 16 + mo), n0 = *(const GAS f32x4*)(mun + mo), n1 = *(const GAS f32x4*)(mun + 16 + mo);
#pragma unroll
    for (int e = 0; e < 8; ++e) { const float mp = e < 4 ? p0[e & 3] : p1[e & 3], mn = e < 4 ? n0[e & 3] : n1[e & 3]; o[e] = z[e] + mp * (a[e] - z[e]) + mn * (b[e] - z[e]); }
}
__device__ __forceinline__ void shift8l(const char* zu, unsigned zo, bool hasp, bool hasn, const LAS float* mup, const LAS float* mun, float (&o)[8]) {
    float z[8], a[8], b[8];
    unpack8(*(const GAS v4u*)(zu + zo), z);
    unpack8(hasp ? *(const GAS v4u*)(zu - PINP * 2 + zo) : (v4u){0u, 0u, 0u, 0u}, a);
    unpack8(hasn ? *(const GAS v4u*)(zu + PINP * 2 + zo) : (v4u){0u, 0u, 0u, 0u}, b);
    const f32x4 p0 = *(const LAS f32x4*)mup, p1 = *(const LAS f32x4*)(mup + 4), n0 = *(const LAS f32x4*)mun, n1 = *(const LAS f32x4*)(mun + 4);
#pragma unroll
    for (int e = 0; e < 8; ++e) { const float mp = e < 4 ? p0[e & 3] : p1[e & 3], mn = e < 4 ? n0[e & 3] : n1[e & 3]; o[e] = z[e] + mp * (a[e] - z[e]) + mn * (b[e] - z[e]); }
}
struct Raw3 { v4u z, a, b; };
__device__ __forceinline__ void dma_tile(const char* gbase, unsigned zo, unsigned lds_tile, int wave, int lane) {
    const unsigned m0a = lds_tile + (unsigned)wave * 1024u;
    asm volatile("s_mov_b32 m0, %0\n\ts_nop 0\n\tglobal_load_lds_dwordx4 %1, %2" :: "s"(m0a), "v"(zo), "s"(gbase) : "memory", "m0");
    if (wave == 0) { if (lane < 16) { const char* g2 = gbase + (size_t)64 * PINP * 2; const unsigned m0b = lds_tile + 8192u;
        asm volatile("s_mov_b32 m0, %0\n\ts_nop 0\n\tglobal_load_lds_dwordx4 %1, %2" :: "s"(m0b), "v"(zo), "s"(g2) : "memory", "m0"); } }
}
__device__ __forceinline__ Raw3 rd3(const LAS unsigned char* tile, int t1, int k8) { Raw3 w; const LAS unsigned char* p = tile + t1 * 128 + k8 * 2;
    w.a = *(const LAS v4u*)p; w.z = *(const LAS v4u*)(p + 128); w.b = *(const LAS v4u*)(p + 256); return w; }
__device__ __forceinline__ Raw3 ld3(const char* zu, unsigned zo) { Raw3 w; w.z = *(const GAS v4u*)(zu + zo); w.a = *(const GAS v4u*)(zu - PINP * 2 + zo); w.b = *(const GAS v4u*)(zu + PINP * 2 + zo); return w; }
__device__ __forceinline__ void mix8(const Raw3& w, bool hasp, bool hasn, const LAS float* mup, const LAS float* mun, float (&o)[8]) {
    float z[8], a[8], b[8];
    unpack8(w.z, z); unpack8(hasp ? w.a : (v4u){0u, 0u, 0u, 0u}, a); unpack8(hasn ? w.b : (v4u){0u, 0u, 0u, 0u}, b);
    const f32x4 p0 = *(const LAS f32x4*)mup, p1 = *(const LAS f32x4*)(mup + 4), n0 = *(const LAS f32x4*)mun, n1 = *(const LAS f32x4*)(mun + 4);
#pragma unroll
    for (int e = 0; e < 8; ++e) { const float mp = e < 4 ? p0[e & 3] : p1[e & 3], mn = e < 4 ? n0[e & 3] : n1[e & 3]; o[e] = z[e] + mp * (a[e] - z[e]) + mn * (b[e] - z[e]); }
}
#define VMW(n) asm volatile("s_waitcnt vmcnt(" #n ")" ::: "memory")
__device__ __forceinline__ float sum8(float v) { v += dppf<0xB1>(v); v += dppf<0x4E>(v); v += dppf<0x141>(v); return v; }

__device__ __forceinline__ int afrag_off(int row, int col) { return ((((row >> 4) * 2 + (col >> 5)) * 64 + ((col >> 2) & 3) * 16 + (row & 15)) << 3) + ((col >> 4) & 1) * 4 + (col & 3); }
__device__ __forceinline__ int cfrag_off(int n, int m) { return ((((n >> 4) * 4 + (m >> 4)) * 64 + ((m >> 2) & 3) * 16 + (n & 15)) << 2) + (m & 3); }
template <int MODE> __device__ __forceinline__ void rwkvA_unit(Frame& F, int u, int& hl, int pre, int un) {
    int lane_ = F.lane, tid_ = F.tid; asm volatile("" : "+v"(lane_), "+v"(tid_));
    const bf16* Z = (const bf16*)(F.ws + WS_Z);
    const bf16* WupT = (const bf16*)(F.ws + WS_LW); const bf16* AupT = WupT + 2 * 512 * 64; const bf16* GupT = AupT + 2 * 512 * 64;
    const int h = u & 7, bt = u >> 3, b = bt / NCHK, blk = bt % NCHK; const bool isctx = blk < 4;
    const int seqlen = isctx ? LC : T, s0 = (isctx ? blk : blk - 4) * 64;
    const size_t row0 = (isctx ? (size_t)MT + b * LC : (size_t)b * T) + s0;
    const int ti = lane_, c8 = F.wave * 8;
    const int r = lane_ & 15, q = lane_ >> 4, nt = F.wave & 3, mt0 = 2 * (F.wave >> 2);
    const int sp = s0 + ti; const bool hasp = sp > 0, hasn = sp < seqlen - 1;
    const bf16* zrow = Z + (row0 + ti) * PINP;
    const int t1 = tid_ >> 3, k8 = (tid_ & 7) * 8; const int sp1 = s0 + t1; const bool hasp1 = sp1 > 0, hasn1 = sp1 < seqlen - 1;
    const char* Zu = (const char*)(Z + row0 * PINP); const unsigned zo = (unsigned)((t1 * PINP + k8) * 2), mo = (unsigned)(k8 * 4);
    LAS float* RSs = (LAS float*)(F.lds + 4 * CBUF); LAS float* KSs = RSs + 64 * 68; LAS bf16* VSs = (LAS bf16*)(F.lds + 4 * CBUF + 2 * 64 * 68 * 4);
    LAS float* ssp = (LAS float*)(F.lds + LDS_CLE + 256);
    const LAS float* mpL = (const LAS float*)(F.lds + LDS_MU); const LAS float* mnL = mpL + 384;
    LAS float* mpR = (LAS float*)(F.lds + 0 * CBUF + 8192); LAS float* mnR = (LAS float*)(F.lds + 1 * CBUF + 8192);
    if (h != hl) { hl = h; if (tid_ < 192) { const int gi = (tid_ >> 6) * 512 + h * 64 + (tid_ & 63); mpR[tid_] = F.in[8][gi]; mnR[tid_] = F.in[9][gi]; } __syncthreads(); }
    const unsigned ldsb = (unsigned)(size_t)F.lds;
    const char* Zm = Zu - PINP * 2;
    if (pre < 0) { dma_tile(Zm + (ZR + h * 64) * 2, zo, ldsb + 10 * CBUF, F.wave, lane_); dma_tile(Zm + (ZRK + h * 64) * 2, zo, ldsb + 11 * CBUF, F.wave, lane_); dma_tile(Zm + (ZRV + h * 64) * 2, zo, ldsb + 14 * CBUF, F.wave, lane_); VMW(0); }
    else if (pre == 4) VMW(4); else VMW(8);
    __syncthreads();
    dma_tile(Zm + ZLORA * 2, zo, ldsb + 9 * CBUF, F.wave, lane_); dma_tile(Zm + (ZLORA + 128) * 2, zo, ldsb + 12 * CBUF, F.wave, lane_); dma_tile(Zm + (ZLORA + 256) * 2, zo, ldsb + 13 * CBUF, F.wave, lane_);
    { float x[8], y[8];
      mix8(rd3(F.lds + 10 * CBUF, t1, k8), hasp1, hasn1, mpR + k8, mnR + k8, x);
      *(LAS f32x4*)(RSs + t1 * 68 + k8) = (f32x4){x[0], x[1], x[2], x[3]}; *(LAS f32x4*)(RSs + t1 * 68 + k8 + 4) = (f32x4){x[4], x[5], x[6], x[7]};
      mix8(rd3(F.lds + 11 * CBUF, t1, k8), hasp1, hasn1, mpR + 64 + k8, mnR + 64 + k8, y);
      *(LAS f32x4*)(KSs + t1 * 68 + k8) = (f32x4){y[0], y[1], y[2], y[3]}; *(LAS f32x4*)(KSs + t1 * 68 + k8 + 4) = (f32x4){y[4], y[5], y[6], y[7]};
      float ss = 0.f;
#pragma unroll
      for (int e = 0; e < 8; ++e) { const float kv = y[e] * F.in[15][h * 64 + k8 + e]; ss += kv * kv; }
      ss = sum8(ss); if ((tid_ & 7) == 0) ssp[t1] = 1.0f / sqrtf(ss + 1e-12f);
      mix8(rd3(F.lds + 14 * CBUF, t1, k8), hasp1, hasn1, mpR + 128 + k8, mnR + 128 + k8, x);
      *(LAS v4u*)(VSs + t1 * CP + k8) = pack8(x); }
    VMW(0); __syncthreads();
    float rs[8], ks[8], rn = 0.f; v4u vsp = {0u, 0u, 0u, 0u};
    LAS float* lwT = (LAS float*)(F.lds + 10 * CBUF);
    LAS float* aT = (LAS float*)(F.lds + 10 * CBUF + 64 * 68 * 4);
    LAS float* tot = (LAS float*)(F.lds + LDS_TOT); LAS float* cle = (LAS float*)(F.lds + LDS_CLE); LAS float* ecle = (LAS float*)(F.lds + LDS_MU + 3072);
#pragma unroll 1
    for (int d = 0; d < 2; ++d) {
        const int ip = d ? 63 - ti : ti;
        const int chunk_p = isctx ? (d ? 3 - blk : blk) : (d ? 4 + (131 - blk) : blk);
        const bf16* wy = WupT + ((size_t)(d * 512 + h * 64 + 16 * nt + r)) * 64 + 8 * q; const bf16* ay = AupT + ((size_t)(d * 512 + h * 64 + 16 * nt + r)) * 64 + 8 * q;
        const bf16x8 wy0 = *(const GAS bf16x8*)wy, wy1 = *(const GAS bf16x8*)(wy + 32), ay0 = *(const GAS bf16x8*)ay, ay1 = *(const GAS bf16x8*)(ay + 32);
        const float w0v = F.in[10][d * 512 + h * 64 + 16 * nt + r], a0v = F.in[12][d * 512 + h * 64 + 16 * nt + r];
        { float x[8]; const int ip1 = d ? 63 - t1 : t1;
          Raw3 gB; if (d == 0) gB = ld3(Zu + (ZLORA + 256 + 64) * 2, zo);
          mix8(rd3(F.lds + (d ? 10 : 9) * CBUF, t1, k8), hasp1, hasn1, mpL + d * 64 + k8, mnL + d * 64 + k8, x);
#pragma unroll
          for (int e = 0; e < 8; ++e) x[e] = tanh_fast(x[e]);
          *(LAS v4u*)(CB(0) + swz(ip1, k8)) = pack8(x);
          mix8(rd3(F.lds + (d ? 11 : 12) * CBUF, t1, k8), hasp1, hasn1, mpL + 128 + d * 64 + k8, mnL + 128 + d * 64 + k8, x);
          *(LAS v4u*)(CB(1) + swz(ip1, k8)) = pack8(x);
          if (d == 0) {
              mix8(rd3(F.lds + 13 * CBUF, t1, k8), hasp1, hasn1, mpL + 256 + k8, mnL + 256 + k8, x);
#pragma unroll
              for (int e = 0; e < 8; ++e) x[e] = sigm(x[e]);
              *(LAS v4u*)(CB(2) + t1 * 144 + k8) = pack8(x);
              mix8(gB, hasp1, hasn1, mpL + 256 + 64 + k8, mnL + 256 + 64 + k8, x);
#pragma unroll
              for (int e = 0; e < 8; ++e) x[e] = sigm(x[e]);
              *(LAS v4u*)(CB(2) + t1 * 144 + 64 + k8) = pack8(x); } }
        __syncthreads();
        if (MODE == 5) { __syncthreads(); continue; }
        { f32x4 aw[2] = Z2, aa[2] = Z2;
          { const FragX xw = ldX<0>(CB(0), mt0, r, q), xa = ldX<0>(CB(1), mt0, r, q); FragY yw, ya; yw.b[0] = wy0; yw.b[1] = wy1; ya.b[0] = ay0; ya.b[1] = ay1;
            __builtin_amdgcn_sched_barrier(0);
            mmf<0>(xw, yw, aw); mmf<0>(xa, ya, aa); }
          const int c = 16 * nt + r;
#pragma unroll
          for (int t = 0; t < 2; ++t) { f32x4 lw, av;
#pragma unroll
              for (int jj = 0; jj < 4; ++jj) { lw[jj] = -0.60653066f * sigm(aw[t][jj] + w0v); av[jj] = sigm(aa[t][jj] + a0v); }
              *(LAS f32x4*)(lwT + c * 68 + 16 * (mt0 + t) + 4 * q) = lw; *(LAS f32x4*)(aT + c * 68 + 16 * (mt0 + t) + 4 * q) = av; }
          if (d == 0) { bf16x8 gyv[4]; { const bf16* gy = GupT + ((size_t)(h * 64 + 16 * nt + r)) * 128 + 8 * q;
#pragma unroll
              for (int k4 = 0; k4 < 4; ++k4) gyv[k4] = *(const GAS bf16x8*)(gy + 32 * k4); }
              f32x4 ag[2] = Z2;
#pragma unroll
              for (int kp = 0; kp < 2; ++kp) { bf16x8 xg[2][2];
#pragma unroll
                  for (int t = 0; t < 2; ++t)
#pragma unroll
                      for (int k2 = 0; k2 < 2; ++k2) xg[t][k2] = *(const LAS bf16x8*)(CB(2) + (16 * (mt0 + t) + r) * 144 + 32 * (2 * kp + k2) + 8 * q);
                  __builtin_amdgcn_sched_barrier(0);
#pragma unroll
                  for (int k2 = 0; k2 < 2; ++k2)
#pragma unroll
                      for (int t = 0; t < 2; ++t) ag[t] = __builtin_amdgcn_mfma_f32_16x16x32_bf16(gyv[2 * kp + k2], xg[t][k2], ag[t], 0, 0, 0); }
              if (!isctx) { bf16* G = (bf16*)(F.ws + WS_G);
#pragma unroll
                  for (int t = 0; t < 2; ++t) *(GAS v2u*)(G + (row0 + 16 * (mt0 + t) + r) * 512 + h * 64 + 16 * nt + 4 * q) = pack4(ag[t]); } } }
        __syncthreads();
        if (MODE == 4) { __syncthreads(); continue; }
        { const int c = tid_ & 63, g = tid_ >> 6; LAS float* p = lwT + c * 68 + 8 * g;
          f32x4 v0 = *(LAS f32x4*)p, v1 = *(LAS f32x4*)(p + 4);
          v0[1] += v0[0]; v0[2] += v0[1]; v0[3] += v0[2]; v1[0] += v0[3]; v1[1] += v1[0]; v1[2] += v1[1]; v1[3] += v1[2];
          tot[g * 64 + c] = v1[3];
          __syncthreads();
          float base = 0.f;
#pragma unroll
          for (int g2 = 0; g2 < 7; ++g2) base += (g2 < g) ? tot[g2 * 64 + c] : 0.f;
          v0 += base; v1 += base; *(LAS f32x4*)p = v0; *(LAS f32x4*)(p + 4) = v1;
          if (g == 7) { cle[c] = v1[3]; ecle[c] = __expf(v1[3]); } }
        __syncthreads();
        { float at[8], btv[8], kt[8], rt[8]; float cf = 0.f;
          if (d == 0) { const f32x4 r0 = *(const LAS f32x4*)(RSs + ti * 68 + c8), r1 = *(const LAS f32x4*)(RSs + ti * 68 + c8 + 4), k0 = *(const LAS f32x4*)(KSs + ti * 68 + c8), k1 = *(const LAS f32x4*)(KSs + ti * 68 + c8 + 4);
              vsp = *(const LAS v4u*)(VSs + ti * CP + c8); rn = ssp[ti];
#pragma unroll
              for (int e = 0; e < 8; ++e) { rs[e] = e < 4 ? r0[e & 3] : r1[e & 3]; ks[e] = e < 4 ? k0[e & 3] : k1[e & 3]; }
              __syncthreads(); }
          float vs[8]; unpack8(vsp, vs);
#pragma unroll
          for (int e = 0; e < 8; ++e) { const int c = c8 + e; const float cl = lwT[c * 68 + ip], clp = ip > 0 ? lwT[c * 68 + ip - 1] : 0.f, a = aT[c * 68 + ip], ge = ecle[c];
              const float G = __expf(cl), iG = __expf(-cl), Gex = __expf(clp), GeG = ge * iG;
              const float kke = ks[e] * F.in[15][h * 64 + c] * rn;
              const float km = ks[e] * (1.0f + (a - 1.0f) * F.in[16][h * 64 + c]), kb = kke * a;
              at[e] = -kke * Gex; btv[e] = kb * iG; kt[e] = km * iG; rt[e] = rs[e] * G;
              { const int so = swz(c, ip); CB(4)[so] = f2bf_hw(at[e]); CB(5)[so] = f2bf_hw(kb * GeG); CB(6)[so] = f2bf_hw(km * GeG); CB(7)[so] = f2bf_hw(vs[e]); }
              cf += rs[e] * km * F.in[17][h * 64 + c]; }
          { const int so = swz(ip, c8); *(LAS v4u*)(CB(0) + so) = pack8(at); *(LAS v4u*)(CB(1) + so) = pack8(btv); *(LAS v4u*)(CB(2) + so) = pack8(kt); *(LAS v4u*)(CB(3) + so) = pack8(rt); }
          ssp[F.wave * 64 + ti] = cf; }
        __syncthreads();
        if (!isctx && F.wave == 0) { float cf = 0.f;
#pragma unroll
            for (int w = 0; w < 8; ++w) cf += ssp[w * 64 + ti];
            ((float*)(F.ws + WS_COEF))[(row0 + ti) * 16 + h * 2 + d] = cf; }
        if (MODE == 3) { __syncthreads(); continue; }
        { f32x4 pN[2] = Z2, pLak[2] = Z2, pMrb[2] = Z2, pMrk[2] = Z2;
          { const FragX x1 = ldX<MODE>(CB(1), mt0, r, q), x2 = ldX<MODE>(CB(2), mt0, r, q); const FragY y0 = ldY<MODE>(CB(0), nt, r, q), y3 = ldY<MODE>(CB(3), nt, r, q);
            __builtin_amdgcn_sched_barrier(0);
            mmf<MODE>(x1, y0, pN); mmf<MODE>(x2, y0, pLak); mmf<MODE>(x1, y3, pMrb); mmf<MODE>(x2, y3, pMrk); }
          __builtin_amdgcn_sched_barrier(0);
          const int n = 16 * nt + r;
#pragma unroll
          for (int t = 0; t < 2; ++t) { f32x4 t0;
#pragma unroll
              for (int jj = 0; jj < 4; ++jj) { const int m = 16 * (mt0 + t) + 4 * q + jj;
                  pN[t][jj] = (m < n) ? pN[t][jj] : 0.f; t0[jj] = pN[t][jj] + ((m == n) ? 1.0f : 0.f);
                  pLak[t][jj] = (m < n) ? pLak[t][jj] : 0.f; pMrb[t][jj] = (m <= n) ? pMrb[t][jj] : 0.f; pMrk[t][jj] = (m <= n) ? pMrk[t][jj] : 0.f; }
              stT(CB(8), mt0 + t, nt, r, q, pN[t]); stT(CB(10), mt0 + t, nt, r, q, t0); stR(CB(9), mt0 + t, nt, r, q, pN[t]);
              stT(CB(11), mt0 + t, nt, r, q, pLak[t]); stT(CB(12), mt0 + t, nt, r, q, pMrb[t]); stT(CB(13), mt0 + t, nt, r, q, pMrk[t]); } }
        __syncthreads();
#define SQ_ST(a1, ONT_, ON_) do { _Pragma("unroll") for (int t = 0; t < 2; ++t) { stT(CB(ONT_), mt0 + t, nt, r, q, a1[t]); if ((ON_) >= 0) stR(CB((ON_) < 0 ? 0 : (ON_)), mt0 + t, nt, r, q, a1[t]); } } while (0)
#define TSQ_STAGE(NTB_, TOLD_, TNEW_, NB_, NTB2_, ONT_, ON_) do { f32x4 a3[2], a1[2] = Z2; \
            const FragX xt = ldX<MODE>(CB(NTB_), mt0, r, q); const FragY yt = ldY<MODE>(CB(TOLD_), nt, r, q); a3[0] = ldT(CB(TOLD_), mt0, nt, r, q); a3[1] = ldT(CB(TOLD_), mt0 + 1, nt, r, q); \
            const FragX xs = ldX<MODE>(CB(NB_), mt0, r, q); const FragY ys = ldY<MODE>(CB(NTB2_), nt, r, q); \
            __builtin_amdgcn_sched_barrier(0); \
            mmf<MODE>(xt, yt, a3); mmf<MODE>(xs, ys, a1); \
            __builtin_amdgcn_sched_barrier(0); \
            _Pragma("unroll") for (int t = 0; t < 2; ++t) stT(CB(TNEW_), mt0 + t, nt, r, q, a3[t]); \
            SQ_ST(a1, ONT_, ON_); } while (0)
        { f32x4 w1[2] = Z2, a1[2] = Z2;
          { const FragX xw = ldX<MODE>(CB(11), mt0, r, q), xs = ldX<MODE>(CB(8), mt0, r, q); const FragY yw = ldY<MODE>(CB(7), nt, r, q), ys = ldY<MODE>(CB(9), nt, r, q);
            __builtin_amdgcn_sched_barrier(0);
            mmf<MODE>(xw, yw, w1); mmf<MODE>(xs, ys, a1); }
          __builtin_amdgcn_sched_barrier(0);
          stT(CB(14), mt0, nt, r, q, w1[0]); stT(CB(14), mt0 + 1, nt, r, q, w1[1]); SQ_ST(a1, 0, 1); }
        __syncthreads();
        TSQ_STAGE(0, 10, 2, 1, 0, 8, 9);   __syncthreads();
        TSQ_STAGE(8, 2, 10, 9, 8, 0, 1);   __syncthreads();
        TSQ_STAGE(0, 10, 2, 1, 0, 8, 9);   __syncthreads();
        TSQ_STAGE(8, 2, 10, 9, 8, 0, -1);  __syncthreads();
        { f32x4 a3[2]; const FragX xt = ldX<MODE>(CB(0), mt0, r, q); const FragY yt = ldY<MODE>(CB(10), nt, r, q); a3[0] = ldT(CB(10), mt0, nt, r, q); a3[1] = ldT(CB(10), mt0 + 1, nt, r, q);
          __builtin_amdgcn_sched_barrier(0);
          mmf<MODE>(xt, yt, a3); stT(CB(2), mt0, nt, r, q, a3[0]); stT(CB(2), mt0 + 1, nt, r, q, a3[1]); }
        __syncthreads();
        if (d == 0) { dma_tile(Zm + (ZLORA + 64) * 2, zo, ldsb + 10 * CBUF, F.wave, lane_); dma_tile(Zm + (ZLORA + 128 + 64) * 2, zo, ldsb + 11 * CBUF, F.wave, lane_); }
        { f32x4 w2[2] = Z2, ah[2] = Z2;
          { const FragX xT = ldX<MODE>(CB(2), mt0, r, q); const FragY y14 = ldY<MODE>(CB(14), nt, r, q), y4 = ldY<MODE>(CB(4), nt, r, q);
            __builtin_amdgcn_sched_barrier(0);
            mmf<MODE>(xT, y14, w2); mmf<MODE>(xT, y4, ah); }
#pragma unroll
          for (int t = 0; t < 2; ++t) { stT(CB(8), mt0 + t, nt, r, q, w2[t]); stT(CB(9), mt0 + t, nt, r, q, ah[t]); } }
        __syncthreads();
        if (d == 1 && un >= 0) { const int hn = un & 7, btn = un >> 3, bn = btn / NCHK, blkn = btn % NCHK;
            const size_t rown = (blkn < 4 ? (size_t)MT + bn * LC + blkn * 64 : (size_t)bn * T + (blkn - 4) * 64);
            const char* zn = (const char*)(Z + (rown - 1) * PINP);
            dma_tile(zn + (ZR + hn * 64) * 2, zo, ldsb + 10 * CBUF, F.wave, lane_); dma_tile(zn + (ZRK + hn * 64) * 2, zo, ldsb + 11 * CBUF, F.wave, lane_); dma_tile(zn + (ZRV + hn * 64) * 2, zo, ldsb + 14 * CBUF, F.wave, lane_); }
        { const size_t ud = ((size_t)((b * 8 + h) * 2 + d)) * NCHK + chunk_p;
          bf16* Pg = (bf16*)(F.ws + WS_PQ + ud * PQ_UNIT); bf16* Qg = Pg + 4096;
          f32x4 pP[2] = Z2, pQ[2] = Z2;
          { const FragX x9 = ldX<MODE>(CB(9), mt0, r, q), x5 = ldX<MODE>(CB(5), mt0, r, q), x6 = ldX<MODE>(CB(6), mt0, r, q); const FragY y5 = ldY<MODE>(CB(5), nt, r, q), y8 = ldY<MODE>(CB(8), nt, r, q), y7 = ldY<MODE>(CB(7), nt, r, q);
            __builtin_amdgcn_sched_barrier(0);
            mmf<MODE>(x9, y5, pP); mmf<MODE>(x5, y8, pQ); mmf<MODE>(x6, y7, pQ); }
          __builtin_amdgcn_sched_barrier(0);
          const int n = 16 * nt + r; const float ge = ecle[n];
#pragma unroll
          for (int t = 0; t < 2; ++t) {
#pragma unroll
              for (int jj = 0; jj < 4; ++jj) { const int m = 16 * (mt0 + t) + 4 * q + jj; pP[t][jj] += (m == n) ? ge : 0.f; }
              *(GAS v2u*)(Pg + afrag_off(n, 16 * (mt0 + t) + 4 * q)) = pack4(pP[t]); *(GAS v2u*)(Qg + cfrag_off(n, 16 * (mt0 + t) + 4 * q)) = pack4(pQ[t]); }
          if (!isctx) { const size_t ul = ((size_t)((b * 8 + h) * 2 + d)) * 128 + (chunk_p - 4);
              bf16* Rg = (bf16*)((unsigned char*)F.out + ul * RY_UNIT); bf16* Yg = Rg + 4096;
              f32x4 pR[2], pY[2] = Z2; pR[0] = ldT(CB(3), mt0, nt, r, q); pR[1] = ldT(CB(3), mt0 + 1, nt, r, q);
              { const FragX x9 = ldX<MODE>(CB(9), mt0, r, q), x12 = ldX<MODE>(CB(12), mt0, r, q), x13 = ldX<MODE>(CB(13), mt0, r, q); const FragY y12 = ldY<MODE>(CB(12), nt, r, q), y8 = ldY<MODE>(CB(8), nt, r, q), y7 = ldY<MODE>(CB(7), nt, r, q);
                __builtin_amdgcn_sched_barrier(0);
                mmf<MODE>(x9, y12, pR); mmf<MODE>(x12, y8, pY); mmf<MODE>(x13, y7, pY); }
              __builtin_amdgcn_sched_barrier(0);
#pragma unroll
              for (int t = 0; t < 2; ++t) {
                  *(GAS v2u*)(Rg + afrag_off(d ? 63 - n : n, 16 * (mt0 + t) + 4 * q)) = pack4(pR[t]);
                  if (d) { const f32x4 rv = {pY[t][3], pY[t][2], pY[t][1], pY[t][0]}; *(GAS v2u*)(Yg + cfrag_off(n, 60 - 16 * (mt0 + t) - 4 * q)) = pack4(rv); }
                  else *(GAS v2u*)(Yg + cfrag_off(n, 16 * (mt0 + t) + 4 * q)) = pack4(pY[t]); } } }
        if (d == 0) { if (isctx) VMW(4); else VMW(8); }
        __syncthreads();
    }
#undef SQ_ST
#undef TSQ_STAGE
}

struct BSetPQ { v4u p[8]; v2u qv[4]; };
constexpr size_t XC_UNIT = 2048;
__device__ __forceinline__ void rwkvB_task(Frame& F, int task) {
    const int vsl = task & 3, chain = task >> 2;
    const int r = F.lane & 15, q = F.lane >> 4;
    const unsigned char* PQ = F.ws + WS_PQ + (size_t)chain * NCHK * PQ_UNIT;
    unsigned char* XC = F.ws + WS_YFB + ((size_t)chain * 128 * 4 + vsl) * XC_UNIT;
    f32x4 X[4];
#pragma unroll
    for (int i = 0; i < 4; ++i) X[i] = (f32x4){0.f, 0.f, 0.f, 0.f};
#define B_LOADPQ(S, c_) do { const int _c = (c_) < NCHK ? (c_) : NCHK - 1; const bf16* _P = (const bf16*)(PQ + (size_t)_c * PQ_UNIT); const bf16* _Q = _P + 4096; \
        _Pragma("unroll") for (int mt = 0; mt < 4; ++mt) { S.qv[mt] = *(const GAS v2u*)(_Q + (((vsl * 4 + mt) * 64 + F.lane) << 2)); \
            _Pragma("unroll") for (int ks = 0; ks < 2; ++ks) S.p[mt * 2 + ks] = *(const GAS v4u*)(_P + (((mt * 2 + ks) * 64 + F.lane) << 3)); } } while (0)
#define B_STEP(S, c_) do { const int _c = (c_); bf16x8 xb[2]; \
        _Pragma("unroll") for (int ks = 0; ks < 2; ++ks) { const v2u lo = pack4(X[2 * ks]), hi = pack4(X[2 * ks + 1]); const v4u xw = {lo.x, lo.y, hi.x, hi.y}; xb[ks] = __builtin_bit_cast(bf16x8, xw); \
            if (_c >= 4) *(GAS v4u*)(XC + (size_t)(_c - 4) * 4 * XC_UNIT + ks * 1024 + F.lane * 16) = xw; } \
        _Pragma("unroll") for (int mt = 0; mt < 4; ++mt) { f32x4 xn = unpack4(S.qv[mt]); \
            _Pragma("unroll") for (int ks = 0; ks < 2; ++ks) xn = __builtin_amdgcn_mfma_f32_16x16x32_bf16(__builtin_bit_cast(bf16x8, S.p[mt * 2 + ks]), xb[ks], xn, 0, 0, 0); \
            X[mt] = xn; } } while (0)
    BSetPQ SA, SB, SC;
    B_LOADPQ(SA, 0); B_LOADPQ(SB, 1);
#pragma unroll 1
    for (int c = 0; c < NCHK; c += 3) {
        B_LOADPQ(SC, c + 2); B_STEP(SA, c);
        B_LOADPQ(SA, c + 3); B_STEP(SB, c + 1);
        B_LOADPQ(SB, c + 4); B_STEP(SC, c + 2);
    }
#undef B_LOADPQ
#undef B_STEP
}

constexpr int YSP = 520;
__device__ __forceinline__ void phase_readout(Frame& F) {
    bf16* Z = (bf16*)(F.ws + WS_Z); const bf16* G = (const bf16*)(F.ws + WS_G); const float* COEF = (const float*)(F.ws + WS_COEF);
    LAS bf16* YS = (LAS bf16*)F.lds;
    const int r = F.lane & 15, q = F.lane >> 4, h = F.wave;
    const int hh = F.lane >> 3, c0 = F.lane * 8;
    float gnw[8], gnb[8];
#pragma unroll
    for (int e = 0; e < 8; ++e) { gnw[e] = F.in[18][c0 + e]; gnb[e] = F.in[19][c0 + e]; }
    for (int u = F.bid; u < NB * 128; u += F.G) {
        const int b = u >> 7, blk = u & 127;
        f32x4 y[4][4];
#pragma unroll
        for (int it = 0; it < 4; ++it)
#pragma unroll
            for (int vs = 0; vs < 4; ++vs) y[it][vs] = (f32x4){0.f, 0.f, 0.f, 0.f};
#pragma unroll
        for (int d = 0; d < 2; ++d) {
            const int chain = (b * 8 + h) * 2 + d, lc = d ? 127 - blk : blk;
            const bf16* Rg = (const bf16*)((const unsigned char*)F.out + ((size_t)chain * 128 + lc) * RY_UNIT); const bf16* Yg = Rg + 4096;
            const unsigned char* XC = F.ws + WS_YFB + ((size_t)chain * 128 + lc) * 4 * XC_UNIT;
            v4u xw[4][2], rr[4][2]; v2u yl[4][4];
#pragma unroll
            for (int vs = 0; vs < 4; ++vs) { xw[vs][0] = *(const GAS v4u*)(XC + vs * XC_UNIT + F.lane * 16); xw[vs][1] = *(const GAS v4u*)(XC + vs * XC_UNIT + 1024 + F.lane * 16); }
#pragma unroll
            for (int it = 0; it < 4; ++it) {
#pragma unroll
                for (int ks = 0; ks < 2; ++ks) rr[it][ks] = *(const GAS v4u*)(Rg + (((it * 2 + ks) * 64 + F.lane) << 3));
#pragma unroll
                for (int vs = 0; vs < 4; ++vs) yl[it][vs] = *(const GAS v2u*)(Yg + (((vs * 4 + it) * 64 + F.lane) << 2)); }
#pragma unroll
            for (int it = 0; it < 4; ++it)
#pragma unroll
                for (int vs = 0; vs < 4; ++vs) { f32x4 a = y[it][vs] + unpack4(yl[it][vs]);
#pragma unroll
                    for (int ks = 0; ks < 2; ++ks) a = __builtin_amdgcn_mfma_f32_16x16x32_bf16(__builtin_bit_cast(bf16x8, rr[it][ks]), __builtin_bit_cast(bf16x8, xw[vs][ks]), a, 0, 0, 0);
                    y[it][vs] = a; }
        }
#pragma unroll
        for (int it = 0; it < 4; ++it)
#pragma unroll
            for (int vs = 0; vs < 4; ++vs)
#pragma unroll
                for (int jj = 0; jj < 4; ++jj) YS[(16 * it + 4 * q + jj) * YSP + h * 64 + 16 * vs + r] = f2bf_hw(y[it][vs][jj]);
        __syncthreads();
#pragma unroll 2
        for (int tk = 0; tk < 8; ++tk) {
            const int tok = 8 * F.wave + tk, t = blk * 64 + tok; const size_t m = (size_t)b * T + t;
            float vsh[8], yf[8], gg[8];
            shift8(Z + m * PINP + ZRV + c0, t > 0, t < T - 1, F.in[8] + 1024 + c0, F.in[9] + 1024 + c0, vsh);
            unpack8(*(const LAS v4u*)(YS + tok * YSP + c0), yf); unpack8(*(const GAS v4u*)(G + m * 512 + c0), gg);
            const f32x2 cf2 = *(const GAS f32x2*)(COEF + m * 16 + hh * 2); const float coef = cf2.x + cf2.y;
            float sm = 0.f;
#pragma unroll
            for (int e = 0; e < 8; ++e) sm += yf[e];
            const float mean = sum8(sm) * (1.0f / 64.0f); float q2 = 0.f;
#pragma unroll
            for (int e = 0; e < 8; ++e) { yf[e] -= mean; q2 += yf[e] * yf[e]; }
            const float rstd = 1.0f / sqrtf(sum8(q2) * (1.0f / 64.0f) + GN_EPS);
            float o[8];
#pragma unroll
            for (int e = 0; e < 8; ++e) o[e] = (yf[e] * rstd * gnw[e] + gnb[e] + coef * vsh[e]) * gg[e];
            *(GAS v4u*)(Z + m * PINP + ZK + c0) = pack8(o);
        }
        __syncthreads();
    }
}

__device__ __forceinline__ void phase_ln1_router(Frame& F, float* hdst = nullptr) {
    const float* MODV = (const float*)(F.ws + WS_MOD);
    unsigned char* U2 = F.ws + WS_U2; float* AFF = (float*)(F.ws + WS_AFF);
    LAS float* wr = (LAS float*)F.lds;
    for (int e = F.tid; e < 1024 * 16; e += NTHR) { const int d = e >> 4, ex = e & 15, j = d >> 8, ln = (d & 255) >> 2, q = d & 3; wr[((j * 4 + q) * 64 + ln) * 20 + ex] = F.in[25][e]; }
    LAS float* tr = (LAS float*)(F.lds + 81920 + F.wave * 4352);
    __syncthreads();
    const int gw = F.bid * NWAVES + F.wave, NGW = F.G * NWAVES;
    f32x4 nx[4];
    if (gw < MT) {
#pragma unroll
        for (int j = 0; j < 4; ++j) nx[j] = ((const GAS f32x4*)(F.out + (size_t)gw * D) + F.lane)[64 * j]; }
    for (int m = gw; m < MT; m += NGW) {
        const int b = m / T;
        const float* sh2 = MODV + b * 6144 + 3072; const float* sc2 = sh2 + 1024;
        GAS f32x4* hr = (GAS f32x4*)(F.out + (size_t)m * D) + F.lane;
        f32x4 v[4]; float s = 0.f;
#pragma unroll
        for (int j = 0; j < 4; ++j) { v[j] = nx[j]; s += (v[j].x + v[j].y) + (v[j].z + v[j].w); }
        if (m + NGW < MT) {
#pragma unroll
            for (int j = 0; j < 4; ++j) nx[j] = ((const GAS f32x4*)(F.out + (size_t)(m + NGW) * D) + F.lane)[64 * j]; }
        float mean = wave_sum(s) * (1.f / D); float s2 = 0.f;
#pragma unroll
        for (int j = 0; j < 4; ++j) { v[j] = v[j] - mean; s2 += (v[j].x * v[j].x + v[j].y * v[j].y) + (v[j].z * v[j].z + v[j].w * v[j].w); }
        float rstd = 1.f / sqrtf(wave_sum(s2) * (1.f / D) + LN_EPS);
        s = 0.f;
#pragma unroll
        for (int j = 0; j < 4; ++j) { const f32x4 g = *((const f32x4*)F.in[23] + F.lane + 64 * j), bb = *((const f32x4*)F.in[24] + F.lane + 64 * j);
            v[j] = v[j] * rstd * g + bb; if (hdst) ((GAS f32x4*)(hdst + (size_t)m * D) + F.lane)[64 * j] = v[j]; else hr[64 * j] = v[j]; s += (v[j].x + v[j].y) + (v[j].z + v[j].w); }
        mean = wave_sum(s) * (1.f / D); s2 = 0.f;
#pragma unroll
        for (int j = 0; j < 4; ++j) { v[j] = v[j] - mean; s2 += (v[j].x * v[j].x + v[j].y * v[j].y) + (v[j].z * v[j].z + v[j].w * v[j].w); }
        rstd = 1.f / sqrtf(wave_sum(s2) * (1.f / D) + LN_EPS);
        GAS unsigned* o4 = (GAS unsigned*)(U2 + (size_t)m * D) + F.lane;
        float lg[16];
#pragma unroll
        for (int e = 0; e < 16; ++e) lg[e] = 0.f;
#pragma unroll
        for (int j = 0; j < 4; ++j) { const f32x4 a = *((const f32x4*)sc2 + F.lane + 64 * j), bb = *((const f32x4*)sh2 + F.lane + 64 * j);
            const f32x4 o = v[j] * rstd * (a + 1.0f) + bb; v[j] = o;
            o4[64 * j] = pk4_fp8(o.x, o.y, o.z, o.w); }
#pragma unroll
        for (int j = 0; j < 4; ++j) {
#pragma unroll
            for (int q = 0; q < 4; ++q) { const LAS f32x4* wp = (const LAS f32x4*)(wr + (size_t)(((j * 4 + q) * 64 + F.lane) * 20)); const float oq = v[j][q];
#pragma unroll
                for (int e4 = 0; e4 < 4; ++e4) { const f32x4 w = wp[e4]; lg[e4 * 4 + 0] += oq * w.x; lg[e4 * 4 + 1] += oq * w.y; lg[e4 * 4 + 2] += oq * w.z; lg[e4 * 4 + 3] += oq * w.w; } }
            __builtin_amdgcn_sched_barrier(0); }
#pragma unroll
        for (int e = 0; e < 16; ++e) tr[F.lane * 17 + e] = lg[e];
        LDS_WAIT(); asm volatile("" ::: "memory");
        float lgt = 0.f;
#pragma unroll
        for (int i = 0; i < 16; ++i) lgt += tr[((F.lane >> 4) * 16 + i) * 17 + (F.lane & 15)];
        LDS_WAIT(); asm volatile("" ::: "memory");
        lgt += __shfl_xor(lgt, 16); lgt += __shfl_xor(lgt, 32);
        float mx = lgt;
        mx = fmaxf(mx, dppf<0xB1>(mx)); mx = fmaxf(mx, dppf<0x4E>(mx)); mx = fmaxf(mx, dppf<0x141>(mx)); mx = fmaxf(mx, dppf<0x140>(mx));
        const float ex = expf(lgt - mx); const float mine = ex / row16_sum(ex);
        if (F.lane < 16) AFF[(size_t)m * 16 + F.lane] = mine;
    }
}

__device__ __forceinline__ unsigned block_excl_scan(Frame& F, unsigned v, LAS unsigned* sc, unsigned& total) {
    unsigned inc = v;
#pragma unroll
    for (int o = 1; o < 64; o <<= 1) { const unsigned t = __shfl_up(inc, o); if (F.lane >= o) inc += t; }
    __syncthreads();
    if (F.lane == 63) sc[F.wave] = inc;
    __syncthreads();
    unsigned base = 0, tot = 0;
#pragma unroll
    for (int w = 0; w < 8; ++w) { const unsigned x = sc[w]; if (w < F.wave) base += x; tot += x; }
    total = tot;
    return base + inc - v;
}
__device__ __forceinline__ void topk_unit(Frame& F, int unit) {
    const int b = unit & 3, e = unit >> 2;
    const float* AFF = (const float*)(F.ws + WS_AFF);
    int* IDX = (int*)(F.ws + WS_IDX); float* GATEV = (float*)(F.ws + WS_GATEV); int* SLOT = (int*)(F.ws + WS_SLOT);
    LAS unsigned* hist = (LAS unsigned*)F.lds;
    LAS unsigned* sc = hist + 256;
    LAS unsigned* sel = sc + 16;
    LAS int* idl = (LAS int*)(sel + 16);
    unsigned key[16];
#pragma unroll
    for (int i = 0; i < 16; ++i) key[i] = __float_as_uint(AFF[((size_t)b * T + F.tid * 16 + i) * 16 + e]);
    unsigned prefix = 0, need = CAP;
#pragma unroll 1
    for (int rd = 0; rd < 4; ++rd) {
        const int shift = 24 - 8 * rd; const unsigned hmask = (rd == 0) ? 0u : (0xffffffffu << (shift + 8));
        if (F.tid < 256) hist[F.tid] = 0u;
        __syncthreads();
#pragma unroll
        for (int i = 0; i < 16; ++i) if ((key[i] & hmask) == prefix) __hip_atomic_fetch_add(&hist[(key[i] >> shift) & 255u], 1u, __ATOMIC_RELAXED, __HIP_MEMORY_SCOPE_WORKGROUP);
        __syncthreads();
        if (F.wave == 0) {
            const unsigned c0 = hist[4 * F.lane], c1 = hist[4 * F.lane + 1], c2 = hist[4 * F.lane + 2], c3 = hist[4 * F.lane + 3];
            const unsigned tot4 = (c0 + c1) + (c2 + c3); unsigned x = tot4;
#pragma unroll
            for (int o = 1; o < 64; o <<= 1) { const unsigned t = __shfl_down(x, o); if (F.lane + o < 64) x += t; }
            const unsigned excl = x - tot4;
            if (excl < need && need <= x) { unsigned cum = excl; int bin;
                if (cum + c3 >= need) bin = 4 * F.lane + 3; else { cum += c3; if (cum + c2 >= need) bin = 4 * F.lane + 2; else { cum += c2; if (cum + c1 >= need) bin = 4 * F.lane + 1; else { cum += c1; bin = 4 * F.lane; } } }
                sel[0] = (unsigned)bin; sel[1] = need - cum; } }
        __syncthreads();
        prefix |= sel[0] << shift; need = sel[1];
        __syncthreads();
    }
    unsigned neq = 0, ngt = 0;
#pragma unroll
    for (int i = 0; i < 16; ++i) { neq += (key[i] == prefix); ngt += (key[i] > prefix); }
    unsigned tot; const unsigned eqbase = block_excl_scan(F, neq, sc, tot);
    unsigned cnt = 0, eqr = eqbase; unsigned selm = 0;
#pragma unroll
    for (int i = 0; i < 16; ++i) { bool s = key[i] > prefix; if (key[i] == prefix) { s = eqr < need; ++eqr; } if (s) { selm |= 1u << i; ++cnt; } }
    const unsigned pos0 = block_excl_scan(F, cnt, sc, tot);
    unsigned pos = pos0;
#pragma unroll
    for (int i = 0; i < 16; ++i) { const int t = F.tid * 16 + i; int sl = -1;
        if (selm & (1u << i)) { sl = (int)pos; ++pos; const int slot = (e * NB + b) * CAP + sl; IDX[slot] = b * T + t; GATEV[slot] = __uint_as_float(key[i]); idl[sl] = b * T + t; }
        SLOT[((size_t)b * T + t) * 16 + e] = sl; }
    __syncthreads();
    { const unsigned char* U2 = F.ws + WS_U2; unsigned char* XS = F.ws + WS_XS + (size_t)((e * NB + b) * CAP) * D;
#pragma unroll 1
      for (int s0 = F.wave * 16; s0 < CAP; s0 += NWAVES * 16) { v4u rw[16];
#pragma unroll
          for (int k = 0; k < 16; ++k) rw[k] = *((const GAS v4u*)(U2 + (size_t)idl[s0 + k] * D) + F.lane);
#pragma unroll
          for (int k = 0; k < 16; ++k) *((GAS v4u*)(XS + (size_t)(s0 + k) * D) + F.lane) = rw[k]; } }
    __syncthreads();
}
constexpr int CV_I13 = 16 * (DE / 64), CV_I2 = (DE / 64) * 16, CV_N13 = NE * 2 * CV_I13;
constexpr int Z_EARLY_PER_WAVE = 6;
__device__ __forceinline__ int z_tail_first(int G) { return ((MA / 256) * (PINP / 256)) % G; }
__device__ __forceinline__ int z_early_tiles(int G) { const int t = z_tail_first(G); const int n = t > 0 ? (G - t) * NWAVES * Z_EARLY_PER_WAVE : 0; return n <= NE * CV_I2 - W2_EARLY_TILES ? n : 0; }
__device__ __forceinline__ void cvt_w2_tile(Frame& F, int w2t) { const int e = w2t / CV_I2, r = w2t % CV_I2, k0 = 64 * (r / 16), n0 = 64 * (r % 16);
    cvt_tile64_fp8(F.in[28] + (size_t)e * DE * 1024, 1024, k0, n0, F.ws + WS_W2 + (size_t)e * 1024 * DE, (size_t)n0, DE, W2_SCALE, F.lane); }
__device__ __forceinline__ void cvt_w13_tile(Frame& F, int it0) { const int e = it0 / (2 * CV_I13); int r = it0 % (2 * CV_I13);
    const int which = r / CV_I13; r %= CV_I13; const int nb = DE / 64, k0 = 64 * (r / nb), n0 = 64 * (r % nb);
    cvt_tile64_fp8(F.in[which ? 27 : 26] + (size_t)e * 1024 * DE, DE, k0, n0, F.ws + WS_W13 + (size_t)e * PINP * 1024, (size_t)(256 * (n0 / 128) + 128 * which + (n0 % 128)), 1024, W13_SCALE, F.lane); }
__device__ __forceinline__ void phase_topk_convert(Frame& F) {
    if (F.bid < NB * NE) topk_unit(F, F.bid);
    const int NTK = NB * NE * NWAVES, NVW = F.G * NWAVES - NTK;
    const int gwl = F.bid * NWAVES + F.wave; const int vw0 = gwl < NTK ? 0 : (gwl - NTK), nvw = gwl < NTK ? 0 : 1;
    const int w2done = z_early_tiles(F.G) + W2_EARLY_TILES, nlate = CV_N13 + NE * CV_I2 - w2done;
    for (int itb = vw0; itb < nlate; itb += NVW) for (int v = 0; v < nvw; ++v) { const int it0 = itb + v; if (it0 >= nlate) break;
        if (it0 < CV_N13) cvt_w13_tile(F, it0); else cvt_w2_tile(F, it0 - CV_N13 + w2done); }
}

__device__ __forceinline__ void phase_gather(Frame& F) {
    const int* IDX = (const int*)(F.ws + WS_IDX); const unsigned char* U2 = F.ws + WS_U2; unsigned char* XS = F.ws + WS_XS;
    const int gw = F.bid * NWAVES + F.wave, NGW = F.G * NWAVES;
    for (int s = gw; s < NSLOT; s += NGW) {
        const int src = IDX[s];
        *((GAS v4u*)(XS + (size_t)s * D) + F.lane) = *((const GAS v4u*)(U2 + (size_t)src * D) + F.lane);
    }
}

__device__ __forceinline__ void phase_final(Frame& F, float* odst = nullptr) {
    const float* MODV = (const float*)(F.ws + WS_MOD); const int* SLOT = (const int*)(F.ws + WS_SLOT); const bf16* YE = (const bf16*)(F.ws + WS_YE);
    const int gw = F.bid * NWAVES + F.wave, NGW = F.G * NWAVES;
    int nslot = -1; f32x4 nhv[4];
    if (gw < MT) { nslot = (F.lane < 16) ? SLOT[(size_t)gw * 16 + F.lane] : -1;
#pragma unroll
        for (int j = 0; j < 4; ++j) nhv[j] = ((const GAS f32x4*)(F.out + (size_t)gw * D) + F.lane)[64 * j]; }
    for (int m = gw; m < MT; m += NGW) {
        const int b = m / T;
        const float* gt2 = MODV + b * 6144 + 5120;
        GAS f32x4* hr = (GAS f32x4*)(F.out + (size_t)m * D) + F.lane;
        f32x4 acc[4];
#pragma unroll
        for (int j = 0; j < 4; ++j) acc[j] = (f32x4){0.f, 0.f, 0.f, 0.f};
        const int myslot = nslot;
        f32x4 hv[4];
#pragma unroll
        for (int j = 0; j < 4; ++j) hv[j] = nhv[j];
        if (m + NGW < MT) { nslot = (F.lane < 16) ? SLOT[(size_t)(m + NGW) * 16 + F.lane] : -1;
#pragma unroll
            for (int j = 0; j < 4; ++j) nhv[j] = ((const GAS f32x4*)(F.out + (size_t)(m + NGW) * D) + F.lane)[64 * j]; }
        unsigned mask = (unsigned)(__ballot(myslot >= 0) & 0xFFFFull);
        while (mask) {
            const int e0 = __builtin_ctz(mask); mask &= mask - 1; const bool two = mask != 0; const int e1 = two ? __builtin_ctz(mask) : e0; if (two) mask &= mask - 1;
            const int s0 = __shfl(myslot, e0), s1 = __shfl(myslot, e1);
            const GAS v2u* y0 = (const GAS v2u*)(YE + (size_t)((e0 * NB + b) * CAP + s0) * D) + F.lane; const GAS v2u* y1 = (const GAS v2u*)(YE + (size_t)((e1 * NB + b) * CAP + s1) * D) + F.lane;
            v2u w0[4], w1[4];
#pragma unroll
            for (int j = 0; j < 4; ++j) { w0[j] = y0[64 * j]; w1[j] = y1[64 * j]; }
            const float f1 = two ? 1.f : 0.f;
#pragma unroll
            for (int j = 0; j < 4; ++j) { acc[j].x += bflo(w0[j].x) + f1 * bflo(w1[j].x); acc[j].y += bfhi(w0[j].x) + f1 * bfhi(w1[j].x); acc[j].z += bflo(w0[j].y) + f1 * bflo(w1[j].y); acc[j].w += bfhi(w0[j].y) + f1 * bfhi(w1[j].y); } }
        f32x4 v[4]; float s = 0.f;
#pragma unroll
        for (int j = 0; j < 4; ++j) { const f32x4 g = *((const f32x4*)gt2 + F.lane + 64 * j); v[j] = hv[j] * ALPHA + g * acc[j]; s += (v[j].x + v[j].y) + (v[j].z + v[j].w); }
        const float mean = wave_sum(s) * (1.f / D); float s2 = 0.f;
#pragma unroll
        for (int j = 0; j < 4; ++j) { v[j] = v[j] - mean; s2 += (v[j].x * v[j].x + v[j].y * v[j].y) + (v[j].z * v[j].z + v[j].w * v[j].w); }
        const float rstd = 1.f / sqrtf(wave_sum(s2) * (1.f / D) + LN_EPS);
#pragma unroll
        for (int j = 0; j < 4; ++j) { const f32x4 g = *((const f32x4*)F.in[29] + F.lane + 64 * j), bb = *((const f32x4*)F.in[30] + F.lane + 64 * j); { const f32x4 ov = v[j] * rstd * g + bb; if (odst) ((GAS f32x4*)(odst + (size_t)m * D) + F.lane)[64 * j] = ov; else hr[64 * j] = ov; } }
    }
}

constexpr int N_PHASES = 16;
struct Args { const float* in[31]; float* out; unsigned char* ws; int ph_lo, ph_hi; };
__global__ void __launch_bounds__(NTHR, 2) fwd(Args args) {
    extern __shared__ __attribute__((aligned(16))) unsigned char lds[];
    Frame F;
    F.lds = (LAS unsigned char*)lds;
    F.tid = threadIdx.x; F.lane = F.tid & 63; F.wave = __builtin_amdgcn_readfirstlane(F.tid >> 6);
    F.G = gridDim.x; F.bid = blockIdx.x;
#pragma unroll
    for (int i = 0; i < 31; ++i) F.in[i] = args.in[i];
    F.out = args.out; F.ws = args.ws;
    volatile LAS unsigned* MISC = (volatile LAS unsigned*)(F.lds + MISC_OFF);
    for (int u = F.tid; u < (LDS_BYTES - LDSCTL_OFF) / 4; u += NTHR) ((LAS unsigned*)(F.lds + LDSCTL_OFF))[u] = 0u;
    __syncthreads();
    XcdBarrier bar; bar.bar = (unsigned*)(F.ws + WS_CTL) + CW_BAR; bar.x = 0; bar.st = nullptr;
    const int lo = args.ph_lo, hi = args.ph_hi;
    const bool multi = (hi - lo) > 1;
    if (multi) bar = xcd_barrier_post((unsigned*)(F.ws + WS_CTL) + CW_BAR, MISC + 8);
#ifndef PH_MASK
#define PH_MASK 0xFFFF
#endif
#define IN(k) (((PH_MASK >> (k)) & 1) && lo <= (k) && (k) < hi)
#define SEAM(k) do { if (IN(k) && IN((k) + 1)) xcd_barrier(bar); } while (0)
    LAS unsigned char* ring = F.lds;
    bf16* Z = (bf16*)(F.ws + WS_Z);

    if (IN(0)) { for (int rp = 0; rp < REPS(0); ++rp) { phase_prologue(F); if (rp + 1 < REPS(0)) xcd_barrier(bar); } SEAM(0); }
    if (IN(1)) { for (int rp = 0; rp < REPS(1); ++rp) { phase_ln_mod(F); if (rp + 1 < REPS(1)) xcd_barrier(bar); } SEAM(1); }
    if (IN(2)) {
        pg8::Gemm g{(const bf16*)(F.ws + WS_U), (const bf16*)(F.ws + WS_WIN), MA, PINP, D, D, 1 << 30, 0};
        pg8::StaticOrder S; S.init(MA, PINP, F.G, F.bid);
        pg8::EpiBf16 E{Z, PINP};
        pg8::gemm_phase<pg8::EpiBf16, pg8::StaticOrder, true, true>(ring, g, S, E);
        if (DUP(2)) { xcd_barrier(bar); pg8::gemm_phase<pg8::EpiBf16, pg8::StaticOrder, true, true>(ring, g, S, E); }
        { const int t0 = z_tail_first(F.G);
          if (z_early_tiles(F.G) > 0 && F.bid >= t0) { const int nw = (F.G - t0) * NWAVES, w0 = (F.bid - t0) * NWAVES + F.wave;
              for (int k = 0; k < Z_EARLY_PER_WAVE; ++k) cvt_w2_tile(F, w0 + k * nw); } }
        SEAM(2);
    }
    if (IN(3)) {
        phase_rope_vt(F);
        __syncthreads();
        { LAS float* mu = (LAS float*)(F.lds + LDS_MU); for (int e = F.tid; e < 768; e += NTHR) mu[e] = F.in[e < 384 ? 8 : 9][1536 + (e < 384 ? e : e - 384)]; }
        __syncthreads();
#ifdef PROBE_AMODE
        { int hl0 = -1; for (int u = F.bid; u < NB * NCHK * 8; u += F.G) rwkvA_unit<PROBE_AMODE>(F, u, hl0, -1, -1); }
        xcd_barrier(bar);
#endif
        for (int rp = 0; rp < REPS(3); ++rp) { int hl = -1, pre = -1; for (int u = F.bid; u < NB * NCHK * 8; u += F.G) { const int un = u + F.G < NB * NCHK * 8 ? u + F.G : -1; rwkvA_unit<0>(F, u, hl, pre, un); pre = (((u >> 3) % NCHK) < 4) ? 4 : 8; } if (rp + 1 < REPS(3)) xcd_barrier(bar); }
        SEAM(3);
    }
    if (IN(4)) {
        LAS float* rpbs = (LAS float*)F.lds;
        LAS bf16* ck = (LAS bf16*)(F.lds + 16384);
        LAS bf16* cvt = (LAS bf16*)(F.lds + 16384 + 36864);
        for (int e = F.tid; e < 8 * 465 + 224; e += NTHR) rpbs[e] = e < 8 * 465 ? 8.0f * F.in[7][e] : -1e30f;
        {
            const int vb = F.bid, bh = (vb >> 3) & 31, b4 = bh >> 3, h4 = bh & 7, sub = vb & 7;
            { const bf16* Zc = Z + ((size_t)MT + b4 * LC) * PINP + ZK + h4 * 64; const bf16* VTCg = (const bf16*)(F.ws + WS_VT) + VT_LAT_ELEMS + (size_t)bh * 64 * LC;
              for (int e = F.tid; e < 256 * 8; e += NTHR) { const int row = e >> 3, c8 = (e & 7) * 8; *(LAS v4u*)(ck + row * NA_KP + c8) = *(const GAS v4u*)(Zc + (size_t)row * PINP + c8); }
              for (int e = F.tid; e < 64 * 32; e += NTHR) { const int row = e >> 5, c8 = (e & 31) * 8; *(LAS v4u*)(cvt + row * NA_VP + c8) = *(const GAS v4u*)(VTCg + (size_t)row * LC + c8); } }
            __syncthreads();
            if (vb < 256) {
                if (DUP(4)) { if (F.wave > 0) for (int tk = F.wave - 1; tk < 64; tk += 7) na_wave_task(F, (b4 << 12) | ((16 * sub + (tk >> 2)) << 5) | (h4 << 2) | (tk & 3), rpbs, ck, cvt, ZV); }
                if (F.wave == 0) { rwkvB_task(F, vb);
                    { const int ze = z_early_tiles(F.G); for (int w2t = ze + vb; w2t < ze + W2_EARLY_TILES; w2t += 256) cvt_w2_tile(F, w2t); } }
                else { for (int tk = F.wave - 1; tk < 64; tk += 7) na_wave_task(F, (b4 << 12) | ((16 * sub + (tk >> 2)) << 5) | (h4 << 2) | (tk & 3), rpbs, ck, cvt); }
            }
        }
        if (REPS(4) > 1) { xcd_barrier(bar); if (F.wave == 0 && F.bid < 256) rwkvB_task(F, F.bid); }
        SEAM(4);
    }
    if (IN(5)) { for (int rp = 0; rp < REPS(5); ++rp) { phase_readout(F); if (rp + 1 < REPS(5)) xcd_barrier(bar); } SEAM(5); }
    if (IN(6)) {
        pg8::StaticOrder S; S.init(MT, D, F.G, F.bid);
        { pg8::Gemm g{Z + ZQ, (const bf16*)(F.ws + WS_WPA), MT, D, 512, PINP, 1 << 30, 0};
          pg8::EpiGate<0> E{(bf16*)(F.ws + WS_LORA), D, Z + ZGNA, PINP};
          pg8::gemm_phase<pg8::EpiGate<0>, pg8::StaticOrder, true, true>(ring, g, S, E); }
        VM_WAIT(); __syncthreads();
        { pg8::Gemm g{Z + ZK, (const bf16*)(F.ws + WS_WPR), MT, D, 512, PINP, 1 << 30, 0};
          pg8::EpiGate<1> E{(bf16*)(F.ws + WS_LORA), D, Z + ZGRW, PINP};
          pg8::gemm_phase<pg8::EpiGate<1>, pg8::StaticOrder, true, true>(ring, g, S, E); }
        if (DUP(6)) { xcd_barrier(bar);

        { pg8::Gemm g{Z + ZQ, (const bf16*)(F.ws + WS_WPA), MT, D, 512, PINP, 1 << 30, 0};
          pg8::EpiGate<0> E{(bf16*)(F.ws + WS_LORA), D, Z + ZGNA, PINP};
          pg8::gemm_phase<pg8::EpiGate<0>, pg8::StaticOrder, true, true>(ring, g, S, E); }
        VM_WAIT(); __syncthreads();
        { pg8::Gemm g{Z + ZK, (const bf16*)(F.ws + WS_WPR), MT, D, 512, PINP, 1 << 30, 0};
          pg8::EpiGate<1> E{(bf16*)(F.ws + WS_LORA), D, Z + ZGRW, PINP};
          pg8::gemm_phase<pg8::EpiGate<1>, pg8::StaticOrder, true, true>(ring, g, S, E); }
        }
        SEAM(6);
    }
    if (IN(7)) {
        pg8::Gemm g{(const bf16*)(F.ws + WS_LORA), (const bf16*)(F.ws + WS_WO), MT, D, D, D, 1 << 30, 0};
        pg8::StaticOrder S; S.init(MT, D, F.G, F.bid);
        pg8::EpiResid E{F.out, F.in[0], (const float*)(F.ws + WS_MOD) + 2048, 6144, T, ALPHA};
        pg8::gemm_phase<pg8::EpiResid, pg8::StaticOrder, true, true>(ring, g, S, E);
        if (DUP(7)) { xcd_barrier(bar); pg8::gemm_phase<pg8::EpiResid, pg8::StaticOrder, true, true>(ring, g, S, E); }
        SEAM(7);
    }
    if (IN(8)) { if (DUP(8)) { phase_ln1_router(F, (float*)(F.ws + WS_YE)); xcd_barrier(bar); } phase_ln1_router(F); SEAM(8); }
    if (IN(9)) { for (int rp = 0; rp < REPS(9); ++rp) { phase_topk_convert(F); if (rp + 1 < REPS(9)) xcd_barrier(bar); } SEAM(9); }
    if (IN(11)) {
        pg8::Gemm g{(const bf16*)(F.ws + WS_XS), (const bf16*)(F.ws + WS_W13), NSLOT, PINP, D / 2, D / 2, 16, (size_t)PINP * 1024};
        pg8::StaticOrder S; S.init(NSLOT, PINP, F.G, F.bid);
        pg8::EpiSwiglu E{F.ws + WS_HDN, DE, 1.0f / W13_SCALE, HDN_SCALE};
        pg8::gemm_phase<pg8::EpiSwiglu, pg8::StaticOrder, true, true, true>(ring, g, S, E);
        if (DUP(11)) { xcd_barrier(bar); pg8::gemm_phase<pg8::EpiSwiglu, pg8::StaticOrder, true, true, true>(ring, g, S, E); }
        SEAM(11);
    }
    if (IN(12)) {
        pg8::Gemm g{(const bf16*)(F.ws + WS_HDN), (const bf16*)(F.ws + WS_W2), NSLOT, D, DE / 2, DE / 2, 16, (size_t)1024 * DE};
        pg8::StaticOrder S; S.init(NSLOT, D, F.G, F.bid);
        pg8::EpiScaleRow E{(bf16*)(F.ws + WS_YE), D, (const float*)(F.ws + WS_GATEV), 1.0f / (W2_SCALE * HDN_SCALE)};
        pg8::gemm_phase<pg8::EpiScaleRow, pg8::StaticOrder, true, true, true>(ring, g, S, E);
        if (DUP(12)) { xcd_barrier(bar); pg8::gemm_phase<pg8::EpiScaleRow, pg8::StaticOrder, true, true, true>(ring, g, S, E); }
        if (IN(12) && IN(15)) xcd_barrier(bar);
    }
    if (IN(15)) { if (DUP(15)) { phase_final(F, (float*)(F.ws + WS_HDN)); xcd_barrier(bar); } phase_final(F); }
#undef IN
#undef SEAM
}

extern "C" void kernel_launch(void* const* d_in, const int* in_sizes, int n_in, void* d_out, int out_size, void* d_ws, size_t ws_size, hipStream_t stream) {
    static int grid = 0;
    if (grid == 0) {
        if (n_in != 31 || out_size != MT * D || ws_size < WS_END) { fprintf(stderr, "kernel_launch: unexpected shapes (n_in %d, out %d, ws %zu); nothing launched\n", n_in, out_size, ws_size); grid = -1; return; }
        int dev = 0, cus = 0, per_cu = 0;
        if (hipGetDevice(&dev) != hipSuccess || hipDeviceGetAttribute(&cus, hipDeviceAttributeMultiprocessorCount, dev) != hipSuccess) { grid = -1; return; }
        if (hipFuncSetAttribute((const void*)fwd, hipFuncAttributeMaxDynamicSharedMemorySize, LDS_BYTES) != hipSuccess) { fprintf(stderr, "kernel_launch: hipFuncSetAttribute failed\n"); grid = -1; return; }
        if (hipOccupancyMaxActiveBlocksPerMultiprocessor(&per_cu, (const void*)fwd, NTHR, LDS_BYTES) != hipSuccess || per_cu < 1) fprintf(stderr, "kernel_launch: occupancy query reports %d\n", per_cu);
        (void)hipGetLastError();
        grid = cus;
        if (grid < 256) { fprintf(stderr, "kernel_launch: this kernel needs >= 256 CUs (got %d); nothing launched\n", cus); grid = -1; return; }
    }
    if (grid < 0) return;
    (void)hipMemsetAsync((char*)d_ws + WS_CTL, 0, CTL_ZERO_BYTES, stream);
    Args a{};
    for (int i = 0; i < 31; ++i) a.in[i] = (const float*)d_in[i];
    a.out = (float*)d_out; a.ws = (unsigned char*)d_ws;
#if MK_ONE_LAUNCH
    a.ph_lo = 0; a.ph_hi = 16;
    hipLaunchKernelGGL(fwd, dim3(grid), dim3(NTHR), LDS_BYTES, stream, a);
#else
    for (int p = 0; p < 16; ++p) { a.ph_lo = p; a.ph_hi = p + 1; hipLaunchKernelGGL(fwd, dim3(grid), dim3(NTHR), LDS_BYTES, stream, a); }
#endif
}
```
